# Optimizing an MI355X kernel written in HIP

```python
import math
import jax, jax.numpy as jnp
from jax import lax
import numpy as np


D_MODEL = 1024
BATCH = 2
SEQ = 8192
DEPTH = 4

HEAD_DIM = 64
HEADS_PER_GROUP = D_MODEL // 2 // HEAD_DIM
ATTN_PATTERN = ((128, 1), (512, 4), (2048, 16))
N_ATTN_GROUPS = len(ATTN_PATTERN)
ATTN_WIDTH = HEADS_PER_GROUP * HEAD_DIM
QKV_GROUP_WIDTH = N_ATTN_GROUPS * ATTN_WIDTH
BLK = 128
SSM_WIDTH = D_MODEL // 2
SSM_GROUP = 16
SSM_GROUPS = SSM_WIDTH // SSM_GROUP
SSM_STATE = 64
DT_MIN = 1e-3
DT_MAX = 1e-1
D_FF = ((8 * D_MODEL + 3 * 256 - 1) // (3 * 256)) * 256
EPS = 1e-6
IN_COLS = 3 * QKV_GROUP_WIDTH + SSM_WIDTH + 2 * D_MODEL
SPLIT_POINTS = (QKV_GROUP_WIDTH, 2 * QKV_GROUP_WIDTH, 3 * QKV_GROUP_WIDTH,
                3 * QKV_GROUP_WIDTH + SSM_WIDTH, 3 * QKV_GROUP_WIDTH + SSM_WIDTH + D_MODEL)

kernel_name = "hybrid_gated_dilated_attn_s5_swiglu"


def rms_norm(t, gain):
    t32 = t.astype(jnp.float32)
    y = t32 * lax.rsqrt(jnp.mean(t32 * t32, axis=-1, keepdims=True) + EPS) * gain.astype(jnp.float32)
    return y.astype(t.dtype)


def head_rms_norm(t, gain):
    t32 = t.astype(jnp.float32)
    return t32 * lax.rsqrt(jnp.mean(t32 * t32, axis=-1, keepdims=True) + EPS) * gain.astype(jnp.float32)


def dilated_window_attention(q, k, v, window, dilation):
    b_, L, H, E = q.shape
    span = window // dilation
    unit = dilation * BLK
    Lp = -(-L // unit) * unit
    M = Lp // dilation
    nb = M // BLK

    def to_blocks(t):
        t = jnp.pad(t, ((0, 0), (0, Lp - L), (0, 0), (0, 0)))
        t = t.reshape(b_, M, dilation, H, E).transpose(0, 2, 3, 1, 4)
        return t.reshape(b_, dilation, H, nb, BLK, E)

    def with_prev(t):
        prev = jnp.pad(t[:, :, :, :-1], ((0, 0), (0, 0), (0, 0), (1, 0), (0, 0), (0, 0)))
        return jnp.concatenate([prev, t], axis=4)

    qb = to_blocks(q)
    kw = with_prev(to_blocks(k))
    vw = with_prev(to_blocks(v))
    s = jnp.einsum('brhnqe,brhnke->brhnqk', qb, kw) * (HEAD_DIM ** -0.5)
    qi = jnp.arange(BLK)[:, None]
    ki = jnp.arange(2 * BLK)[None, :]
    dist = BLK + qi - ki
    blk = jnp.arange(nb)[:, None, None]
    mask = (dist >= 0) & (dist <= span) & (blk * BLK + ki - BLK >= 0)
    s = jnp.where(mask, s, -jnp.inf)
    m = jnp.max(s, axis=-1, keepdims=True)
    p = jnp.exp(s - m)
    denom = jnp.sum(p, axis=-1, keepdims=True)
    o = jnp.einsum('brhnqk,brhnke->brhnqe', p, vw) / denom
    lse = (m + jnp.log(denom))[..., 0]
    o = o.reshape(b_, dilation, H, M, E).transpose(0, 3, 1, 2, 4).reshape(b_, Lp, H, E)[:, :L]
    lse = lse.reshape(b_, dilation, H, M).transpose(0, 3, 1, 2).reshape(b_, Lp, H)[:, :L]
    return o, lse


def dilated_attention(q, k, v, g_q, g_k):
    b_, L, _ = q.shape
    shape = (b_, L, N_ATTN_GROUPS, HEADS_PER_GROUP, HEAD_DIM)
    q = head_rms_norm(q.reshape(shape), g_q)
    k = head_rms_norm(k.reshape(shape), g_k)
    v = v.reshape(shape).astype(jnp.float32)
    outs, lses = [], []
    for gi, (window, dilation) in enumerate(ATTN_PATTERN):
        o, lse = dilated_window_attention(q[:, :, gi], k[:, :, gi], v[:, :, gi], window, dilation)
        outs.append(o)
        lses.append(lse)
    w = jax.nn.softmax(jnp.stack(lses, axis=0), axis=0)
    out = jnp.sum(w[..., None] * jnp.stack(outs, axis=0), axis=0)
    return out.reshape(b_, L, ATTN_WIDTH)


def _complex_linear_combine(e1, e2):
    a1r, a1i, b1r, b1i = e1
    a2r, a2i, b2r, b2i = e2
    ar = a2r * a1r - a2i * a1i
    ai = a2r * a1i + a2i * a1r
    br = a2r * b1r - a2i * b1i + b2r
    bi = a2r * b1i + a2i * b1r + b2i
    return (ar, ai, br, bi)


def s5_ssm(u, lam_re, lam_im, log_dt, b_re, b_im, c_re, c_im, d_skip):
    b_, L, _ = u.shape
    u = u.astype(jnp.float32)
    lr = lam_re.astype(jnp.float32)
    li = lam_im.astype(jnp.float32)
    dt = jnp.exp(log_dt.astype(jnp.float32))[:, None]
    mag = jnp.exp(lr * dt)
    ang = li * dt
    abar_re = mag * jnp.cos(ang)
    abar_im = mag * jnp.sin(ang)
    nr = abar_re - 1.0
    ni = abar_im
    den = lr * lr + li * li
    cr = ((nr * lr + ni * li) / den)[..., None]
    ci = ((ni * lr - nr * li) / den)[..., None]
    br = b_re.astype(jnp.float32)
    bi = b_im.astype(jnp.float32)
    bbar_re = cr * br - ci * bi
    bbar_im = cr * bi + ci * br
    ug = u.reshape(b_, L, SSM_GROUPS, SSM_GROUP)
    bu_re = jnp.einsum('blgc,gpc->lbgp', ug, bbar_re)
    bu_im = jnp.einsum('blgc,gpc->lbgp', ug, bbar_im)
    a_re = jnp.broadcast_to(abar_re[None, None], (L, 1, SSM_GROUPS, SSM_STATE))
    a_im = jnp.broadcast_to(abar_im[None, None], (L, 1, SSM_GROUPS, SSM_STATE))
    _, _, xr, xi = lax.associative_scan(_complex_linear_combine, (a_re, a_im, bu_re, bu_im), axis=0)
    y = (jnp.einsum('lbgp,gcp->blgc', xr, c_re.astype(jnp.float32))
         - jnp.einsum('lbgp,gcp->blgc', xi, c_im.astype(jnp.float32)))
    return y.reshape(b_, L, SSM_WIDTH) + d_skip.astype(jnp.float32) * u


def setup_inputs(seed: int = 0) -> dict:
    key = jax.random.key(seed)
    ks = jax.random.split(key, 24)
    f32 = jnp.float32

    def normal(k, shape, scale):
        return jax.random.normal(k, shape, f32) * scale

    n_idx = jnp.arange(SSM_STATE, dtype=f32)
    return {
        "x": normal(ks[0], (BATCH, SEQ, D_MODEL), 1.0),
        "g_mix": 1.0 + normal(ks[1], (DEPTH, D_MODEL), 0.02),
        "w_in": normal(ks[2], (DEPTH, D_MODEL, IN_COLS), D_MODEL ** -0.5),
        "g_q": 1.0 + normal(ks[3], (DEPTH, HEAD_DIM), 0.02),
        "g_k": 1.0 + normal(ks[4], (DEPTH, HEAD_DIM), 0.02),
        "w_attn_proj": normal(ks[5], (DEPTH, ATTN_WIDTH, D_MODEL), ATTN_WIDTH ** -0.5),
        "lambda_re": -0.5 + normal(ks[6], (DEPTH, SSM_GROUPS, SSM_STATE), 0.01),
        "lambda_im": math.pi * n_idx + normal(ks[7], (DEPTH, SSM_GROUPS, SSM_STATE), 0.01),
        "log_dt": jax.random.uniform(ks[8], (DEPTH, SSM_GROUPS), f32, math.log(DT_MIN), math.log(DT_MAX)),
        "b_re": normal(ks[9], (DEPTH, SSM_GROUPS, SSM_STATE, SSM_GROUP), (2 * SSM_GROUP) ** -0.5),
        "b_im": normal(ks[10], (DEPTH, SSM_GROUPS, SSM_STATE, SSM_GROUP), (2 * SSM_GROUP) ** -0.5),
        "c_re": normal(ks[11], (DEPTH, SSM_GROUPS, SSM_GROUP, SSM_STATE), (2 * SSM_STATE) ** -0.5),
        "c_im": normal(ks[12], (DEPTH, SSM_GROUPS, SSM_GROUP, SSM_STATE), (2 * SSM_STATE) ** -0.5),
        "d_skip": normal(ks[13], (DEPTH, SSM_WIDTH), 1.0),
        "w_glu_a": normal(ks[14], (DEPTH, SSM_WIDTH, D_MODEL), SSM_WIDTH ** -0.5),
        "w_glu_b": normal(ks[15], (DEPTH, SSM_WIDTH, D_MODEL), SSM_WIDTH ** -0.5),
        "w_out": normal(ks[16], (DEPTH, D_MODEL, D_MODEL), D_MODEL ** -0.5),
        "g_ffn": 1.0 + normal(ks[17], (DEPTH, D_MODEL), 0.02),
        "w_ffn_gate": normal(ks[18], (DEPTH, D_MODEL, D_FF), D_MODEL ** -0.5),
        "w_ffn_up": normal(ks[19], (DEPTH, D_MODEL, D_FF), D_MODEL ** -0.5),
        "w_ffn_down": normal(ks[20], (DEPTH, D_FF, D_MODEL), D_FF ** -0.5),
    }


def reference(x, g_mix, w_in, g_q, g_k, w_attn_proj, lambda_re, lambda_im, log_dt,
              b_re, b_im, c_re, c_im, d_skip, w_glu_a, w_glu_b, w_out,
              g_ffn, w_ffn_gate, w_ffn_up, w_ffn_down):
    for l in range(DEPTH):
        h = rms_norm(x, g_mix[l])
        z = h @ w_in[l]
        q, k, v, u, gate_a, gate_s = jnp.split(z, SPLIT_POINTS, axis=-1)
        a = dilated_attention(q, k, v, g_q[l], g_k[l]).astype(x.dtype)
        a_out = a @ w_attn_proj[l]
        y = s5_ssm(u, lambda_re[l], lambda_im[l], log_dt[l], b_re[l], b_im[l],
                   c_re[l], c_im[l], d_skip[l])
        y = jax.nn.gelu(y).astype(x.dtype)
        s_out = (y @ w_glu_a[l]) * jax.nn.sigmoid(y @ w_glu_b[l])
        mix = jax.nn.sigmoid(gate_a) * a_out + jax.nn.sigmoid(gate_s) * s_out
        x = x + mix @ w_out[l]
        h2 = rms_norm(x, g_ffn[l])
        x = x + (jax.nn.silu(h2 @ w_ffn_gate[l]) * (h2 @ w_ffn_up[l])) @ w_ffn_down[l]
    return x
```

```cpp
#include <hip/hip_runtime.h>
#include <hip/hip_cooperative_groups.h>
#include <cstdio>
#include <cstdint>
namespace cg = cooperative_groups;

#ifndef MK_SINGLE
#define MK_SINGLE 0
#endif

namespace pg8 {
#define PG8_LAS __attribute__((address_space(3)))
typedef unsigned short bf16_t;
typedef short bf16x8 __attribute__((ext_vector_type(8)));
typedef float f32x4 __attribute__((ext_vector_type(4)));
typedef unsigned u32x4 __attribute__((ext_vector_type(4)));
constexpr int BM = 256, BK = 64, HALF = 128, HTB = HALF * BK * 2, STAGE_BYTES = 8 * HTB, NXCD = 8, WGM = 8;

__host__ __device__ __forceinline__ int lds_byte(int r, int c) { const int st = (r >> 4) * 2 + (c >> 5), rr = r & 15, cc = c & 31, ob = rr * 64 + cc * 2; return st * 1024 + (ob ^ (((ob >> 9) & 1) << 5)); }
__host__ __device__ __forceinline__ void stage_rc(int b, int& R, int& C) { const int st = b / 1024, sb = b % 1024, swz = sb ^ (((sb >> 9) & 1) << 5); R = (st >> 1) * 16 + swz / 64; C = (st & 1) * 32 + (swz % 64) / 2; }
__host__ __device__ __forceinline__ int perm32(int rho) { const int n = rho >> 4, i = rho & 15; return 8 * (i >> 2) + 4 * n + (i & 3); }

struct Unit { int pm, pn; };
struct Gemm { const bf16_t* A; const bf16_t* Bt; int M, N, K, lda; };

struct StaticOrder {
    int nM, nN, nwg, G, c;
    __host__ __device__ void init(int M, int N, int G_, int c_) { nM = M / BM; nN = N / BM; nwg = nM * nN; G = G_; c = c_; }
    __host__ __device__ bool next(int i, Unit& u) const {
        const long L = (long)i * G + c; if (L >= nwg) return false;
        int wgid = (int)L; { const int q = nwg / NXCD, r = nwg % NXCD, xcd = wgid % NXCD, off = wgid / NXCD; wgid = (xcd < r ? xcd * (q + 1) : r * (q + 1) + (xcd - r) * q) + off; }
        const int nig = WGM * nN, gid = wgid / nig, fm = gid * WGM, gsz = (nM - fm) < WGM ? (nM - fm) : WGM;
        u.pm = fm + ((wgid % nig) % gsz); u.pn = (wgid % nig) / gsz; return true;
    }
    __device__ __forceinline__ void a_ready(const Unit&) const {}
    __device__ __forceinline__ void done(const Unit&) const {}
};
struct PairOrder {
    StaticOrder base;
    __host__ __device__ bool next(int i, Unit& u) const { Unit b; if (!base.next(i >> 1, b)) return false; u.pm = b.pm; u.pn = 2 * b.pn + (i & 1); return true; }
    __device__ __forceinline__ void a_ready(const Unit&) const {}
    __device__ __forceinline__ void done(const Unit&) const {}
};

__device__ __forceinline__ unsigned cvt_pk_bf16(float lo, float hi) { unsigned r; asm volatile("v_cvt_pk_bf16_f32 %0, %1, %2" : "=v"(r) : "v"(lo), "v"(hi)); return r; }
__device__ __forceinline__ float bf_lo(unsigned w) { return __uint_as_float(w << 16); }
__device__ __forceinline__ float bf_hi(unsigned w) { return __uint_as_float(w & 0xffff0000u); }
__device__ __forceinline__ float sigmoidf_(float x) { return __builtin_amdgcn_rcpf(1.0f + __builtin_amdgcn_exp2f(-1.44269504089f * x)); }

struct EpiZ {
    static constexpr bool PERM = true, AFTER_DRAIN = false;
    bf16_t* O; int ldc; int sig_pn;
    __device__ __forceinline__ void operator()(const f32x4 (&acc)[2][2][4][2], const Unit& u, int wr, int wc, int fr, int fq) const {
        const int row0 = u.pm * BM + wr * 64 + fr, col0 = u.pn * BM + wc * 32 + 8 * fq; const bool sg = u.pn >= sig_pn;
#pragma unroll
        for (int ai = 0; ai < 2; ++ai)
#pragma unroll
            for (int m = 0; m < 4; ++m) { bf16_t* rowp = O + (size_t)(row0 + ai * HALF + m * 16) * ldc + col0;
#pragma unroll
                for (int bj = 0; bj < 2; ++bj) { f32x4 v0 = acc[ai][bj][m][0], v1 = acc[ai][bj][m][1];
                    if (sg) {
#pragma unroll
                        for (int j = 0; j < 4; ++j) { v0[j] = sigmoidf_(v0[j]); v1[j] = sigmoidf_(v1[j]); } }
                    u32x4 w; w.x = cvt_pk_bf16(v0[0], v0[1]); w.y = cvt_pk_bf16(v0[2], v0[3]); w.z = cvt_pk_bf16(v1[0], v1[1]); w.w = cvt_pk_bf16(v1[2], v1[3]);
                    *(u32x4*)(rowp + bj * HALF) = w; } }
    }
};
struct EpiGate1 {
    static constexpr bool PERM = true, AFTER_DRAIN = false;
    bf16_t* O; int ldc; const bf16_t* G; int ldg;
    __device__ __forceinline__ void operator()(const f32x4 (&acc)[2][2][4][2], const Unit& u, int wr, int wc, int fr, int fq) const {
        const int row0 = u.pm * BM + wr * 64 + fr, col0 = u.pn * BM + wc * 32 + 8 * fq;
#pragma unroll
        for (int ai = 0; ai < 2; ++ai)
#pragma unroll
            for (int m = 0; m < 4; ++m) { const size_t r = (size_t)(row0 + ai * HALF + m * 16);
#pragma unroll
                for (int bj = 0; bj < 2; ++bj) { const f32x4 v0 = acc[ai][bj][m][0], v1 = acc[ai][bj][m][1];
                    const u32x4 g = *(const u32x4*)(G + r * ldg + col0 + bj * HALF);
                    u32x4 w; w.x = cvt_pk_bf16(v0[0] * bf_lo(g.x), v0[1] * bf_hi(g.x)); w.y = cvt_pk_bf16(v0[2] * bf_lo(g.y), v0[3] * bf_hi(g.y));
                    w.z = cvt_pk_bf16(v1[0] * bf_lo(g.z), v1[1] * bf_hi(g.z)); w.w = cvt_pk_bf16(v1[2] * bf_lo(g.w), v1[3] * bf_hi(g.w));
                    *(u32x4*)(O + r * ldc + col0 + bj * HALF) = w; }
                asm volatile("" ::: "memory"); }
    }
};
struct EpiGlu {
    static constexpr bool PERM = true, AFTER_DRAIN = false;
    bf16_t* O; int ldc; const bf16_t* G; int ldg;
    __device__ __forceinline__ void operator()(const f32x4 (&acc)[2][2][4][2], const Unit& u, int wr, int wc, int fr, int fq) const {
        const int row0 = u.pm * BM + wr * 64 + fr, col0 = u.pn * HALF + wc * 32 + 8 * fq;
#pragma unroll
        for (int ai = 0; ai < 2; ++ai)
#pragma unroll
            for (int m = 0; m < 4; ++m) { const size_t r = (size_t)(row0 + ai * HALF + m * 16);
                const u32x4 g = *(const u32x4*)(G + r * ldg + col0); const u32x4 t = *(const u32x4*)(O + r * ldc + col0);
                const f32x4 a0 = acc[ai][0][m][0], a1 = acc[ai][0][m][1], b0 = acc[ai][1][m][0], b1 = acc[ai][1][m][1];
                u32x4 w;
                w.x = cvt_pk_bf16(bf_lo(t.x) + bf_lo(g.x) * a0[0] * sigmoidf_(b0[0]), bf_hi(t.x) + bf_hi(g.x) * a0[1] * sigmoidf_(b0[1]));
                w.y = cvt_pk_bf16(bf_lo(t.y) + bf_lo(g.y) * a0[2] * sigmoidf_(b0[2]), bf_hi(t.y) + bf_hi(g.y) * a0[3] * sigmoidf_(b0[3]));
                w.z = cvt_pk_bf16(bf_lo(t.z) + bf_lo(g.z) * a1[0] * sigmoidf_(b1[0]), bf_hi(t.z) + bf_hi(g.z) * a1[1] * sigmoidf_(b1[1]));
                w.w = cvt_pk_bf16(bf_lo(t.w) + bf_lo(g.w) * a1[2] * sigmoidf_(b1[2]), bf_hi(t.w) + bf_hi(g.w) * a1[3] * sigmoidf_(b1[3]));
                *(u32x4*)(O + r * ldc + col0) = w; asm volatile("" ::: "memory"); }
    }
};
struct EpiSwiglu {
    static constexpr bool PERM = true, AFTER_DRAIN = false;
    bf16_t* O; int ldc;
    __device__ __forceinline__ void operator()(const f32x4 (&acc)[2][2][4][2], const Unit& u, int wr, int wc, int fr, int fq) const {
        const int row0 = u.pm * BM + wr * 64 + fr, col0 = u.pn * HALF + wc * 32 + 8 * fq;
#pragma unroll
        for (int ai = 0; ai < 2; ++ai)
#pragma unroll
            for (int m = 0; m < 4; ++m) { const size_t r = (size_t)(row0 + ai * HALF + m * 16);
                const f32x4 a0 = acc[ai][0][m][0], a1 = acc[ai][0][m][1], b0 = acc[ai][1][m][0], b1 = acc[ai][1][m][1];
                u32x4 w;
                w.x = cvt_pk_bf16(a0[0] * sigmoidf_(a0[0]) * b0[0], a0[1] * sigmoidf_(a0[1]) * b0[1]);
                w.y = cvt_pk_bf16(a0[2] * sigmoidf_(a0[2]) * b0[2], a0[3] * sigmoidf_(a0[3]) * b0[3]);
                w.z = cvt_pk_bf16(a1[0] * sigmoidf_(a1[0]) * b1[0], a1[1] * sigmoidf_(a1[1]) * b1[1]);
                w.w = cvt_pk_bf16(a1[2] * sigmoidf_(a1[2]) * b1[2], a1[3] * sigmoidf_(a1[3]) * b1[3]);
                *(u32x4*)(O + r * ldc + col0) = w; }
    }
};
struct EpiResid {
    static constexpr bool PERM = false, AFTER_DRAIN = false;
    const float* R; float* C; int ldc;
    __device__ __forceinline__ void operator()(const f32x4 (&acc)[2][2][4][2], const Unit& u, int wr, int wc, int fr, int fq) const {
        const int row0 = u.pm * BM + wr * 64 + fr, col0 = u.pn * BM + wc * 32 + 4 * fq;
#pragma unroll
        for (int ai = 0; ai < 2; ++ai)
#pragma unroll
            for (int m = 0; m < 4; ++m) { const size_t off = (size_t)(row0 + ai * HALF + m * 16) * ldc + col0;
#pragma unroll
                for (int bj = 0; bj < 2; ++bj)
#pragma unroll
                    for (int n = 0; n < 2; ++n) { const f32x4 rv = *(const f32x4*)(R + off + bj * HALF + n * 16); *(f32x4*)(C + off + bj * HALF + n * 16) = acc[ai][bj][m][n] + rv; }
                asm volatile("" ::: "memory"); }
    }
};

template <class Epi, class Sched, bool ALIGN_EPI = false, bool SP2 = false>
__device__ __forceinline__ void gemm_phase(PG8_LAS unsigned char* lds, const int tid, const Gemm g, const Sched& S, const Epi& E) {
    const int wid = __builtin_amdgcn_readfirstlane(tid >> 6), lane = tid & 63, wr = wid >> 2, wc = wid & 3, fr = lane & 15, fq = lane >> 4;
    const int K = g.K, nt = K / BK, lda = g.lda;
    unsigned voffA[2], voffB[2];
#pragma unroll
    for (int i = 0; i < 2; ++i) { int R, C; stage_rc(tid * 16 + i * 8192, R, C); const int Rb = Epi::PERM ? ((R & ~31) + perm32(R & 31)) : R;
        voffA[i] = (unsigned)(R * lda + C) * 2u; voffB[i] = (unsigned)(Rb * K + C) * 2u; }
    const size_t kstep = (size_t)(BK * 2);
    const size_t hA = (size_t)HALF * lda * 2, hB = (size_t)HALF * K * 2;
    const size_t tA = 2 * hA, tB = 2 * hB;
    const unsigned ldsw = (unsigned)wid * 1024u;
    const int aoff = lds_byte(wr * 64 + fr, fq * 8), boff = lds_byte(wc * 32 + fr, fq * 8);
#define PG8_SA(b, h) (((b) * 2 + (h)) * HTB)
#define PG8_SB(b, h) ((4 + (b) * 2 + (h)) * HTB)
#define PG8_STAGE(bufoff, gbase, voff) do { _Pragma("unroll") for (int _i = 0; _i < 2; ++_i) \
        __builtin_amdgcn_global_load_lds((const unsigned*)((const char*)(gbase) + (voff)[_i]), (PG8_LAS unsigned*)(lds + (bufoff) + ldsw + _i * 8192), 16, 0, 0); } while (0)
#define PG8_LDA(dst, b, h) do { _Pragma("unroll") for (int m = 0; m < 4; ++m) _Pragma("unroll") for (int k = 0; k < 2; ++k) dst[m][k] = *(const PG8_LAS bf16x8*)(lds + PG8_SA(b, h) + aoff + m * 2048 + k * 1024); } while (0)
#define PG8_LDB(dst, b, h) do { _Pragma("unroll") for (int n = 0; n < 2; ++n) _Pragma("unroll") for (int k = 0; k < 2; ++k) dst[n][k] = *(const PG8_LAS bf16x8*)(lds + PG8_SB(b, h) + boff + n * 2048 + k * 1024); } while (0)
#define PG8_MMA(ai, bj, At, Bt) do { __builtin_amdgcn_s_setprio(1); _Pragma("unroll") for (int m = 0; m < 4; ++m) _Pragma("unroll") for (int n = 0; n < 2; ++n) _Pragma("unroll") for (int k = 0; k < 2; ++k) \
        acc[ai][bj][m][n] = __builtin_amdgcn_mfma_f32_16x16x32_bf16(Bt[n][k], At[m][k], acc[ai][bj][m][n], 0, 0, 0); __builtin_amdgcn_s_setprio(0); } while (0)
#define PG8_WAIT_V(n) asm volatile("s_waitcnt vmcnt(" #n ")" ::: "memory")
#define PG8_WAIT_L(n) asm volatile("s_waitcnt lgkmcnt(" #n ")" ::: "memory")
#define PG8_BAR __builtin_amdgcn_s_barrier()
#define PG8_SCHED __builtin_amdgcn_sched_barrier(0)
    Unit cur, nxt; int ui = 0;
    if (!S.next(0, cur)) return;
    f32x4 acc[2][2][4][2];
#pragma unroll
    for (int a = 0; a < 2; ++a)
#pragma unroll
        for (int b = 0; b < 2; ++b)
#pragma unroll
            for (int m = 0; m < 4; ++m)
#pragma unroll
                for (int n = 0; n < 2; ++n) acc[a][b][m][n] = (f32x4){0.f, 0.f, 0.f, 0.f};
    bf16x8 At[4][2], B0[2][2], B1[2][2];
    const char* cA = (const char*)g.A + (size_t)cur.pm * tA; const char* cB = (const char*)g.Bt + (size_t)cur.pn * tB;
    S.a_ready(cur);
    if constexpr (SP2) {
        PG8_STAGE(PG8_SB(0, 0), cB, voffB); PG8_STAGE(PG8_SB(0, 1), cB + hB, voffB); PG8_STAGE(PG8_SA(0, 0), cA, voffA); PG8_STAGE(PG8_SA(0, 1), cA + hA, voffA);
        if (wr == 1) PG8_BAR;
        PG8_WAIT_V(2); PG8_BAR;
        PG8_STAGE(PG8_SB(1, 0), cB + kstep, voffB); PG8_STAGE(PG8_SA(1, 0), cA + kstep, voffA); PG8_STAGE(PG8_SB(1, 1), cB + hB + kstep, voffB);
        PG8_WAIT_V(6); PG8_BAR;
    } else {
        PG8_STAGE(PG8_SB(0, 0), cB, voffB); PG8_STAGE(PG8_SA(0, 0), cA, voffA); PG8_STAGE(PG8_SB(0, 1), cB + hB, voffB); PG8_STAGE(PG8_SA(0, 1), cA + hA, voffA);
        if (wr == 1) PG8_BAR;
        PG8_WAIT_V(4); PG8_BAR;
        PG8_STAGE(PG8_SB(1, 0), cB + kstep, voffB); PG8_STAGE(PG8_SA(1, 0), cA + kstep, voffA); PG8_STAGE(PG8_SB(1, 1), cB + hB + kstep, voffB);
        PG8_WAIT_V(6); PG8_BAR;
    }
    for (;;) {
        const bool has_next = S.next(ui + 1, nxt);
        const char* nA = has_next ? (const char*)g.A + (size_t)nxt.pm * tA : cA; const char* nB = has_next ? (const char*)g.Bt + (size_t)nxt.pn * tB : cB;
        for (int t = 0; t < nt; t += 2) {
            const bool last = (t == nt - 2);
            const char* a1 = cA + (size_t)(t + 1) * kstep;
            const char* a2 = last ? nA : cA + (size_t)(t + 2) * kstep; const char* b2 = last ? nB : cB + (size_t)(t + 2) * kstep;
            const char* a3 = a2 + kstep; const char* b3 = b2 + kstep;
            if (last && has_next) S.a_ready(nxt);
            if constexpr (SP2) {
            PG8_LDB(B0, 0, 0); PG8_LDB(B1, 0, 1); PG8_SCHED; PG8_LDA(At, 0, 0); PG8_STAGE(PG8_SA(1, 1), a1 + hA, voffA);
            PG8_WAIT_V(8); PG8_WAIT_L(0); PG8_BAR; PG8_MMA(0, 0, At, B0); PG8_MMA(0, 1, At, B1); PG8_BAR; PG8_SCHED;
            PG8_LDA(At, 0, 1); PG8_STAGE(PG8_SB(0, 0), b2, voffB); PG8_STAGE(PG8_SB(0, 1), b2 + hB, voffB); PG8_STAGE(PG8_SA(0, 0), a2, voffA);
            PG8_WAIT_V(8); PG8_WAIT_L(0); PG8_BAR; PG8_MMA(1, 0, At, B0); PG8_MMA(1, 1, At, B1); PG8_BAR; PG8_SCHED;
            PG8_LDB(B0, 1, 0); PG8_LDB(B1, 1, 1); PG8_SCHED; PG8_LDA(At, 1, 0); PG8_STAGE(PG8_SA(0, 1), a2 + hA, voffA);
            PG8_WAIT_V(8); PG8_WAIT_L(0); PG8_BAR; PG8_MMA(0, 0, At, B0); PG8_MMA(0, 1, At, B1); PG8_BAR; PG8_SCHED;
            PG8_LDA(At, 1, 1); PG8_STAGE(PG8_SB(1, 0), b3, voffB); PG8_STAGE(PG8_SB(1, 1), b3 + hB, voffB); PG8_STAGE(PG8_SA(1, 0), a3, voffA);
            PG8_WAIT_V(8); PG8_WAIT_L(0); PG8_BAR; PG8_MMA(1, 0, At, B0); PG8_MMA(1, 1, At, B1); PG8_BAR; PG8_SCHED;
            } else {
            PG8_LDB(B0, 0, 0); PG8_SCHED; PG8_LDA(At, 0, 0); PG8_STAGE(PG8_SA(1, 1), a1 + hA, voffA);
            PG8_WAIT_L(8); PG8_BAR; PG8_WAIT_L(0); PG8_MMA(0, 0, At, B0); PG8_BAR; PG8_SCHED;
            PG8_LDB(B1, 0, 1); PG8_STAGE(PG8_SB(0, 0), b2, voffB);
            PG8_BAR; PG8_WAIT_L(0); PG8_MMA(0, 1, At, B1); PG8_BAR;
            PG8_LDA(At, 0, 1); PG8_STAGE(PG8_SA(0, 0), a2, voffA);
            PG8_BAR; PG8_WAIT_L(0); PG8_MMA(1, 0, At, B0); PG8_BAR; PG8_SCHED;
            PG8_STAGE(PG8_SB(0, 1), b2 + hB, voffB);
            PG8_WAIT_V(6); PG8_BAR; PG8_MMA(1, 1, At, B1); PG8_BAR;
            PG8_LDB(B0, 1, 0); PG8_SCHED; PG8_LDA(At, 1, 0); PG8_STAGE(PG8_SA(0, 1), a2 + hA, voffA);
            PG8_WAIT_L(8); PG8_BAR; PG8_WAIT_L(0); PG8_MMA(0, 0, At, B0); PG8_BAR; PG8_SCHED;
            PG8_LDB(B1, 1, 1); PG8_STAGE(PG8_SB(1, 0), b3, voffB);
            PG8_BAR; PG8_WAIT_L(0); PG8_MMA(0, 1, At, B1); PG8_BAR;
            PG8_LDA(At, 1, 1); PG8_STAGE(PG8_SA(1, 0), a3, voffA);
            PG8_BAR; PG8_WAIT_L(0); PG8_MMA(1, 0, At, B0); PG8_BAR; PG8_SCHED;
            PG8_STAGE(PG8_SB(1, 1), b3 + hB, voffB);
            PG8_WAIT_V(6); PG8_BAR; PG8_MMA(1, 1, At, B1); PG8_BAR;
            }
        }
        if constexpr (ALIGN_EPI) { if (wr == 0) PG8_BAR; }
        if constexpr (!Epi::AFTER_DRAIN) { E(acc, cur, wr, wc, fr, fq); S.done(cur); }
        if (!has_next) break;
#pragma unroll
        for (int a = 0; a < 2; ++a)
#pragma unroll
            for (int b = 0; b < 2; ++b)
#pragma unroll
                for (int m = 0; m < 4; ++m)
#pragma unroll
                    for (int n = 0; n < 2; ++n) acc[a][b][m][n] = (f32x4){0.f, 0.f, 0.f, 0.f};
        cur = nxt; cA = nA; cB = nB; ++ui;
        if constexpr (ALIGN_EPI) { if (wr == 1) PG8_BAR; }
    }
    PG8_WAIT_V(0);
    if constexpr (!ALIGN_EPI) { if (wr == 0) PG8_BAR; }
    PG8_BAR;
#undef PG8_SA
#undef PG8_SB
#undef PG8_STAGE
#undef PG8_LDA
#undef PG8_LDB
#undef PG8_MMA
#undef PG8_WAIT_V
#undef PG8_WAIT_L
#undef PG8_BAR
#undef PG8_SCHED
}
}

typedef unsigned short bf16;
typedef short bf16x8 __attribute__((ext_vector_type(8)));
typedef float f32x4 __attribute__((ext_vector_type(4)));
typedef unsigned u32x4 __attribute__((ext_vector_type(4)));
typedef unsigned u32x2 __attribute__((ext_vector_type(2)));
#define LAS __attribute__((address_space(3)))

constexpr int NWAVES = 8, NTHR = 512;
constexpr int DM = 1024, SEQ = 8192, MTOK = 16384, DEPTH = 4;
constexpr int INC = 7168, DFF = 2816, AW = 512;
constexpr int COL_Q = 0, COL_K = 1536, COL_V = 3072, COL_U = 4608, COL_GA = 5120, COL_GS = 6144;
constexpr int TC = 32, NCH = MTOK / TC  , CHB = SEQ / TC  ;
constexpr float EPS = 1e-6f;

constexpr size_t OFF_IN = 0, OFF_P = 7340032, OFF_GLU = 7864320, OFF_OUT = 8912896, OFF_GU = 9961472, OFF_DN = 15728640, LAYER_W = 18612224;
constexpr size_t MiB = 1u << 20;
constexpr size_t WS_WB = 1 * MiB, WS_Z = 143 * MiB, WS_ACT = 367 * MiB, WS_Y = 399 * MiB, WS_LSE = 415 * MiB, WS_KT = 417 * MiB, WS_E = 418 * MiB, WS_P = 422 * MiB,
                 WS_AT = 426 * MiB, WS_S = 427 * MiB, WS_XP = 435 * MiB, WS_END = 439 * MiB;
static_assert(WS_WB + 4 * LAYER_W * 2 <= WS_Z && WS_Z + (size_t)MTOK * INC * 2 <= WS_ACT, "ws map");
constexpr int LDS_BYTES = 147456;

struct Args { const float* in[21]; float* out; unsigned char* ws; int ph_lo, ph_hi; };

__device__ __forceinline__ unsigned f2bf(float f) { unsigned u = __float_as_uint(f); return (u + 0x7fffu + ((u >> 16) & 1u)) >> 16; }
__device__ __forceinline__ unsigned pk2(float lo, float hi) { return f2bf(lo) | (f2bf(hi) << 16); }
__device__ __forceinline__ float bflo(unsigned w) { return __uint_as_float(w << 16); }
__device__ __forceinline__ float bfhi(unsigned w) { return __uint_as_float(w & 0xffff0000u); }
__device__ __forceinline__ float wave_sum(float v) {
#pragma unroll
    for (int o = 1; o < 64; o <<= 1) v += __shfl_xor(v, o);
    return v;
}

__device__ __forceinline__ void transpose_item(const float* W, int K, int N, bf16* WT, int il_off, float* scr, int item, int lane) {
    const int nblk = N / 32, kb = item / nblk, nb = item % nblk, k0 = 64 * kb, n0 = 32 * nb;
#pragma unroll 8
    for (int i = 0; i < 32; ++i) { const int kk = 2 * i + (lane >> 5); scr[kk * 33 + (lane & 31)] = W[(size_t)(k0 + kk) * N + n0 + (lane & 31)]; }
    __builtin_amdgcn_s_waitcnt(0xc07f); asm volatile("" ::: "memory");
    const int drow = (il_off < 0) ? n0 : (n0 / 128) * 256 + il_off + (n0 % 128);
    const int c = lane & 7;
#pragma unroll
    for (int j = 0; j < 4; ++j) { const int n = (lane >> 3) + 8 * j; const float* s = scr + (8 * c) * 33 + n;
        u32x4 o; o.x = pk2(s[0 * 33], s[1 * 33]); o.y = pk2(s[2 * 33], s[3 * 33]); o.z = pk2(s[4 * 33], s[5 * 33]); o.w = pk2(s[6 * 33], s[7 * 33]);
        *(u32x4*)(WT + (size_t)(drow + n) * K + k0 + 8 * c) = o; }
    __builtin_amdgcn_s_waitcnt(0xc07f); asm volatile("" ::: "memory");
}
__device__ __forceinline__ void phase_weights(const Args& a, int zero, bf16* WB, float* ldsf, int gw, int ngw, int wave, int lane) {
    float* scr = ldsf + wave * 4096;
    constexpr int PER_LAYER = 9088;
    for (int it = gw; it < DEPTH * PER_LAYER; it += ngw) {
        const int l = it / PER_LAYER; int r = it % PER_LAYER; bf16* wl = WB + (size_t)l * LAYER_W;
        if (r < 3584) { transpose_item(a.in[2 + zero] + (size_t)l * DM * INC, DM, INC, wl + OFF_IN, -1, scr, r, lane); continue; } r -= 3584;
        if (r < 256) { transpose_item(a.in[5 + zero] + (size_t)l * AW * DM, AW, DM, wl + OFF_P, -1, scr, r, lane); continue; } r -= 256;
        if (r < 256) { transpose_item(a.in[14 + zero] + (size_t)l * AW * DM, AW, DM, wl + OFF_GLU, 0, scr, r, lane); continue; } r -= 256;
        if (r < 256) { transpose_item(a.in[15 + zero] + (size_t)l * AW * DM, AW, DM, wl + OFF_GLU, 128, scr, r, lane); continue; } r -= 256;
        if (r < 512) { transpose_item(a.in[16 + zero] + (size_t)l * DM * DM, DM, DM, wl + OFF_OUT, -1, scr, r, lane); continue; } r -= 512;
        if (r < 1408) { transpose_item(a.in[18 + zero] + (size_t)l * DM * DFF, DM, DFF, wl + OFF_GU, 0, scr, r, lane); continue; } r -= 1408;
        if (r < 1408) { transpose_item(a.in[19 + zero] + (size_t)l * DM * DFF, DM, DFF, wl + OFF_GU, 128, scr, r, lane); continue; } r -= 1408;
        transpose_item(a.in[20 + zero] + (size_t)l * DFF * DM, DFF, DM, wl + OFF_DN, -1, scr, r, lane);
    }
}

__device__ __forceinline__ void phase_rmsnorm(const float* x, const float* g, bf16* out, int gw, int ngw, int lane) {
    f32x4 gv[4];
#pragma unroll
    for (int j = 0; j < 4; ++j) gv[j] = ((const f32x4*)g)[lane + 64 * j];
    for (int m = gw; m < MTOK; m += ngw) {
        const f32x4* xr = (const f32x4*)(x + (size_t)m * DM) + lane;
        f32x4 v[4]; float s = 0.f;
#pragma unroll
        for (int j = 0; j < 4; ++j) { v[j] = xr[64 * j]; s += (v[j].x * v[j].x + v[j].y * v[j].y) + (v[j].z * v[j].z + v[j].w * v[j].w); }
        const float rstd = 1.0f / sqrtf(wave_sum(s) * (1.f / DM) + EPS);
        u32x2* o8 = (u32x2*)(out + (size_t)m * DM) + lane;
#pragma unroll
        for (int j = 0; j < 4; ++j) { u32x2 w; w.x = pk2(v[j].x * rstd * gv[j].x, v[j].y * rstd * gv[j].y); w.y = pk2(v[j].z * rstd * gv[j].z, v[j].w * rstd * gv[j].w); o8[64 * j] = w; }
    }
}

__device__ __forceinline__ void ssm_pre_item(const Args& a, int zero, int l, int g, unsigned char* ws, float* L, int tid) {
    float* pw = L; float* bb = L + 4224; float* cc = L + 6272; float* lrdt = L + 8320; double* angd = (double*)(L + 8448);
    const float* lam_re = a.in[6 + zero] + (size_t)(l * 32 + g) * 64; const float* lam_im = a.in[7 + zero] + (size_t)(l * 32 + g) * 64;
    const float dt = expf(a.in[8 + zero][l * 32 + g]);
    const float* b_re = a.in[9 + zero] + (size_t)(l * 32 + g) * 1024; const float* b_im = a.in[10 + zero] + (size_t)(l * 32 + g) * 1024;
    const float* c_re = a.in[11 + zero] + (size_t)(l * 32 + g) * 1024; const float* c_im = a.in[12 + zero] + (size_t)(l * 32 + g) * 1024;
    if (tid < 64) {
        const int p = tid; const float lr = lam_re[p], li = lam_im[p];
        const double angle = (double)li * (double)dt; const float lrd = lr * dt;
        lrdt[p] = lrd; angd[p] = angle;
        const double TWO_PI = 6.283185307179586476925; double rr = angle - TWO_PI * rint(angle / TWO_PI);
        float sn, cs; sincosf((float)rr, &sn, &cs); const float mag = expf(lrd);
        const float are = mag * cs, aim = mag * sn, nr = are - 1.0f, ni = aim, den = lr * lr + li * li;
        const float cr = (nr * lr + ni * li) / den, ci = (ni * lr - nr * li) / den;
        for (int c = 0; c < 16; ++c) { const float br = b_re[p * 16 + c], bi = b_im[p * 16 + c]; bb[(p * 16 + c) * 2] = cr * br - ci * bi; bb[(p * 16 + c) * 2 + 1] = cr * bi + ci * br; }
    }
    for (int i = tid; i < 1024; i += NTHR) { cc[i * 2] = c_re[i]; cc[i * 2 + 1] = c_im[i]; }
    __syncthreads();
    for (int i = tid; i < 33 * 64; i += NTHR) { const int j = i >> 6, p = i & 63;
        const double TWO_PI = 6.283185307179586476925; const double angle = angd[p] * (double)j; const double rr = angle - TWO_PI * rint(angle / TWO_PI);
        float sn, cs; sincosf((float)rr, &sn, &cs); const float mag = expf(lrdt[p] * (float)j);
        pw[i * 2] = mag * cs; pw[i * 2 + 1] = mag * sn; }
    __syncthreads();
    bf16* KT = (bf16*)(ws + WS_KT) + (size_t)g * 32 * 256; bf16* E = (bf16*)(ws + WS_E) + (size_t)g * 128 * 512; bf16* P = (bf16*)(ws + WS_P) + (size_t)g * 512 * 128;
    float* AT = (float*)(ws + WS_AT) + g * 128;
    for (int i = tid; i < 32 * 256; i += NTHR) { const int j = i >> 8, c = (i >> 4) & 15, c2 = i & 15; float s = 0.f;
        for (int p = 0; p < 64; ++p) { const float Cr = cc[(c * 64 + p) * 2], Ci = cc[(c * 64 + p) * 2 + 1], wr_ = pw[(j * 64 + p) * 2], wi_ = pw[(j * 64 + p) * 2 + 1];
            const float tr = Cr * wr_ - Ci * wi_, ti = Cr * wi_ + Ci * wr_; s += tr * bb[(p * 16 + c2) * 2] - ti * bb[(p * 16 + c2) * 2 + 1]; }
        KT[i] = (bf16)f2bf(s); }
    for (int i = tid; i < 128 * 512; i += NTHR) { const int row = i >> 9, kidx = i & 511, p = row & 63, s = kidx >> 4, c2 = kidx & 15, j = 31 - s;
        const float wr_ = pw[(j * 64 + p) * 2], wi_ = pw[(j * 64 + p) * 2 + 1], br = bb[(p * 16 + c2) * 2], bi = bb[(p * 16 + c2) * 2 + 1];
        E[i] = (bf16)f2bf((row < 64) ? (wr_ * br - wi_ * bi) : (wr_ * bi + wi_ * br)); }
    for (int i = tid; i < 512 * 128; i += NTHR) { const int row = i >> 7, q = i & 127, p = q & 63, t = row >> 4, c = row & 15, j = t + 1;
        const float Cr = cc[(c * 64 + p) * 2], Ci = cc[(c * 64 + p) * 2 + 1], wr_ = pw[(j * 64 + p) * 2], wi_ = pw[(j * 64 + p) * 2 + 1];
        P[i] = (bf16)f2bf((q < 64) ? (Cr * wr_ - Ci * wi_) : -(Cr * wi_ + Ci * wr_)); }
    if (tid < 64) { AT[tid] = pw[(32 * 64 + tid) * 2]; AT[64 + tid] = pw[(32 * 64 + tid) * 2 + 1]; }
    __syncthreads();
}

constexpr int QP = 72, VP = 272;
constexpr int LQ_OFF = 0, LK_OFF = 128 * QP * 2, LV_OFF = LK_OFF + 256 * QP * 2;
__device__ __forceinline__ void attn_item(int item, const float* gq, const float* gk, bf16* Z, float* LSE, unsigned char* lds, int tid) {
    int it = item; const int rn = it & 63; it >>= 6; const int h = it & 7; it >>= 3; const int gi = it % 3; const int b = it / 3;
    const int dsh = 2 * gi, d = 1 << dsh, nbsh = 6 - dsh;
    const int r = rn >> nbsh, n = rn & ((1 << nbsh) - 1);
    bf16* Qs = (bf16*)(lds + LQ_OFF); bf16* Ks = (bf16*)(lds + LK_OFF); bf16* Vt = (bf16*)(lds + LV_OFF);
    const int chunk = tid & 7, rowi = tid >> 3;
    const size_t rowbase = (size_t)b * SEQ;
    const int hc = gi * 512 + h * 64 + chunk * 8;
    u32x4 qv[2], kv[4], vv[4];
#pragma unroll
    for (int rd = 0; rd < 2; ++rd) { const int row = rowi + 64 * rd; const int tok = ((128 * n + row) << dsh) + r; qv[rd] = *(const u32x4*)(Z + (rowbase + tok) * INC + COL_Q + hc); }
#pragma unroll
    for (int rd = 0; rd < 4; ++rd) { const int ki = rowi + 64 * rd; const int mp = 128 * (n - 1) + ki;
        if (mp >= 0) { const int tok = (mp << dsh) + r; const bf16* p = Z + (rowbase + tok) * INC + hc; kv[rd] = *(const u32x4*)(p + COL_K); vv[rd] = *(const u32x4*)(p + COL_V); }
        else { kv[rd] = (u32x4){0u, 0u, 0u, 0u}; vv[rd] = (u32x4){0u, 0u, 0u, 0u}; } }
    float gqv[8], gkv[8];
#pragma unroll
    for (int i = 0; i < 8; ++i) { gqv[i] = gq[chunk * 8 + i] * 0.125f; gkv[i] = gk[chunk * 8 + i]; }
#pragma unroll
    for (int rd = 0; rd < 2; ++rd) { float f[8]; f[0] = bflo(qv[rd].x); f[1] = bfhi(qv[rd].x); f[2] = bflo(qv[rd].y); f[3] = bfhi(qv[rd].y); f[4] = bflo(qv[rd].z); f[5] = bfhi(qv[rd].z); f[6] = bflo(qv[rd].w); f[7] = bfhi(qv[rd].w);
        float ss = 0.f;
#pragma unroll
        for (int i = 0; i < 8; ++i) ss += f[i] * f[i];
        ss += __shfl_xor(ss, 1); ss += __shfl_xor(ss, 2); ss += __shfl_xor(ss, 4);
        const float rs = 1.0f / sqrtf(ss * (1.f / 64.f) + EPS);
        u32x4 w; w.x = pk2(f[0] * rs * gqv[0], f[1] * rs * gqv[1]); w.y = pk2(f[2] * rs * gqv[2], f[3] * rs * gqv[3]); w.z = pk2(f[4] * rs * gqv[4], f[5] * rs * gqv[5]); w.w = pk2(f[6] * rs * gqv[6], f[7] * rs * gqv[7]);
        *(u32x4*)(Qs + (rowi + 64 * rd) * QP + chunk * 8) = w; }
#pragma unroll
    for (int rd = 0; rd < 4; ++rd) { float f[8]; f[0] = bflo(kv[rd].x); f[1] = bfhi(kv[rd].x); f[2] = bflo(kv[rd].y); f[3] = bfhi(kv[rd].y); f[4] = bflo(kv[rd].z); f[5] = bfhi(kv[rd].z); f[6] = bflo(kv[rd].w); f[7] = bfhi(kv[rd].w);
        float ss = 0.f;
#pragma unroll
        for (int i = 0; i < 8; ++i) ss += f[i] * f[i];
        ss += __shfl_xor(ss, 1); ss += __shfl_xor(ss, 2); ss += __shfl_xor(ss, 4);
        const float rs = 1.0f / sqrtf(ss * (1.f / 64.f) + EPS);
        u32x4 w; w.x = pk2(f[0] * rs * gkv[0], f[1] * rs * gkv[1]); w.y = pk2(f[2] * rs * gkv[2], f[3] * rs * gkv[3]); w.z = pk2(f[4] * rs * gkv[4], f[5] * rs * gkv[5]); w.w = pk2(f[6] * rs * gkv[6], f[7] * rs * gkv[7]);
        const int ki = rowi + 64 * rd;
        *(u32x4*)(Ks + ki * QP + chunk * 8) = w;
        bf16* vp = Vt + (chunk * 8) * VP + ki;
        vp[0 * VP] = (bf16)(vv[rd].x & 0xffffu); vp[1 * VP] = (bf16)(vv[rd].x >> 16); vp[2 * VP] = (bf16)(vv[rd].y & 0xffffu); vp[3 * VP] = (bf16)(vv[rd].y >> 16);
        vp[4 * VP] = (bf16)(vv[rd].z & 0xffffu); vp[5 * VP] = (bf16)(vv[rd].z >> 16); vp[6 * VP] = (bf16)(vv[rd].w & 0xffffu); vp[7 * VP] = (bf16)(vv[rd].w >> 16); }
    __syncthreads();
    {
        const int w = tid >> 6, lane = tid & 63, fr = lane & 15, fq = lane >> 4, kt0 = w & ~1;
        bf16x8 qf[2];
#pragma unroll
        for (int kk = 0; kk < 2; ++kk) qf[kk] = *(const bf16x8*)(Qs + (16 * w + fr) * QP + 32 * kk + 8 * fq);
        f32x4 s[10];
#pragma unroll
        for (int t = 0; t < 10; ++t) { s[t] = (f32x4){0.f, 0.f, 0.f, 0.f};
#pragma unroll
            for (int kk = 0; kk < 2; ++kk) { const bf16x8 kf = *(const bf16x8*)(Ks + (16 * (kt0 + t) + fr) * QP + 32 * kk + 8 * fq); s[t] = __builtin_amdgcn_mfma_f32_16x16x32_bf16(kf, qf[kk], s[t], 0, 0, 0); } }
        const int qi = 16 * w + fr; float mx = -INFINITY;
        const int dbase = 16 * (kt0 - w) + 4 * fq - fr, kbase = 16 * kt0 + 4 * fq - ((n > 0) ? 0 : 128);
#pragma unroll
        for (int t = 0; t < 10; ++t)
#pragma unroll
            for (int j = 0; j < 4; ++j) { const int dlt = dbase + 16 * t + j; const int bad = (dlt | (128 - dlt) | (kbase + 16 * t + j)) >> 31;
                s[t][j] += __int_as_float(bad & (int)0xff800000); mx = fmaxf(mx, s[t][j]); }
        mx = fmaxf(mx, __shfl_xor(mx, 16)); mx = fmaxf(mx, __shfl_xor(mx, 32));
        float sum = 0.f;
#pragma unroll
        for (int t = 0; t < 10; ++t)
#pragma unroll
            for (int j = 0; j < 4; ++j) { const float p = __builtin_amdgcn_exp2f((s[t][j] - mx) * 1.44269504089f); s[t][j] = p; sum += p; }
        sum += __shfl_xor(sum, 16); sum += __shfl_xor(sum, 32);
        f32x4 o[4];
#pragma unroll
        for (int dt = 0; dt < 4; ++dt) o[dt] = (f32x4){0.f, 0.f, 0.f, 0.f};
#pragma unroll
        for (int jj = 0; jj < 5; ++jj) {
            u32x4 pw; pw.x = pk2(s[2 * jj][0], s[2 * jj][1]); pw.y = pk2(s[2 * jj][2], s[2 * jj][3]); pw.z = pk2(s[2 * jj + 1][0], s[2 * jj + 1][1]); pw.w = pk2(s[2 * jj + 1][2], s[2 * jj + 1][3]);
            const bf16x8 pf = __builtin_bit_cast(bf16x8, pw);
#pragma unroll
            for (int dt = 0; dt < 4; ++dt) { const bf16* vp = Vt + (16 * dt + fr) * VP + 32 * (kt0 / 2 + jj) + 4 * fq;
                const u32x2 lo = *(const u32x2*)vp, hi = *(const u32x2*)(vp + 16); u32x4 vw; vw.x = lo.x; vw.y = lo.y; vw.z = hi.x; vw.w = hi.y;
                o[dt] = __builtin_amdgcn_mfma_f32_16x16x32_bf16(__builtin_bit_cast(bf16x8, vw), pf, o[dt], 0, 0, 0); } }
        const float inv = 1.0f / sum;
        const int tokq = ((128 * n + qi) << dsh) + r; const size_t row = rowbase + tokq;
        bf16* op = Z + row * INC + COL_Q + gi * 512 + h * 64 + 4 * fq;
#pragma unroll
        for (int dt = 0; dt < 4; ++dt) { u32x2 w2; w2.x = pk2(o[dt][0] * inv, o[dt][1] * inv); w2.y = pk2(o[dt][2] * inv, o[dt][3] * inv); *(u32x2*)(op + 16 * dt) = w2; }
        if (fq == 0) LSE[((size_t)gi * MTOK + row) * 8 + h] = mx + logf(sum);
    }
    __syncthreads();
}

__device__ __forceinline__ void ssm_s1_item(int item, const bf16* Z, unsigned char* ws, int tid) {
    const int g = item >> 3, mt = item & 7, w = tid >> 6, lane = tid & 63, fr = lane & 15, fq = lane >> 4, sub = w & 3, nh = w >> 2;
    const int chunk = 64 * mt + 16 * sub + fr;
    const bf16* E = (const bf16*)(ws + WS_E) + (size_t)g * 128 * 512; float* S = (float*)(ws + WS_S);
    const bf16* up = Z + ((size_t)chunk * TC + (fq >> 1)) * INC + COL_U + 16 * g + 8 * (fq & 1);
    const bf16* ep = E + (size_t)(64 * nh + fr) * 512 + 8 * fq;
    f32x4 acc[4];
#pragma unroll
    for (int nt = 0; nt < 4; ++nt) acc[nt] = (f32x4){0.f, 0.f, 0.f, 0.f};
#pragma unroll 4
    for (int ks = 0; ks < 16; ++ks) {
        const bf16x8 uf = *(const bf16x8*)(up + (size_t)(2 * ks) * INC);
#pragma unroll
        for (int nt = 0; nt < 4; ++nt) { const bf16x8 ef = *(const bf16x8*)(ep + (size_t)(16 * nt) * 512 + 32 * ks); acc[nt] = __builtin_amdgcn_mfma_f32_16x16x32_bf16(ef, uf, acc[nt], 0, 0, 0); }
    }
#pragma unroll
    for (int nt = 0; nt < 4; ++nt) *(f32x4*)(S + ((size_t)chunk * 32 + g) * 128 + 64 * nh + 16 * nt + 4 * fq) = acc[nt];
}

__device__ __forceinline__ void ssm_carry_item(int item, unsigned char* ws, float* L, int tid) {
    const int b = item >> 5, g = item & 31;
    const float* S = (const float*)(ws + WS_S); bf16* XP = (bf16*)(ws + WS_XP); const float* AT = (const float*)(ws + WS_AT) + g * 128;
#pragma unroll 4
    for (int i = 0; i < 16; ++i) { const int idx = i * NTHR + tid, k = idx >> 5, q4 = idx & 31;
        *(f32x4*)(L + k * 128 + 4 * q4) = *(const f32x4*)(S + ((size_t)(b * CHB + k) * 32 + g) * 128 + 4 * q4); }
    __syncthreads();
    if (tid < 64) {
        const int p = tid; const float ar = AT[p], ai = AT[64 + p]; float xr = 0.f, xi = 0.f;
        bf16* xo = XP + ((size_t)(b * CHB) * 32 + g) * 128 + p;
#pragma unroll 8
        for (int k = 0; k < CHB; ++k) {
            xo[(size_t)k * 32 * 128] = (bf16)f2bf(xr); xo[(size_t)k * 32 * 128 + 64] = (bf16)f2bf(xi);
            const float sr = L[k * 128 + p], si = L[k * 128 + 64 + p];
            const float nr = ar * xr - ai * xi + sr, ni = ar * xi + ai * xr + si; xr = nr; xi = ni;
        }
    }
    __syncthreads();
}

__device__ __forceinline__ void phase_merge(bf16* Z, const float* LSE, int vt, int nvt) {
    for (int i = vt; i < MTOK * 64; i += nvt) { const int row = i >> 6, h = (i >> 3) & 7, ch = i & 7;
        const float l0 = LSE[((size_t)0 * MTOK + row) * 8 + h], l1 = LSE[((size_t)1 * MTOK + row) * 8 + h], l2 = LSE[((size_t)2 * MTOK + row) * 8 + h];
        const float mx = fmaxf(l0, fmaxf(l1, l2)); float w0 = expf(l0 - mx), w1 = expf(l1 - mx), w2 = expf(l2 - mx); const float inv = 1.0f / (w0 + w1 + w2); w0 *= inv; w1 *= inv; w2 *= inv;
        bf16* p = Z + (size_t)row * INC + h * 64 + ch * 8;
        const u32x4 a0 = *(const u32x4*)p, a1 = *(const u32x4*)(p + 512), a2 = *(const u32x4*)(p + 1024);
        u32x4 o;
        o.x = pk2(w0 * bflo(a0.x) + w1 * bflo(a1.x) + w2 * bflo(a2.x), w0 * bfhi(a0.x) + w1 * bfhi(a1.x) + w2 * bfhi(a2.x));
        o.y = pk2(w0 * bflo(a0.y) + w1 * bflo(a1.y) + w2 * bflo(a2.y), w0 * bfhi(a0.y) + w1 * bfhi(a1.y) + w2 * bfhi(a2.y));
        o.z = pk2(w0 * bflo(a0.z) + w1 * bflo(a1.z) + w2 * bflo(a2.z), w0 * bfhi(a0.z) + w1 * bfhi(a1.z) + w2 * bfhi(a2.z));
        o.w = pk2(w0 * bflo(a0.w) + w1 * bflo(a1.w) + w2 * bflo(a2.w), w0 * bfhi(a0.w) + w1 * bfhi(a1.w) + w2 * bfhi(a2.w));
        *(u32x4*)p = o; }
}

__device__ __forceinline__ float gelu_tanh(float y) { const float z = 1.5957691216f * (y + 0.044715f * y * y * y); return y * __builtin_amdgcn_rcpf(1.0f + __builtin_amdgcn_exp2f(-1.44269504089f * z)); }
__device__ __forceinline__ void ssm_s3_item(int item, const float* dskip, const bf16* Z, bf16* Y, unsigned char* ws, int tid) {
    const int g = item >> 3, mt = item & 7, w = tid >> 6, lane = tid & 63, fr = lane & 15, fq = lane >> 4;
    const bf16* KT = (const bf16*)(ws + WS_KT) + (size_t)g * 32 * 256; const bf16* P = (const bf16*)(ws + WS_P) + (size_t)g * 512 * 128; const bf16* XP = (const bf16*)(ws + WS_XP);
    const float* dsk = dskip + g * 16 + 4 * fq;
    const float d0 = dsk[0], d1 = dsk[1], d2 = dsk[2], d3 = dsk[3];
    const int chunk0 = 64 * mt + fr;
    const int shalf = fq >> 1, c20 = 8 * (fq & 1);
#pragma unroll 1
    for (int ti = 0; ti < 4; ++ti) {
        const int t = (ti == 0) ? w : (ti == 1) ? 15 - w : (ti == 2) ? 16 + w : 31 - w;
        f32x4 acc[4];
#pragma unroll
        for (int mi = 0; mi < 4; ++mi) acc[mi] = (f32x4){0.f, 0.f, 0.f, 0.f};
        const int nks = (t >> 1) + 1;
#pragma unroll 2
        for (int ks = 0; ks < nks; ++ks) {
            const int s = 2 * ks + shalf, lag = t - s;
            bf16x8 wf = (bf16x8){0, 0, 0, 0, 0, 0, 0, 0};
            if (lag >= 0) wf = *(const bf16x8*)(KT + (size_t)lag * 256 + fr * 16 + c20);
#pragma unroll
            for (int mi = 0; mi < 4; ++mi) { const bf16x8 uf = *(const bf16x8*)(Z + ((size_t)(chunk0 + 16 * mi) * TC + s) * INC + COL_U + 16 * g + c20);
                acc[mi] = __builtin_amdgcn_mfma_f32_16x16x32_bf16(wf, uf, acc[mi], 0, 0, 0); }
        }
#pragma unroll
        for (int k2 = 0; k2 < 4; ++k2) {
            const bf16x8 wf = *(const bf16x8*)(P + (size_t)(t * 16 + fr) * 128 + 32 * k2 + 8 * fq);
#pragma unroll
            for (int mi = 0; mi < 4; ++mi) { const bf16x8 xf = *(const bf16x8*)(XP + ((size_t)(chunk0 + 16 * mi) * 32 + g) * 128 + 32 * k2 + 8 * fq);
                acc[mi] = __builtin_amdgcn_mfma_f32_16x16x32_bf16(wf, xf, acc[mi], 0, 0, 0); }
        }
#pragma unroll
        for (int mi = 0; mi < 4; ++mi) { const size_t tok = (size_t)(chunk0 + 16 * mi) * TC + t;
            const u32x2 uu = *(const u32x2*)(Z + tok * INC + COL_U + 16 * g + 4 * fq);
            const float y0 = acc[mi][0] + d0 * bflo(uu.x), y1 = acc[mi][1] + d1 * bfhi(uu.x), y2 = acc[mi][2] + d2 * bflo(uu.y), y3 = acc[mi][3] + d3 * bfhi(uu.y);
            u32x2 o; o.x = pk2(gelu_tanh(y0), gelu_tanh(y1)); o.y = pk2(gelu_tanh(y2), gelu_tanh(y3));
            *(u32x2*)(Y + tok * AW + 16 * g + 4 * fq) = o; }
    }
}

constexpr int N_PHASES = 1 + 10 * DEPTH;
__global__ void __launch_bounds__(NTHR, 2) mega_fwd(Args a) {
    extern __shared__ __attribute__((aligned(16))) unsigned char lds[];
    cg::grid_group grid = cg::this_grid();
    LAS unsigned char* ldsl = (LAS unsigned char*)lds;
    for (int ph = a.ph_lo; ph < a.ph_hi; ++ph) {
        int zero; asm volatile("s_mov_b32 %0, 0" : "=s"(zero));
        int tid = threadIdx.x; asm volatile("" : "+v"(tid));
        const int lane = tid & 63, wave = __builtin_amdgcn_readfirstlane(tid >> 6);
        const int G = (int)gridDim.x + zero, bx = (int)blockIdx.x + zero;
        const int gw = bx * NWAVES + wave, ngw = G * NWAVES;
        unsigned char* ws = a.ws + zero; float* outp = a.out + zero;
        bf16* WB = (bf16*)(ws + WS_WB); bf16* Z = (bf16*)(ws + WS_Z); bf16* ACT = (bf16*)(ws + WS_ACT); bf16* Y = (bf16*)(ws + WS_Y); float* LSE = (float*)(ws + WS_LSE);
        if (ph == 0) {
            phase_weights(a, zero, WB, (float*)lds, gw, ngw, wave, lane);
        } else {
            const int l = (ph - 1) / 10, k = (ph - 1) % 10;
            const bf16* wl = WB + (size_t)l * LAYER_W;
            const float* xin = (l == 0) ? a.in[zero] : outp;
            if (k == 0) {
                for (int g = bx; g < 32; g += G) ssm_pre_item(a, zero, l, g, ws, (float*)lds, tid);
                phase_rmsnorm(xin, a.in[1 + zero] + l * DM, ACT, gw, ngw, lane);
            } else if (k == 1) {
                pg8::Gemm gm{ACT, wl + OFF_IN, MTOK, INC, DM, DM}; pg8::StaticOrder S; S.init(MTOK, INC, G, bx);
                pg8::EpiZ E{Z, INC, COL_GA / 256};
                pg8::gemm_phase<pg8::EpiZ, pg8::StaticOrder, true, true>(ldsl, tid, gm, S, E);
            } else if (k == 2) {
                const float* gq = a.in[3 + zero] + l * 64; const float* gk = a.in[4 + zero] + l * 64;
                for (int it = bx; it < 3072 + 256; it += G) {
                    if (it < 3072) attn_item(it, gq, gk, Z, LSE, lds, tid);
                    else ssm_s1_item(it - 3072, Z, ws, tid);
                }
            } else if (k == 3) {
                for (int it = bx; it < 64; it += G) ssm_carry_item(it, ws, (float*)lds, tid);
                if (G >= 128) { if (bx >= 64) phase_merge(Z, LSE, (bx - 64) * NTHR + tid, (G - 64) * NTHR); }
                else phase_merge(Z, LSE, bx * NTHR + tid, G * NTHR);
            } else if (k == 4) {
                const float* dskip = a.in[13 + zero] + l * 512;
                for (int it = bx; it < 256; it += G) ssm_s3_item(it, dskip, Z, Y, ws, tid);
            } else if (k == 5) {
                { pg8::Gemm gm{Z + COL_Q, wl + OFF_P, MTOK, DM, AW, INC}; pg8::StaticOrder S; S.init(MTOK, DM, G, bx);
                  pg8::EpiGate1 E{ACT, DM, Z + COL_GA, INC};
                  pg8::gemm_phase<pg8::EpiGate1, pg8::StaticOrder, true, true>(ldsl, tid, gm, S, E); }
                { pg8::Gemm gm{Y, wl + OFF_GLU, MTOK, 2 * DM, AW, AW}; pg8::PairOrder S; S.base.init(MTOK, DM, G, bx);
                  pg8::EpiGlu E{ACT, DM, Z + COL_GS, INC};
                  pg8::gemm_phase<pg8::EpiGlu, pg8::PairOrder, true, true>(ldsl, tid, gm, S, E); }
            } else if (k == 6) {
                pg8::Gemm gm{ACT, wl + OFF_OUT, MTOK, DM, DM, DM}; pg8::StaticOrder S; S.init(MTOK, DM, G, bx);
                pg8::EpiResid E{xin, outp, DM};
                pg8::gemm_phase<pg8::EpiResid, pg8::StaticOrder, true, true>(ldsl, tid, gm, S, E);
            } else if (k == 7) {
                phase_rmsnorm(outp, a.in[17 + zero] + l * DM, ACT, gw, ngw, lane);
            } else if (k == 8) {
                pg8::Gemm gm{ACT, wl + OFF_GU, MTOK, 2 * DFF, DM, DM}; pg8::StaticOrder S; S.init(MTOK, 2 * DFF, G, bx);
                pg8::EpiSwiglu E{Z, DFF};
                pg8::gemm_phase<pg8::EpiSwiglu, pg8::StaticOrder, true, true>(ldsl, tid, gm, S, E);
            } else {
                pg8::Gemm gm{Z, wl + OFF_DN, MTOK, DM, DFF, DFF}; pg8::StaticOrder S; S.init(MTOK, DM, G, bx);
                pg8::EpiResid E{outp, outp, DM};
                pg8::gemm_phase<pg8::EpiResid, pg8::StaticOrder, true, true>(ldsl, tid, gm, S, E);
            }
        }
        if (ph + 1 < a.ph_hi) grid.sync();
    }
}

extern "C" void kernel_launch(void* const* d_in, const int* in_sizes, int n_in, void* d_out, int out_size, void* d_ws, size_t ws_size, hipStream_t stream) {
    static int grid = 0;
    if (grid == 0) {
        if (n_in != 21 || in_sizes[0] != MTOK * DM || out_size != MTOK * DM || ws_size < WS_END) { fprintf(stderr, "kernel_launch: unexpected shapes / workspace (n_in %d, ws %zu)\n", n_in, ws_size); grid = -1; return; }
        int dev = 0, cus = 0, per_cu = 0;
        (void)hipGetDevice(&dev); (void)hipDeviceGetAttribute(&cus, hipDeviceAttributeMultiprocessorCount, dev);
        (void)hipFuncSetAttribute((const void*)mega_fwd, hipFuncAttributeMaxDynamicSharedMemorySize, LDS_BYTES);
        (void)hipOccupancyMaxActiveBlocksPerMultiprocessor(&per_cu, (const void*)mega_fwd, NTHR, LDS_BYTES);
        if (per_cu < 1) per_cu = 1;
        (void)hipGetLastError();
        grid = cus * per_cu;
    }
    if (grid < 0) return;
    Args a{};
    for (int i = 0; i < 21; ++i) a.in[i] = (const float*)d_in[i];
    a.out = (float*)d_out; a.ws = (unsigned char*)d_ws;
#if MK_SINGLE
    a.ph_lo = 0; a.ph_hi = N_PHASES;
    void* args[] = {&a};
    hipError_t e = hipLaunchCooperativeKernel((const void*)mega_fwd, dim3(grid), dim3(NTHR), args, LDS_BYTES, stream);
    if (e != hipSuccess) fprintf(stderr, "cooperative launch failed: %s (grid %d)\n", hipGetErrorString(e), grid);
#else
    for (int ph = 0; ph < N_PHASES; ++ph) { a.ph_lo = ph; a.ph_hi = ph + 1; hipLaunchKernelGGL(mega_fwd, dim3(grid), dim3(NTHR), LDS_BYTES, stream, a); }
#endif
}
```

```cpp
#include <hip/hip_runtime.h>
#include <hip/hip_cooperative_groups.h>
#include <cstdio>
#include <cstdint>
namespace cg = cooperative_groups;

#ifndef MK_SINGLE
#define MK_SINGLE 1
#endif

namespace pg8 {
#define PG8_LAS __attribute__((address_space(3)))
typedef unsigned short bf16_t;
typedef short bf16x8 __attribute__((ext_vector_type(8)));
typedef float f32x4 __attribute__((ext_vector_type(4)));
typedef unsigned u32x4 __attribute__((ext_vector_type(4)));
constexpr int BM = 256, BK = 64, HALF = 128, HTB = HALF * BK * 2, STAGE_BYTES = 8 * HTB, NXCD = 8, WGM = 8;

__host__ __device__ __forceinline__ int lds_byte(int r, int c) { const int st = (r >> 4) * 2 + (c >> 5), rr = r & 15, cc = c & 31, ob = rr * 64 + cc * 2; return st * 1024 + (ob ^ (((ob >> 9) & 1) << 5)); }
__host__ __device__ __forceinline__ void stage_rc(int b, int& R, int& C) { const int st = b / 1024, sb = b % 1024, swz = sb ^ (((sb >> 9) & 1) << 5); R = (st >> 1) * 16 + swz / 64; C = (st & 1) * 32 + (swz % 64) / 2; }
__host__ __device__ __forceinline__ int perm32(int rho) { const int n = rho >> 4, i = rho & 15; return 8 * (i >> 2) + 4 * n + (i & 3); }

struct Unit { int pm, pn; };
struct Gemm { const bf16_t* A; const bf16_t* Bt; int M, N, K, lda; };

struct StaticOrder {
    int nM, nN, nwg, G, c;
    __host__ __device__ void init(int M, int N, int G_, int c_) { nM = M / BM; nN = N / BM; nwg = nM * nN; G = G_; c = c_; }
    __host__ __device__ bool next(int i, Unit& u) const {
        const long L = (long)i * G + c; if (L >= nwg) return false;
        int wgid = (int)L; { const int q = nwg / NXCD, r = nwg % NXCD, xcd = wgid % NXCD, off = wgid / NXCD; wgid = (xcd < r ? xcd * (q + 1) : r * (q + 1) + (xcd - r) * q) + off; }
        const int nig = WGM * nN, gid = wgid / nig, fm = gid * WGM, gsz = (nM - fm) < WGM ? (nM - fm) : WGM;
        u.pm = fm + ((wgid % nig) % gsz); u.pn = (wgid % nig) / gsz; return true;
    }
    __device__ __forceinline__ void a_ready(const Unit&) const {}
    __device__ __forceinline__ void done(const Unit&) const {}
};
struct PairOrder {
    StaticOrder base;
    __host__ __device__ bool next(int i, Unit& u) const { Unit b; if (!base.next(i >> 1, b)) return false; u.pm = b.pm; u.pn = 2 * b.pn + (i & 1); return true; }
    __device__ __forceinline__ void a_ready(const Unit&) const {}
    __device__ __forceinline__ void done(const Unit&) const {}
};

__device__ __forceinline__ unsigned cvt_pk_bf16(float lo, float hi) { unsigned r; asm volatile("v_cvt_pk_bf16_f32 %0, %1, %2" : "=v"(r) : "v"(lo), "v"(hi)); return r; }
__device__ __forceinline__ float bf_lo(unsigned w) { return __uint_as_float(w << 16); }
__device__ __forceinline__ float bf_hi(unsigned w) { return __uint_as_float(w & 0xffff0000u); }
__device__ __forceinline__ float sigmoidf_(float x) { return __builtin_amdgcn_rcpf(1.0f + __builtin_amdgcn_exp2f(-1.44269504089f * x)); }

struct EpiZ {
    static constexpr bool PERM = true, AFTER_DRAIN = false;
    bf16_t* O; int ldc; int sig_pn;
    __device__ __forceinline__ void operator()(const f32x4 (&acc)[2][2][4][2], const Unit& u, int wr, int wc, int fr, int fq) const {
        const int row0 = u.pm * BM + wr * 64 + fr, col0 = u.pn * BM + wc * 32 + 8 * fq; const bool sg = u.pn >= sig_pn;
#pragma unroll
        for (int ai = 0; ai < 2; ++ai)
#pragma unroll
            for (int m = 0; m < 4; ++m) { bf16_t* rowp = O + (size_t)(row0 + ai * HALF + m * 16) * ldc + col0;
#pragma unroll
                for (int bj = 0; bj < 2; ++bj) { f32x4 v0 = acc[ai][bj][m][0], v1 = acc[ai][bj][m][1];
                    if (sg) {
#pragma unroll
                        for (int j = 0; j < 4; ++j) { v0[j] = sigmoidf_(v0[j]); v1[j] = sigmoidf_(v1[j]); } }
                    u32x4 w; w.x = cvt_pk_bf16(v0[0], v0[1]); w.y = cvt_pk_bf16(v0[2], v0[3]); w.z = cvt_pk_bf16(v1[0], v1[1]); w.w = cvt_pk_bf16(v1[2], v1[3]);
                    *(u32x4*)(rowp + bj * HALF) = w; } }
    }
};
struct EpiGate1 {
    static constexpr bool PERM = true, AFTER_DRAIN = false;
    bf16_t* O; int ldc; const bf16_t* G; int ldg;
    __device__ __forceinline__ void operator()(const f32x4 (&acc)[2][2][4][2], const Unit& u, int wr, int wc, int fr, int fq) const {
        const int row0 = u.pm * BM + wr * 64 + fr, col0 = u.pn * BM + wc * 32 + 8 * fq;
#pragma unroll
        for (int ai = 0; ai < 2; ++ai)
#pragma unroll
            for (int m = 0; m < 4; ++m) { const size_t r = (size_t)(row0 + ai * HALF + m * 16);
#pragma unroll
                for (int bj = 0; bj < 2; ++bj) { const f32x4 v0 = acc[ai][bj][m][0], v1 = acc[ai][bj][m][1];
                    const u32x4 g = *(const u32x4*)(G + r * ldg + col0 + bj * HALF);
                    u32x4 w; w.x = cvt_pk_bf16(v0[0] * bf_lo(g.x), v0[1] * bf_hi(g.x)); w.y = cvt_pk_bf16(v0[2] * bf_lo(g.y), v0[3] * bf_hi(g.y));
                    w.z = cvt_pk_bf16(v1[0] * bf_lo(g.z), v1[1] * bf_hi(g.z)); w.w = cvt_pk_bf16(v1[2] * bf_lo(g.w), v1[3] * bf_hi(g.w));
                    *(u32x4*)(O + r * ldc + col0 + bj * HALF) = w; }
                asm volatile("" ::: "memory"); }
    }
};
struct EpiGlu {
    static constexpr bool PERM = true, AFTER_DRAIN = false;
    bf16_t* O; int ldc; const bf16_t* G; int ldg;
    __device__ __forceinline__ void operator()(const f32x4 (&acc)[2][2][4][2], const Unit& u, int wr, int wc, int fr, int fq) const {
        const int row0 = u.pm * BM + wr * 64 + fr, col0 = u.pn * HALF + wc * 32 + 8 * fq;
#pragma unroll
        for (int ai = 0; ai < 2; ++ai)
#pragma unroll
            for (int m = 0; m < 4; ++m) { const size_t r = (size_t)(row0 + ai * HALF + m * 16);
                const u32x4 g = *(const u32x4*)(G + r * ldg + col0); const u32x4 t = *(const u32x4*)(O + r * ldc + col0);
                const f32x4 a0 = acc[ai][0][m][0], a1 = acc[ai][0][m][1], b0 = acc[ai][1][m][0], b1 = acc[ai][1][m][1];
                u32x4 w;
                w.x = cvt_pk_bf16(bf_lo(t.x) + bf_lo(g.x) * a0[0] * sigmoidf_(b0[0]), bf_hi(t.x) + bf_hi(g.x) * a0[1] * sigmoidf_(b0[1]));
                w.y = cvt_pk_bf16(bf_lo(t.y) + bf_lo(g.y) * a0[2] * sigmoidf_(b0[2]), bf_hi(t.y) + bf_hi(g.y) * a0[3] * sigmoidf_(b0[3]));
                w.z = cvt_pk_bf16(bf_lo(t.z) + bf_lo(g.z) * a1[0] * sigmoidf_(b1[0]), bf_hi(t.z) + bf_hi(g.z) * a1[1] * sigmoidf_(b1[1]));
                w.w = cvt_pk_bf16(bf_lo(t.w) + bf_lo(g.w) * a1[2] * sigmoidf_(b1[2]), bf_hi(t.w) + bf_hi(g.w) * a1[3] * sigmoidf_(b1[3]));
                *(u32x4*)(O + r * ldc + col0) = w; asm volatile("" ::: "memory"); }
    }
};
struct EpiSwiglu {
    static constexpr bool PERM = true, AFTER_DRAIN = false;
    bf16_t* O; int ldc;
    __device__ __forceinline__ void operator()(const f32x4 (&acc)[2][2][4][2], const Unit& u, int wr, int wc, int fr, int fq) const {
        const int row0 = u.pm * BM + wr * 64 + fr, col0 = u.pn * HALF + wc * 32 + 8 * fq;
#pragma unroll
        for (int ai = 0; ai < 2; ++ai)
#pragma unroll
            for (int m = 0; m < 4; ++m) { const size_t r = (size_t)(row0 + ai * HALF + m * 16);
                const f32x4 a0 = acc[ai][0][m][0], a1 = acc[ai][0][m][1], b0 = acc[ai][1][m][0], b1 = acc[ai][1][m][1];
                u32x4 w;
                w.x = cvt_pk_bf16(a0[0] * sigmoidf_(a0[0]) * b0[0], a0[1] * sigmoidf_(a0[1]) * b0[1]);
                w.y = cvt_pk_bf16(a0[2] * sigmoidf_(a0[2]) * b0[2], a0[3] * sigmoidf_(a0[3]) * b0[3]);
                w.z = cvt_pk_bf16(a1[0] * sigmoidf_(a1[0]) * b1[0], a1[1] * sigmoidf_(a1[1]) * b1[1]);
                w.w = cvt_pk_bf16(a1[2] * sigmoidf_(a1[2]) * b1[2], a1[3] * sigmoidf_(a1[3]) * b1[3]);
                *(u32x4*)(O + r * ldc + col0) = w; }
    }
};
struct EpiResid {
    static constexpr bool PERM = false, AFTER_DRAIN = false;
    const float* R; float* C; int ldc;
    __device__ __forceinline__ void operator()(const f32x4 (&acc)[2][2][4][2], const Unit& u, int wr, int wc, int fr, int fq) const {
        const int row0 = u.pm * BM + wr * 64 + fr, col0 = u.pn * BM + wc * 32 + 4 * fq;
#pragma unroll
        for (int ai = 0; ai < 2; ++ai)
#pragma unroll
            for (int m = 0; m < 4; ++m) { const size_t off = (size_t)(row0 + ai * HALF + m * 16) * ldc + col0;
#pragma unroll
                for (int bj = 0; bj < 2; ++bj)
#pragma unroll
                    for (int n = 0; n < 2; ++n) { const f32x4 rv = *(const f32x4*)(R + off + bj * HALF + n * 16); *(f32x4*)(C + off + bj * HALF + n * 16) = acc[ai][bj][m][n] + rv; }
                asm volatile("" ::: "memory"); }
    }
};

template <class Epi, class Sched, bool ALIGN_EPI = false, bool SP2 = false>
__device__ __forceinline__ void gemm_phase(PG8_LAS unsigned char* lds, const int tid, const Gemm g, const Sched& S, const Epi& E) {
    const int wid = __builtin_amdgcn_readfirstlane(tid >> 6), lane = tid & 63, wr = wid >> 2, wc = wid & 3, fr = lane & 15, fq = lane >> 4;
    const int K = g.K, nt = K / BK, lda = g.lda;
    unsigned voffA[2], voffB[2];
#pragma unroll
    for (int i = 0; i < 2; ++i) { int R, C; stage_rc(tid * 16 + i * 8192, R, C); const int Rb = Epi::PERM ? ((R & ~31) + perm32(R & 31)) : R;
        voffA[i] = (unsigned)(R * lda + C) * 2u; voffB[i] = (unsigned)(Rb * K + C) * 2u; }
    const size_t kstep = (size_t)(BK * 2);
    const size_t hA = (size_t)HALF * lda * 2, hB = (size_t)HALF * K * 2;
    const size_t tA = 2 * hA, tB = 2 * hB;
    const unsigned ldsw = (unsigned)wid * 1024u;
    const int aoff = lds_byte(wr * 64 + fr, fq * 8), boff = lds_byte(wc * 32 + fr, fq * 8);
#define PG8_SA(b, h) (((b) * 2 + (h)) * HTB)
#define PG8_SB(b, h) ((4 + (b) * 2 + (h)) * HTB)
#define PG8_STAGE(bufoff, gbase, voff) do { _Pragma("unroll") for (int _i = 0; _i < 2; ++_i) \
        __builtin_amdgcn_global_load_lds((const unsigned*)((const char*)(gbase) + (voff)[_i]), (PG8_LAS unsigned*)(lds + (bufoff) + ldsw + _i * 8192), 16, 0, 0); } while (0)
#define PG8_LDA(dst, b, h) do { _Pragma("unroll") for (int m = 0; m < 4; ++m) _Pragma("unroll") for (int k = 0; k < 2; ++k) dst[m][k] = *(const PG8_LAS bf16x8*)(lds + PG8_SA(b, h) + aoff + m * 2048 + k * 1024); } while (0)
#define PG8_LDB(dst, b, h) do { _Pragma("unroll") for (int n = 0; n < 2; ++n) _Pragma("unroll") for (int k = 0; k < 2; ++k) dst[n][k] = *(const PG8_LAS bf16x8*)(lds + PG8_SB(b, h) + boff + n * 2048 + k * 1024); } while (0)
#define PG8_MMA(ai, bj, At, Bt) do { __builtin_amdgcn_s_setprio(1); _Pragma("unroll") for (int m = 0; m < 4; ++m) _Pragma("unroll") for (int n = 0; n < 2; ++n) _Pragma("unroll") for (int k = 0; k < 2; ++k) \
        acc[ai][bj][m][n] = __builtin_amdgcn_mfma_f32_16x16x32_bf16(Bt[n][k], At[m][k], acc[ai][bj][m][n], 0, 0, 0); __builtin_amdgcn_s_setprio(0); } while (0)
#define PG8_WAIT_V(n) asm volatile("s_waitcnt vmcnt(" #n ")" ::: "memory")
#define PG8_WAIT_L(n) asm volatile("s_waitcnt lgkmcnt(" #n ")" ::: "memory")
#define PG8_BAR __builtin_amdgcn_s_barrier()
#define PG8_SCHED __builtin_amdgcn_sched_barrier(0)
    Unit cur, nxt; int ui = 0;
    if (!S.next(0, cur)) return;
    f32x4 acc[2][2][4][2];
#pragma unroll
    for (int a = 0; a < 2; ++a)
#pragma unroll
        for (int b = 0; b < 2; ++b)
#pragma unroll
            for (int m = 0; m < 4; ++m)
#pragma unroll
                for (int n = 0; n < 2; ++n) acc[a][b][m][n] = (f32x4){0.f, 0.f, 0.f, 0.f};
    bf16x8 At[4][2], B0[2][2], B1[2][2];
    const char* cA = (const char*)g.A + (size_t)cur.pm * tA; const char* cB = (const char*)g.Bt + (size_t)cur.pn * tB;
    S.a_ready(cur);
    if constexpr (SP2) {
        PG8_STAGE(PG8_SB(0, 0), cB, voffB); PG8_STAGE(PG8_SB(0, 1), cB + hB, voffB); PG8_STAGE(PG8_SA(0, 0), cA, voffA); PG8_STAGE(PG8_SA(0, 1), cA + hA, voffA);
        if (wr == 1) PG8_BAR;
        PG8_WAIT_V(2); PG8_BAR;
        PG8_STAGE(PG8_SB(1, 0), cB + kstep, voffB); PG8_STAGE(PG8_SA(1, 0), cA + kstep, voffA); PG8_STAGE(PG8_SB(1, 1), cB + hB + kstep, voffB);
        PG8_WAIT_V(6); PG8_BAR;
    } else {
        PG8_STAGE(PG8_SB(0, 0), cB, voffB); PG8_STAGE(PG8_SA(0, 0), cA, voffA); PG8_STAGE(PG8_SB(0, 1), cB + hB, voffB); PG8_STAGE(PG8_SA(0, 1), cA + hA, voffA);
        if (wr == 1) PG8_BAR;
        PG8_WAIT_V(4); PG8_BAR;
        PG8_STAGE(PG8_SB(1, 0), cB + kstep, voffB); PG8_STAGE(PG8_SA(1, 0), cA + kstep, voffA); PG8_STAGE(PG8_SB(1, 1), cB + hB + kstep, voffB);
        PG8_WAIT_V(6); PG8_BAR;
    }
    for (;;) {
        const bool has_next = S.next(ui + 1, nxt);
        const char* nA = has_next ? (const char*)g.A + (size_t)nxt.pm * tA : cA; const char* nB = has_next ? (const char*)g.Bt + (size_t)nxt.pn * tB : cB;
        for (int t = 0; t < nt; t += 2) {
            const bool last = (t == nt - 2);
            const char* a1 = cA + (size_t)(t + 1) * kstep;
            const char* a2 = last ? nA : cA + (size_t)(t + 2) * kstep; const char* b2 = last ? nB : cB + (size_t)(t + 2) * kstep;
            const char* a3 = a2 + kstep; const char* b3 = b2 + kstep;
            if (last && has_next) S.a_ready(nxt);
            if constexpr (SP2) {
            PG8_LDB(B0, 0, 0); PG8_LDB(B1, 0, 1); PG8_SCHED; PG8_LDA(At, 0, 0); PG8_STAGE(PG8_SA(1, 1), a1 + hA, voffA);
            PG8_WAIT_V(8); PG8_WAIT_L(0); PG8_BAR; PG8_MMA(0, 0, At, B0); PG8_MMA(0, 1, At, B1); PG8_BAR; PG8_SCHED;
            PG8_LDA(At, 0, 1); PG8_STAGE(PG8_SB(0, 0), b2, voffB); PG8_STAGE(PG8_SB(0, 1), b2 + hB, voffB); PG8_STAGE(PG8_SA(0, 0), a2, voffA);
            PG8_WAIT_V(8); PG8_WAIT_L(0); PG8_BAR; PG8_MMA(1, 0, At, B0); PG8_MMA(1, 1, At, B1); PG8_BAR; PG8_SCHED;
            PG8_LDB(B0, 1, 0); PG8_LDB(B1, 1, 1); PG8_SCHED; PG8_LDA(At, 1, 0); PG8_STAGE(PG8_SA(0, 1), a2 + hA, voffA);
            PG8_WAIT_V(8); PG8_WAIT_L(0); PG8_BAR; PG8_MMA(0, 0, At, B0); PG8_MMA(0, 1, At, B1); PG8_BAR; PG8_SCHED;
            PG8_LDA(At, 1, 1); PG8_STAGE(PG8_SB(1, 0), b3, voffB); PG8_STAGE(PG8_SB(1, 1), b3 + hB, voffB); PG8_STAGE(PG8_SA(1, 0), a3, voffA);
            PG8_WAIT_V(8); PG8_WAIT_L(0); PG8_BAR; PG8_MMA(1, 0, At, B0); PG8_MMA(1, 1, At, B1); PG8_BAR; PG8_SCHED;
            } else {
            PG8_LDB(B0, 0, 0); PG8_SCHED; PG8_LDA(At, 0, 0); PG8_STAGE(PG8_SA(1, 1), a1 + hA, voffA);
            PG8_WAIT_L(8); PG8_BAR; PG8_WAIT_L(0); PG8_MMA(0, 0, At, B0); PG8_BAR; PG8_SCHED;
            PG8_LDB(B1, 0, 1); PG8_STAGE(PG8_SB(0, 0), b2, voffB);
            PG8_BAR; PG8_WAIT_L(0); PG8_MMA(0, 1, At, B1); PG8_BAR;
            PG8_LDA(At, 0, 1); PG8_STAGE(PG8_SA(0, 0), a2, voffA);
            PG8_BAR; PG8_WAIT_L(0); PG8_MMA(1, 0, At, B0); PG8_BAR; PG8_SCHED;
            PG8_STAGE(PG8_SB(0, 1), b2 + hB, voffB);
            PG8_WAIT_V(6); PG8_BAR; PG8_MMA(1, 1, At, B1); PG8_BAR;
            PG8_LDB(B0, 1, 0); PG8_SCHED; PG8_LDA(At, 1, 0); PG8_STAGE(PG8_SA(0, 1), a2 + hA, voffA);
            PG8_WAIT_L(8); PG8_BAR; PG8_WAIT_L(0); PG8_MMA(0, 0, At, B0); PG8_BAR; PG8_SCHED;
            PG8_LDB(B1, 1, 1); PG8_STAGE(PG8_SB(1, 0), b3, voffB);
            PG8_BAR; PG8_WAIT_L(0); PG8_MMA(0, 1, At, B1); PG8_BAR;
            PG8_LDA(At, 1, 1); PG8_STAGE(PG8_SA(1, 0), a3, voffA);
            PG8_BAR; PG8_WAIT_L(0); PG8_MMA(1, 0, At, B0); PG8_BAR; PG8_SCHED;
            PG8_STAGE(PG8_SB(1, 1), b3 + hB, voffB);
            PG8_WAIT_V(6); PG8_BAR; PG8_MMA(1, 1, At, B1); PG8_BAR;
            }
        }
        if constexpr (ALIGN_EPI) { if (wr == 0) PG8_BAR; }
        if constexpr (!Epi::AFTER_DRAIN) { E(acc, cur, wr, wc, fr, fq); S.done(cur); }
        if (!has_next) break;
#pragma unroll
        for (int a = 0; a < 2; ++a)
#pragma unroll
            for (int b = 0; b < 2; ++b)
#pragma unroll
                for (int m = 0; m < 4; ++m)
#pragma unroll
                    for (int n = 0; n < 2; ++n) acc[a][b][m][n] = (f32x4){0.f, 0.f, 0.f, 0.f};
        cur = nxt; cA = nA; cB = nB; ++ui;
        if constexpr (ALIGN_EPI) { if (wr == 1) PG8_BAR; }
    }
    PG8_WAIT_V(0);
    if constexpr (!ALIGN_EPI) { if (wr == 0) PG8_BAR; }
    PG8_BAR;
#undef PG8_SA
#undef PG8_SB
#undef PG8_STAGE
#undef PG8_LDA
#undef PG8_LDB
#undef PG8_MMA
#undef PG8_WAIT_V
#undef PG8_WAIT_L
#undef PG8_BAR
#undef PG8_SCHED
}
}

typedef unsigned short bf16;
typedef short bf16x8 __attribute__((ext_vector_type(8)));
typedef float f32x4 __attribute__((ext_vector_type(4)));
typedef unsigned u32x4 __attribute__((ext_vector_type(4)));
typedef unsigned u32x2 __attribute__((ext_vector_type(2)));
#define LAS __attribute__((address_space(3)))

constexpr int NWAVES = 8, NTHR = 512;
constexpr int DM = 1024, SEQ = 8192, MTOK = 16384, DEPTH = 4;
constexpr int INC = 7168, DFF = 2816, AW = 512;
constexpr int COL_Q = 0, COL_K = 1536, COL_V = 3072, COL_U = 4608, COL_GA = 5120, COL_GS = 6144;
constexpr int TC = 32, NCH = MTOK / TC  , CHB = SEQ / TC  ;
constexpr float EPS = 1e-6f;

constexpr size_t OFF_IN = 0, OFF_P = 7340032, OFF_GLU = 7864320, OFF_OUT = 8912896, OFF_GU = 9961472, OFF_DN = 15728640, LAYER_W = 18612224;
constexpr size_t MiB = 1u << 20;
constexpr size_t WS_WB = 1 * MiB, WS_Z = 143 * MiB, WS_ACT = 367 * MiB, WS_Y = 399 * MiB, WS_LSE = 415 * MiB, WS_KT = 417 * MiB, WS_E = 418 * MiB, WS_P = 422 * MiB,
                 WS_AT = 426 * MiB, WS_S = 427 * MiB, WS_XP = 435 * MiB, WS_END = 439 * MiB;
static_assert(WS_WB + 4 * LAYER_W * 2 <= WS_Z && WS_Z + (size_t)MTOK * INC * 2 <= WS_ACT, "ws map");
constexpr int LDS_BYTES = 147456;

struct Args { const float* in[21]; float* out; unsigned char* ws; int ph_lo, ph_hi; };

__device__ __forceinline__ unsigned f2bf(float f) { unsigned u = __float_as_uint(f); return (u + 0x7fffu + ((u >> 16) & 1u)) >> 16; }
__device__ __forceinline__ unsigned pk2(float lo, float hi) { return f2bf(lo) | (f2bf(hi) << 16); }
__device__ __forceinline__ float bflo(unsigned w) { return __uint_as_float(w << 16); }
__device__ __forceinline__ float bfhi(unsigned w) { return __uint_as_float(w & 0xffff0000u); }
__device__ __forceinline__ float wave_sum(float v) {
#pragma unroll
    for (int o = 1; o < 64; o <<= 1) v += __shfl_xor(v, o);
    return v;
}

__device__ __forceinline__ void transpose_item(const float* W, int K, int N, bf16* WT, int il_off, float* scr, int item, int lane) {
    const int nblk = N / 32, kb = item / nblk, nb = item % nblk, k0 = 64 * kb, n0 = 32 * nb;
#pragma unroll 8
    for (int i = 0; i < 32; ++i) { const int kk = 2 * i + (lane >> 5); scr[kk * 33 + (lane & 31)] = W[(size_t)(k0 + kk) * N + n0 + (lane & 31)]; }
    __builtin_amdgcn_s_waitcnt(0xc07f); asm volatile("" ::: "memory");
    const int drow = (il_off < 0) ? n0 : (n0 / 128) * 256 + il_off + (n0 % 128);
    const int c = lane & 7;
#pragma unroll
    for (int j = 0; j < 4; ++j) { const int n = (lane >> 3) + 8 * j; const float* s = scr + (8 * c) * 33 + n;
        u32x4 o; o.x = pk2(s[0 * 33], s[1 * 33]); o.y = pk2(s[2 * 33], s[3 * 33]); o.z = pk2(s[4 * 33], s[5 * 33]); o.w = pk2(s[6 * 33], s[7 * 33]);
        *(u32x4*)(WT + (size_t)(drow + n) * K + k0 + 8 * c) = o; }
    __builtin_amdgcn_s_waitcnt(0xc07f); asm volatile("" ::: "memory");
}
__device__ __forceinline__ void phase_weights(const Args& a, int zero, bf16* WB, float* ldsf, int gw, int ngw, int wave, int lane) {
    float* scr = ldsf + wave * 4096;
    constexpr int PER_LAYER = 9088;
    for (int it = gw; it < DEPTH * PER_LAYER; it += ngw) {
        const int l = it / PER_LAYER; int r = it % PER_LAYER; bf16* wl = WB + (size_t)l * LAYER_W;
        if (r < 3584) { transpose_item(a.in[2 + zero] + (size_t)l * DM * INC, DM, INC, wl + OFF_IN, -1, scr, r, lane); continue; } r -= 3584;
        if (r < 256) { transpose_item(a.in[5 + zero] + (size_t)l * AW * DM, AW, DM, wl + OFF_P, -1, scr, r, lane); continue; } r -= 256;
        if (r < 256) { transpose_item(a.in[14 + zero] + (size_t)l * AW * DM, AW, DM, wl + OFF_GLU, 0, scr, r, lane); continue; } r -= 256;
        if (r < 256) { transpose_item(a.in[15 + zero] + (size_t)l * AW * DM, AW, DM, wl + OFF_GLU, 128, scr, r, lane); continue; } r -= 256;
        if (r < 512) { transpose_item(a.in[16 + zero] + (size_t)l * DM * DM, DM, DM, wl + OFF_OUT, -1, scr, r, lane); continue; } r -= 512;
        if (r < 1408) { transpose_item(a.in[18 + zero] + (size_t)l * DM * DFF, DM, DFF, wl + OFF_GU, 0, scr, r, lane); continue; } r -= 1408;
        if (r < 1408) { transpose_item(a.in[19 + zero] + (size_t)l * DM * DFF, DM, DFF, wl + OFF_GU, 128, scr, r, lane); continue; } r -= 1408;
        transpose_item(a.in[20 + zero] + (size_t)l * DFF * DM, DFF, DM, wl + OFF_DN, -1, scr, r, lane);
    }
}

__device__ __forceinline__ void phase_rmsnorm(const float* x, const float* g, bf16* out, int gw, int ngw, int lane) {
    f32x4 gv[4];
#pragma unroll
    for (int j = 0; j < 4; ++j) gv[j] = ((const f32x4*)g)[lane + 64 * j];
    for (int m = gw; m < MTOK; m += ngw) {
        const f32x4* xr = (const f32x4*)(x + (size_t)m * DM) + lane;
        f32x4 v[4]; float s = 0.f;
#pragma unroll
        for (int j = 0; j < 4; ++j) { v[j] = xr[64 * j]; s += (v[j].x * v[j].x + v[j].y * v[j].y) + (v[j].z * v[j].z + v[j].w * v[j].w); }
        const float rstd = 1.0f / sqrtf(wave_sum(s) * (1.f / DM) + EPS);
        u32x2* o8 = (u32x2*)(out + (size_t)m * DM) + lane;
#pragma unroll
        for (int j = 0; j < 4; ++j) { u32x2 w; w.x = pk2(v[j].x * rstd * gv[j].x, v[j].y * rstd * gv[j].y); w.y = pk2(v[j].z * rstd * gv[j].z, v[j].w * rstd * gv[j].w); o8[64 * j] = w; }
    }
}

__device__ __forceinline__ void ssm_pre_item(const Args& a, int zero, int l, int g, unsigned char* ws, float* L, int tid) {
    float* pw = L; float* bb = L + 4224; float* cc = L + 6272; float* lrdt = L + 8320; double* angd = (double*)(L + 8448);
    const float* lam_re = a.in[6 + zero] + (size_t)(l * 32 + g) * 64; const float* lam_im = a.in[7 + zero] + (size_t)(l * 32 + g) * 64;
    const float dt = expf(a.in[8 + zero][l * 32 + g]);
    const float* b_re = a.in[9 + zero] + (size_t)(l * 32 + g) * 1024; const float* b_im = a.in[10 + zero] + (size_t)(l * 32 + g) * 1024;
    const float* c_re = a.in[11 + zero] + (size_t)(l * 32 + g) * 1024; const float* c_im = a.in[12 + zero] + (size_t)(l * 32 + g) * 1024;
    if (tid < 64) {
        const int p = tid; const float lr = lam_re[p], li = lam_im[p];
        const double angle = (double)li * (double)dt; const float lrd = lr * dt;
        lrdt[p] = lrd; angd[p] = angle;
        const double TWO_PI = 6.283185307179586476925; double rr = angle - TWO_PI * rint(angle / TWO_PI);
        float sn, cs; sincosf((float)rr, &sn, &cs); const float mag = expf(lrd);
        const float are = mag * cs, aim = mag * sn, nr = are - 1.0f, ni = aim, den = lr * lr + li * li;
        const float cr = (nr * lr + ni * li) / den, ci = (ni * lr - nr * li) / den;
        for (int c = 0; c < 16; ++c) { const float br = b_re[p * 16 + c], bi = b_im[p * 16 + c]; bb[(p * 16 + c) * 2] = cr * br - ci * bi; bb[(p * 16 + c) * 2 + 1] = cr * bi + ci * br; }
    }
    for (int i = tid; i < 1024; i += NTHR) { cc[i * 2] = c_re[i]; cc[i * 2 + 1] = c_im[i]; }
    __syncthreads();
    for (int i = tid; i < 33 * 64; i += NTHR) { const int j = i >> 6, p = i & 63;
        const double TWO_PI = 6.283185307179586476925; const double angle = angd[p] * (double)j; const double rr = angle - TWO_PI * rint(angle / TWO_PI);
        float sn, cs; sincosf((float)rr, &sn, &cs); const float mag = expf(lrdt[p] * (float)j);
        pw[i * 2] = mag * cs; pw[i * 2 + 1] = mag * sn; }
    __syncthreads();
    bf16* KT = (bf16*)(ws + WS_KT) + (size_t)g * 32 * 256; bf16* E = (bf16*)(ws + WS_E) + (size_t)g * 128 * 512; bf16* P = (bf16*)(ws + WS_P) + (size_t)g * 512 * 128;
    float* AT = (float*)(ws + WS_AT) + g * 128;
    for (int i = tid; i < 32 * 256; i += NTHR) { const int j = i >> 8, c = (i >> 4) & 15, c2 = i & 15; float s = 0.f;
        for (int p = 0; p < 64; ++p) { const float Cr = cc[(c * 64 + p) * 2], Ci = cc[(c * 64 + p) * 2 + 1], wr_ = pw[(j * 64 + p) * 2], wi_ = pw[(j * 64 + p) * 2 + 1];
            const float tr = Cr * wr_ - Ci * wi_, ti = Cr * wi_ + Ci * wr_; s += tr * bb[(p * 16 + c2) * 2] - ti * bb[(p * 16 + c2) * 2 + 1]; }
        KT[i] = (bf16)f2bf(s); }
    for (int i = tid; i < 128 * 512; i += NTHR) { const int row = i >> 9, kidx = i & 511, p = row & 63, s = kidx >> 4, c2 = kidx & 15, j = 31 - s;
        const float wr_ = pw[(j * 64 + p) * 2], wi_ = pw[(j * 64 + p) * 2 + 1], br = bb[(p * 16 + c2) * 2], bi = bb[(p * 16 + c2) * 2 + 1];
        E[i] = (bf16)f2bf((row < 64) ? (wr_ * br - wi_ * bi) : (wr_ * bi + wi_ * br)); }
    for (int i = tid; i < 512 * 128; i += NTHR) { const int row = i >> 7, q = i & 127, p = q & 63, t = row >> 4, c = row & 15, j = t + 1;
        const float Cr = cc[(c * 64 + p) * 2], Ci = cc[(c * 64 + p) * 2 + 1], wr_ = pw[(j * 64 + p) * 2], wi_ = pw[(j * 64 + p) * 2 + 1];
        P[i] = (bf16)f2bf((q < 64) ? (Cr * wr_ - Ci * wi_) : -(Cr * wi_ + Ci * wr_)); }
    if (tid < 64) { AT[tid] = pw[(32 * 64 + tid) * 2]; AT[64 + tid] = pw[(32 * 64 + tid) * 2 + 1]; }
    __syncthreads();
}

constexpr int QP = 72, VP = 272;
constexpr int LQ_OFF = 0, LK_OFF = 128 * QP * 2, LV_OFF = LK_OFF + 256 * QP * 2;
__device__ __forceinline__ void attn_item(int item, const float* gq, const float* gk, bf16* Z, float* LSE, unsigned char* lds, int tid) {
    int it = item; const int rn = it & 63; it >>= 6; const int h = it & 7; it >>= 3; const int gi = it % 3; const int b = it / 3;
    const int dsh = 2 * gi, d = 1 << dsh, nbsh = 6 - dsh;
    const int r = rn >> nbsh, n = rn & ((1 << nbsh) - 1);
    bf16* Qs = (bf16*)(lds + LQ_OFF); bf16* Ks = (bf16*)(lds + LK_OFF); bf16* Vt = (bf16*)(lds + LV_OFF);
    const int chunk = tid & 7, rowi = tid >> 3;
    const size_t rowbase = (size_t)b * SEQ;
    const int hc = gi * 512 + h * 64 + chunk * 8;
    u32x4 qv[2], kv[4], vv[4];
#pragma unroll
    for (int rd = 0; rd < 2; ++rd) { const int row = rowi + 64 * rd; const int tok = ((128 * n + row) << dsh) + r; qv[rd] = *(const u32x4*)(Z + (rowbase + tok) * INC + COL_Q + hc); }
#pragma unroll
    for (int rd = 0; rd < 4; ++rd) { const int ki = rowi + 64 * rd; const int mp = 128 * (n - 1) + ki;
        if (mp >= 0) { const int tok = (mp << dsh) + r; const bf16* p = Z + (rowbase + tok) * INC + hc; kv[rd] = *(const u32x4*)(p + COL_K); vv[rd] = *(const u32x4*)(p + COL_V); }
        else { kv[rd] = (u32x4){0u, 0u, 0u, 0u}; vv[rd] = (u32x4){0u, 0u, 0u, 0u}; } }
    float gqv[8], gkv[8];
#pragma unroll
    for (int i = 0; i < 8; ++i) { gqv[i] = gq[chunk * 8 + i] * 0.125f; gkv[i] = gk[chunk * 8 + i]; }
#pragma unroll
    for (int rd = 0; rd < 2; ++rd) { float f[8]; f[0] = bflo(qv[rd].x); f[1] = bfhi(qv[rd].x); f[2] = bflo(qv[rd].y); f[3] = bfhi(qv[rd].y); f[4] = bflo(qv[rd].z); f[5] = bfhi(qv[rd].z); f[6] = bflo(qv[rd].w); f[7] = bfhi(qv[rd].w);
        float ss = 0.f;
#pragma unroll
        for (int i = 0; i < 8; ++i) ss += f[i] * f[i];
        ss += __shfl_xor(ss, 1); ss += __shfl_xor(ss, 2); ss += __shfl_xor(ss, 4);
        const float rs = 1.0f / sqrtf(ss * (1.f / 64.f) + EPS);
        u32x4 w; w.x = pk2(f[0] * rs * gqv[0], f[1] * rs * gqv[1]); w.y = pk2(f[2] * rs * gqv[2], f[3] * rs * gqv[3]); w.z = pk2(f[4] * rs * gqv[4], f[5] * rs * gqv[5]); w.w = pk2(f[6] * rs * gqv[6], f[7] * rs * gqv[7]);
        *(u32x4*)(Qs + (rowi + 64 * rd) * QP + chunk * 8) = w; }
#pragma unroll
    for (int rd = 0; rd < 4; ++rd) { float f[8]; f[0] = bflo(kv[rd].x); f[1] = bfhi(kv[rd].x); f[2] = bflo(kv[rd].y); f[3] = bfhi(kv[rd].y); f[4] = bflo(kv[rd].z); f[5] = bfhi(kv[rd].z); f[6] = bflo(kv[rd].w); f[7] = bfhi(kv[rd].w);
        float ss = 0.f;
#pragma unroll
        for (int i = 0; i < 8; ++i) ss += f[i] * f[i];
        ss += __shfl_xor(ss, 1); ss += __shfl_xor(ss, 2); ss += __shfl_xor(ss, 4);
        const float rs = 1.0f / sqrtf(ss * (1.f / 64.f) + EPS);
        u32x4 w; w.x = pk2(f[0] * rs * gkv[0], f[1] * rs * gkv[1]); w.y = pk2(f[2] * rs * gkv[2], f[3] * rs * gkv[3]); w.z = pk2(f[4] * rs * gkv[4], f[5] * rs * gkv[5]); w.w = pk2(f[6] * rs * gkv[6], f[7] * rs * gkv[7]);
        const int ki = rowi + 64 * rd;
        *(u32x4*)(Ks + ki * QP + chunk * 8) = w;
        bf16* vp = Vt + (chunk * 8) * VP + ki;
        vp[0 * VP] = (bf16)(vv[rd].x & 0xffffu); vp[1 * VP] = (bf16)(vv[rd].x >> 16); vp[2 * VP] = (bf16)(vv[rd].y & 0xffffu); vp[3 * VP] = (bf16)(vv[rd].y >> 16);
        vp[4 * VP] = (bf16)(vv[rd].z & 0xffffu); vp[5 * VP] = (bf16)(vv[rd].z >> 16); vp[6 * VP] = (bf16)(vv[rd].w & 0xffffu); vp[7 * VP] = (bf16)(vv[rd].w >> 16); }
    __syncthreads();
    {
        const int w = tid >> 6, lane = tid & 63, fr = lane & 15, fq = lane >> 4, kt0 = w & ~1;
        bf16x8 qf[2];
#pragma unroll
        for (int kk = 0; kk < 2; ++kk) qf[kk] = *(const bf16x8*)(Qs + (16 * w + fr) * QP + 32 * kk + 8 * fq);
        f32x4 s[10];
#pragma unroll
        for (int t = 0; t < 10; ++t) { s[t] = (f32x4){0.f, 0.f, 0.f, 0.f};
#pragma unroll
            for (int kk = 0; kk < 2; ++kk) { const bf16x8 kf = *(const bf16x8*)(Ks + (16 * (kt0 + t) + fr) * QP + 32 * kk + 8 * fq); s[t] = __builtin_amdgcn_mfma_f32_16x16x32_bf16(kf, qf[kk], s[t], 0, 0, 0); } }
        const int qi = 16 * w + fr; float mx = -INFINITY;
        const int dbase = 16 * (kt0 - w) + 4 * fq - fr, kbase = 16 * kt0 + 4 * fq - ((n > 0) ? 0 : 128);
#pragma unroll
        for (int t = 0; t < 10; ++t)
#pragma unroll
            for (int j = 0; j < 4; ++j) { const int dlt = dbase + 16 * t + j; const int bad = (dlt | (128 - dlt) | (kbase + 16 * t + j)) >> 31;
                s[t][j] += __int_as_float(bad & (int)0xff800000); mx = fmaxf(mx, s[t][j]); }
        mx = fmaxf(mx, __shfl_xor(mx, 16)); mx = fmaxf(mx, __shfl_xor(mx, 32));
        float sum = 0.f;
#pragma unroll
        for (int t = 0; t < 10; ++t)
#pragma unroll
            for (int j = 0; j < 4; ++j) { const float p = __builtin_amdgcn_exp2f((s[t][j] - mx) * 1.44269504089f); s[t][j] = p; sum += p; }
        sum += __shfl_xor(sum, 16); sum += __shfl_xor(sum, 32);
        f32x4 o[4];
#pragma unroll
        for (int dt = 0; dt < 4; ++dt) o[dt] = (f32x4){0.f, 0.f, 0.f, 0.f};
#pragma unroll
        for (int jj = 0; jj < 5; ++jj) {
            u32x4 pw; pw.x = pk2(s[2 * jj][0], s[2 * jj][1]); pw.y = pk2(s[2 * jj][2], s[2 * jj][3]); pw.z = pk2(s[2 * jj + 1][0], s[2 * jj + 1][1]); pw.w = pk2(s[2 * jj + 1][2], s[2 * jj + 1][3]);
            const bf16x8 pf = __builtin_bit_cast(bf16x8, pw);
#pragma unroll
            for (int dt = 0; dt < 4; ++dt) { const bf16* vp = Vt + (16 * dt + fr) * VP + 32 * (kt0 / 2 + jj) + 4 * fq;
                const u32x2 lo = *(const u32x2*)vp, hi = *(const u32x2*)(vp + 16); u32x4 vw; vw.x = lo.x; vw.y = lo.y; vw.z = hi.x; vw.w = hi.y;
                o[dt] = __builtin_amdgcn_mfma_f32_16x16x32_bf16(__builtin_bit_cast(bf16x8, vw), pf, o[dt], 0, 0, 0); } }
        const float inv = 1.0f / sum;
        const int tokq = ((128 * n + qi) << dsh) + r; const size_t row = rowbase + tokq;
        bf16* op = Z + row * INC + COL_Q + gi * 512 + h * 64 + 4 * fq;
#pragma unroll
        for (int dt = 0; dt < 4; ++dt) { u32x2 w2; w2.x = pk2(o[dt][0] * inv, o[dt][1] * inv); w2.y = pk2(o[dt][2] * inv, o[dt][3] * inv); *(u32x2*)(op + 16 * dt) = w2; }
        if (fq == 0) LSE[((size_t)gi * MTOK + row) * 8 + h] = mx + logf(sum);
    }
    __syncthreads();
}

__device__ __forceinline__ void ssm_s1_item(int item, const bf16* Z, unsigned char* ws, int tid) {
    const int g = item >> 3, mt = item & 7, w = tid >> 6, lane = tid & 63, fr = lane & 15, fq = lane >> 4, sub = w & 3, nh = w >> 2;
    const int chunk = 64 * mt + 16 * sub + fr;
    const bf16* E = (const bf16*)(ws + WS_E) + (size_t)g * 128 * 512; float* S = (float*)(ws + WS_S);
    const bf16* up = Z + ((size_t)chunk * TC + (fq >> 1)) * INC + COL_U + 16 * g + 8 * (fq & 1);
    const bf16* ep = E + (size_t)(64 * nh + fr) * 512 + 8 * fq;
    f32x4 acc[4];
#pragma unroll
    for (int nt = 0; nt < 4; ++nt) acc[nt] = (f32x4){0.f, 0.f, 0.f, 0.f};
#pragma unroll 4
    for (int ks = 0; ks < 16; ++ks) {
        const bf16x8 uf = *(const bf16x8*)(up + (size_t)(2 * ks) * INC);
#pragma unroll
        for (int nt = 0; nt < 4; ++nt) { const bf16x8 ef = *(const bf16x8*)(ep + (size_t)(16 * nt) * 512 + 32 * ks); acc[nt] = __builtin_amdgcn_mfma_f32_16x16x32_bf16(ef, uf, acc[nt], 0, 0, 0); }
    }
#pragma unroll
    for (int nt = 0; nt < 4; ++nt) *(f32x4*)(S + ((size_t)chunk * 32 + g) * 128 + 64 * nh + 16 * nt + 4 * fq) = acc[nt];
}

__device__ __forceinline__ void ssm_carry_item(int item, unsigned char* ws, float* L, int tid) {
    const int b = item >> 5, g = item & 31;
    const float* S = (const float*)(ws + WS_S); bf16* XP = (bf16*)(ws + WS_XP); const float* AT = (const float*)(ws + WS_AT) + g * 128;
#pragma unroll 4
    for (int i = 0; i < 16; ++i) { const int idx = i * NTHR + tid, k = idx >> 5, q4 = idx & 31;
        *(f32x4*)(L + k * 128 + 4 * q4) = *(const f32x4*)(S + ((size_t)(b * CHB + k) * 32 + g) * 128 + 4 * q4); }
    __syncthreads();
    if (tid < 64) {
        const int p = tid; const float ar = AT[p], ai = AT[64 + p]; float xr = 0.f, xi = 0.f;
        bf16* xo = XP + ((size_t)(b * CHB) * 32 + g) * 128 + p;
#pragma unroll 8
        for (int k = 0; k < CHB; ++k) {
            xo[(size_t)k * 32 * 128] = (bf16)f2bf(xr); xo[(size_t)k * 32 * 128 + 64] = (bf16)f2bf(xi);
            const float sr = L[k * 128 + p], si = L[k * 128 + 64 + p];
            const float nr = ar * xr - ai * xi + sr, ni = ar * xi + ai * xr + si; xr = nr; xi = ni;
        }
    }
    __syncthreads();
}

__device__ __forceinline__ void phase_merge(bf16* Z, const float* LSE, int vt, int nvt) {
    for (int i = vt; i < MTOK * 64; i += nvt) { const int row = i >> 6, h = (i >> 3) & 7, ch = i & 7;
        const float l0 = LSE[((size_t)0 * MTOK + row) * 8 + h], l1 = LSE[((size_t)1 * MTOK + row) * 8 + h], l2 = LSE[((size_t)2 * MTOK + row) * 8 + h];
        const float mx = fmaxf(l0, fmaxf(l1, l2)); float w0 = expf(l0 - mx), w1 = expf(l1 - mx), w2 = expf(l2 - mx); const float inv = 1.0f / (w0 + w1 + w2); w0 *= inv; w1 *= inv; w2 *= inv;
        bf16* p = Z + (size_t)row * INC + h * 64 + ch * 8;
        const u32x4 a0 = *(const u32x4*)p, a1 = *(const u32x4*)(p + 512), a2 = *(const u32x4*)(p + 1024);
        u32x4 o;
        o.x = pk2(w0 * bflo(a0.x) + w1 * bflo(a1.x) + w2 * bflo(a2.x), w0 * bfhi(a0.x) + w1 * bfhi(a1.x) + w2 * bfhi(a2.x));
        o.y = pk2(w0 * bflo(a0.y) + w1 * bflo(a1.y) + w2 * bflo(a2.y), w0 * bfhi(a0.y) + w1 * bfhi(a1.y) + w2 * bfhi(a2.y));
        o.z = pk2(w0 * bflo(a0.z) + w1 * bflo(a1.z) + w2 * bflo(a2.z), w0 * bfhi(a0.z) + w1 * bfhi(a1.z) + w2 * bfhi(a2.z));
        o.w = pk2(w0 * bflo(a0.w) + w1 * bflo(a1.w) + w2 * bflo(a2.w), w0 * bfhi(a0.w) + w1 * bfhi(a1.w) + w2 * bfhi(a2.w));
        *(u32x4*)p = o; }
}

__device__ __forceinline__ float gelu_tanh(float y) { const float z = 1.5957691216f * (y + 0.044715f * y * y * y); return y * __builtin_amdgcn_rcpf(1.0f + __builtin_amdgcn_exp2f(-1.44269504089f * z)); }
__device__ __forceinline__ void ssm_s3_item(int item, const float* dskip, const bf16* Z, bf16* Y, unsigned char* ws, int tid) {
    const int g = item >> 3, mt = item & 7, w = tid >> 6, lane = tid & 63, fr = lane & 15, fq = lane >> 4;
    const bf16* KT = (const bf16*)(ws + WS_KT) + (size_t)g * 32 * 256; const bf16* P = (const bf16*)(ws + WS_P) + (size_t)g * 512 * 128; const bf16* XP = (const bf16*)(ws + WS_XP);
    const float* dsk = dskip + g * 16 + 4 * fq;
    const float d0 = dsk[0], d1 = dsk[1], d2 = dsk[2], d3 = dsk[3];
    const int chunk0 = 64 * mt + fr;
    const int shalf = fq >> 1, c20 = 8 * (fq & 1);
#pragma unroll 1
    for (int ti = 0; ti < 4; ++ti) {
        const int t = (ti == 0) ? w : (ti == 1) ? 15 - w : (ti == 2) ? 16 + w : 31 - w;
        f32x4 acc[4];
#pragma unroll
        for (int mi = 0; mi < 4; ++mi) acc[mi] = (f32x4){0.f, 0.f, 0.f, 0.f};
        const int nks = (t >> 1) + 1;
#pragma unroll 2
        for (int ks = 0; ks < nks; ++ks) {
            const int s = 2 * ks + shalf, lag = t - s;
            bf16x8 wf = (bf16x8){0, 0, 0, 0, 0, 0, 0, 0};
            if (lag >= 0) wf = *(const bf16x8*)(KT + (size_t)lag * 256 + fr * 16 + c20);
#pragma unroll
            for (int mi = 0; mi < 4; ++mi) { const bf16x8 uf = *(const bf16x8*)(Z + ((size_t)(chunk0 + 16 * mi) * TC + s) * INC + COL_U + 16 * g + c20);
                acc[mi] = __builtin_amdgcn_mfma_f32_16x16x32_bf16(wf, uf, acc[mi], 0, 0, 0); }
        }
#pragma unroll
        for (int k2 = 0; k2 < 4; ++k2) {
            const bf16x8 wf = *(const bf16x8*)(P + (size_t)(t * 16 + fr) * 128 + 32 * k2 + 8 * fq);
#pragma unroll
            for (int mi = 0; mi < 4; ++mi) { const bf16x8 xf = *(const bf16x8*)(XP + ((size_t)(chunk0 + 16 * mi) * 32 + g) * 128 + 32 * k2 + 8 * fq);
                acc[mi] = __builtin_amdgcn_mfma_f32_16x16x32_bf16(wf, xf, acc[mi], 0, 0, 0); }
        }
#pragma unroll
        for (int mi = 0; mi < 4; ++mi) { const size_t tok = (size_t)(chunk0 + 16 * mi) * TC + t;
            const u32x2 uu = *(const u32x2*)(Z + tok * INC + COL_U + 16 * g + 4 * fq);
            const float y0 = acc[mi][0] + d0 * bflo(uu.x), y1 = acc[mi][1] + d1 * bfhi(uu.x), y2 = acc[mi][2] + d2 * bflo(uu.y), y3 = acc[mi][3] + d3 * bfhi(uu.y);
            u32x2 o; o.x = pk2(gelu_tanh(y0), gelu_tanh(y1)); o.y = pk2(gelu_tanh(y2), gelu_tanh(y3));
            *(u32x2*)(Y + tok * AW + 16 * g + 4 * fq) = o; }
    }
}

constexpr int N_PHASES = 1 + 10 * DEPTH;
__global__ void __launch_bounds__(NTHR, 2) mega_fwd(Args a) {
    extern __shared__ __attribute__((aligned(16))) unsigned char lds[];
    cg::grid_group grid = cg::this_grid();
    LAS unsigned char* ldsl = (LAS unsigned char*)lds;
    for (int ph = a.ph_lo; ph < a.ph_hi; ++ph) {
        int zero; asm volatile("s_mov_b32 %0, 0" : "=s"(zero));
        int tid = threadIdx.x; asm volatile("" : "+v"(tid));
        const int lane = tid & 63, wave = __builtin_amdgcn_readfirstlane(tid >> 6);
        const int G = (int)gridDim.x + zero, bx = (int)blockIdx.x + zero;
        const int gw = bx * NWAVES + wave, ngw = G * NWAVES;
        unsigned char* ws = a.ws + zero; float* outp = a.out + zero;
        bf16* WB = (bf16*)(ws + WS_WB); bf16* Z = (bf16*)(ws + WS_Z); bf16* ACT = (bf16*)(ws + WS_ACT); bf16* Y = (bf16*)(ws + WS_Y); float* LSE = (float*)(ws + WS_LSE);
        if (ph == 0) {
            phase_weights(a, zero, WB, (float*)lds, gw, ngw, wave, lane);
        } else {
            const int l = (ph - 1) / 10, k = (ph - 1) % 10;
            const bf16* wl = WB + (size_t)l * LAYER_W;
            const float* xin = (l == 0) ? a.in[zero] : outp;
            if (k == 0) {
                for (int g = bx; g < 32; g += G) ssm_pre_item(a, zero, l, g, ws, (float*)lds, tid);
                phase_rmsnorm(xin, a.in[1 + zero] + l * DM, ACT, gw, ngw, lane);
            } else if (k == 1) {
                pg8::Gemm gm{ACT, wl + OFF_IN, MTOK, INC, DM, DM}; pg8::StaticOrder S; S.init(MTOK, INC, G, bx);
                pg8::EpiZ E{Z, INC, COL_GA / 256};
                pg8::gemm_phase<pg8::EpiZ, pg8::StaticOrder, true, true>(ldsl, tid, gm, S, E);
            } else if (k == 2) {
                const float* gq = a.in[3 + zero] + l * 64; const float* gk = a.in[4 + zero] + l * 64;
                for (int it = bx; it < 3072 + 256; it += G) {
                    if (it < 3072) attn_item(it, gq, gk, Z, LSE, lds, tid);
                    else ssm_s1_item(it - 3072, Z, ws, tid);
                }
            } else if (k == 3) {
                for (int it = bx; it < 64; it += G) ssm_carry_item(it, ws, (float*)lds, tid);
                if (G >= 128) { if (bx >= 64) phase_merge(Z, LSE, (bx - 64) * NTHR + tid, (G - 64) * NTHR); }
                else phase_merge(Z, LSE, bx * NTHR + tid, G * NTHR);
            } else if (k == 4) {
                const float* dskip = a.in[13 + zero] + l * 512;
                for (int it = bx; it < 256; it += G) ssm_s3_item(it, dskip, Z, Y, ws, tid);
            } else if (k == 5) {
                { pg8::Gemm gm{Z + COL_Q, wl + OFF_P, MTOK, DM, AW, INC}; pg8::StaticOrder S; S.init(MTOK, DM, G, bx);
                  pg8::EpiGate1 E{ACT, DM, Z + COL_GA, INC};
                  pg8::gemm_phase<pg8::EpiGate1, pg8::StaticOrder, true, true>(ldsl, tid, gm, S, E); }
                { pg8::Gemm gm{Y, wl + OFF_GLU, MTOK, 2 * DM, AW, AW}; pg8::PairOrder S; S.base.init(MTOK, DM, G, bx);
                  pg8::EpiGlu E{ACT, DM, Z + COL_GS, INC};
                  pg8::gemm_phase<pg8::EpiGlu, pg8::PairOrder, true, true>(ldsl, tid, gm, S, E); }
            } else if (k == 6) {
                pg8::Gemm gm{ACT, wl + OFF_OUT, MTOK, DM, DM, DM}; pg8::StaticOrder S; S.init(MTOK, DM, G, bx);
                pg8::EpiResid E{xin, outp, DM};
                pg8::gemm_phase<pg8::EpiResid, pg8::StaticOrder, true, true>(ldsl, tid, gm, S, E);
            } else if (k == 7) {
                phase_rmsnorm(outp, a.in[17 + zero] + l * DM, ACT, gw, ngw, lane);
            } else if (k == 8) {
                pg8::Gemm gm{ACT, wl + OFF_GU, MTOK, 2 * DFF, DM, DM}; pg8::StaticOrder S; S.init(MTOK, 2 * DFF, G, bx);
                pg8::EpiSwiglu E{Z, DFF};
                pg8::gemm_phase<pg8::EpiSwiglu, pg8::StaticOrder, true, true>(ldsl, tid, gm, S, E);
            } else {
                pg8::Gemm gm{Z, wl + OFF_DN, MTOK, DM, DFF, DFF}; pg8::StaticOrder S; S.init(MTOK, DM, G, bx);
                pg8::EpiResid E{outp, outp, DM};
                pg8::gemm_phase<pg8::EpiResid, pg8::StaticOrder, true, true>(ldsl, tid, gm, S, E);
            }
        }
        if (ph + 1 < a.ph_hi) grid.sync();
    }
}

extern "C" void kernel_launch(void* const* d_in, const int* in_sizes, int n_in, void* d_out, int out_size, void* d_ws, size_t ws_size, hipStream_t stream) {
    static int grid = 0;
    if (grid == 0) {
        if (n_in != 21 || in_sizes[0] != MTOK * DM || out_size != MTOK * DM || ws_size < WS_END) { fprintf(stderr, "kernel_launch: unexpected shapes / workspace (n_in %d, ws %zu)\n", n_in, ws_size); grid = -1; return; }
        int dev = 0, cus = 0, per_cu = 0;
        (void)hipGetDevice(&dev); (void)hipDeviceGetAttribute(&cus, hipDeviceAttributeMultiprocessorCount, dev);
        (void)hipFuncSetAttribute((const void*)mega_fwd, hipFuncAttributeMaxDynamicSharedMemorySize, LDS_BYTES);
        (void)hipOccupancyMaxActiveBlocksPerMultiprocessor(&per_cu, (const void*)mega_fwd, NTHR, LDS_BYTES);
        if (per_cu < 1) per_cu = 1;
        (void)hipGetLastError();
        grid = cus * per_cu;
    }
    if (grid < 0) return;
    Args a{};
    for (int i = 0; i < 21; ++i) a.in[i] = (const float*)d_in[i];
    a.out = (float*)d_out; a.ws = (unsigned char*)d_ws;
#if MK_SINGLE
    a.ph_lo = 0; a.ph_hi = N_PHASES;
    void* args[] = {&a};
    hipError_t e = hipLaunchCooperativeKernel((const void*)mega_fwd, dim3(grid), dim3(NTHR), args, LDS_BYTES, stream);
    if (e != hipSuccess) fprintf(stderr, "cooperative launch failed: %s (grid %d)\n", hipGetErrorString(e), grid);
#else
    for (int ph = 0; ph < N_PHASES; ++ph) { a.ph_lo = ph; a.ph_hi = ph + 1; hipLaunchKernelGGL(mega_fwd, dim3(grid), dim3(NTHR), LDS_BYTES, stream, a); }
#endif
}
```

```cpp
#include <hip/hip_runtime.h>
#include <hip/hip_cooperative_groups.h>
#include <cstdio>
#include <cstdint>
namespace cg = cooperative_groups;

#ifndef REP_MASK
#define REP_MASK 0
#endif
#ifndef REP_PH
#define REP_PH 0
#endif
#ifndef REP_ATT
#define REP_ATT 0
#endif
#ifndef SYNC_X
#define SYNC_X 1
#endif
#define NREP(k) (((REP_MASK >> (k)) & 1) ? 2 : 1)
#ifndef MK_SINGLE
#define MK_SINGLE 1
#endif

namespace pg8 {
#define PG8_LAS __attribute__((address_space(3)))
typedef unsigned short bf16_t;
typedef short bf16x8 __attribute__((ext_vector_type(8)));
typedef float f32x4 __attribute__((ext_vector_type(4)));
typedef unsigned u32x4 __attribute__((ext_vector_type(4)));
constexpr int BM = 256, BK = 64, HALF = 128, HTB = HALF * BK * 2, STAGE_BYTES = 8 * HTB, NXCD = 8, WGM = 8;

__host__ __device__ __forceinline__ int lds_byte(int r, int c) { const int st = (r >> 4) * 2 + (c >> 5), rr = r & 15, cc = c & 31, ob = rr * 64 + cc * 2; return st * 1024 + (ob ^ (((ob >> 9) & 1) << 5)); }
__host__ __device__ __forceinline__ void stage_rc(int b, int& R, int& C) { const int st = b / 1024, sb = b % 1024, swz = sb ^ (((sb >> 9) & 1) << 5); R = (st >> 1) * 16 + swz / 64; C = (st & 1) * 32 + (swz % 64) / 2; }
__host__ __device__ __forceinline__ int perm32(int rho) { const int n = rho >> 4, i = rho & 15; return 8 * (i >> 2) + 4 * n + (i & 3); }

struct Unit { int pm, pn; };
struct Gemm { const bf16_t* A; const bf16_t* Bt; int M, N, K, lda; };

struct StaticOrder {
    int nM, nN, nwg, G, c;
    __host__ __device__ void init(int M, int N, int G_, int c_) { nM = M / BM; nN = N / BM; nwg = nM * nN; G = G_; c = c_; }
    __host__ __device__ bool next(int i, Unit& u) const {
        const long L = (long)i * G + c; if (L >= nwg) return false;
        int wgid = (int)L; { const int q = nwg / NXCD, r = nwg % NXCD, xcd = wgid % NXCD, off = wgid / NXCD; wgid = (xcd < r ? xcd * (q + 1) : r * (q + 1) + (xcd - r) * q) + off; }
        const int nig = WGM * nN, gid = wgid / nig, fm = gid * WGM, gsz = (nM - fm) < WGM ? (nM - fm) : WGM;
        u.pm = fm + ((wgid % nig) % gsz); u.pn = (wgid % nig) / gsz; return true;
    }
    __device__ __forceinline__ void a_ready(const Unit&) const {}
    __device__ __forceinline__ void done(const Unit&) const {}
};
struct PairOrder {
    StaticOrder base;
    __host__ __device__ bool next(int i, Unit& u) const { Unit b; if (!base.next(i >> 1, b)) return false; u.pm = b.pm; u.pn = 2 * b.pn + (i & 1); return true; }
    __device__ __forceinline__ void a_ready(const Unit&) const {}
    __device__ __forceinline__ void done(const Unit&) const {}
};

__device__ __forceinline__ unsigned cvt_pk_bf16(float lo, float hi) { unsigned r; asm volatile("v_cvt_pk_bf16_f32 %0, %1, %2" : "=v"(r) : "v"(lo), "v"(hi)); return r; }
__device__ __forceinline__ float bf_lo(unsigned w) { return __uint_as_float(w << 16); }
__device__ __forceinline__ float bf_hi(unsigned w) { return __uint_as_float(w & 0xffff0000u); }
__device__ __forceinline__ float sigmoidf_(float x) { return __builtin_amdgcn_rcpf(1.0f + __builtin_amdgcn_exp2f(-1.44269504089f * x)); }

__device__ __forceinline__ float row_rstd(const float* SSP, size_t row) {
    const f32x4* p = (const f32x4*)(SSP + row * 16); const f32x4 a = p[0], b = p[1], c = p[2], d = p[3];
    const float ss = ((a[0] + a[1]) + (a[2] + a[3])) + ((b[0] + b[1]) + (b[2] + b[3])) + ((c[0] + c[1]) + (c[2] + c[3])) + ((d[0] + d[1]) + (d[2] + d[3]));
    return rsqrtf(ss * (1.0f / 1024.0f) + 1e-6f);
}
struct EpiZ {
    static constexpr bool PERM = true, AFTER_DRAIN = false;
    bf16_t* QH; bf16_t* UG; const float* SS; const PG8_LAS float* rst; int pbase;
    __device__ __forceinline__ void operator()(const f32x4 (&acc)[2][2][4][2], const Unit& u, int wr, int wc, int fr, int fq) const {
        const int row0 = u.pm * BM + wr * 64 + fr;
        float rs[2][4];
#pragma unroll
        for (int ai = 0; ai < 2; ++ai)
#pragma unroll
            for (int m = 0; m < 4; ++m) { const int rr = row0 + ai * HALF + m * 16, rl = rr - pbase; rs[ai][m] = ((unsigned)rl < 2048u) ? rst[rl] : row_rstd(SS, (size_t)rr); }
        if (u.pn < 18) {
            const int which = u.pn / 6, colt = (u.pn % 6) * 256;
#pragma unroll
            for (int bj = 0; bj < 2; ++bj) { const int col = colt + bj * HALF + wc * 32 + 8 * fq, gi = col >> 9, h = (col >> 6) & 7, e = col & 63, dsh = 2 * gi;
#pragma unroll
                for (int ai = 0; ai < 2; ++ai)
#pragma unroll
                    for (int m = 0; m < 4; ++m) { const int row = row0 + ai * HALF + m * 16, b = row >> 13, t = row & 8191, idx = ((t & ((1 << dsh) - 1)) << (13 - dsh)) + (t >> dsh);
                        const f32x4 v0 = acc[ai][bj][m][0] * rs[ai][m], v1 = acc[ai][bj][m][1] * rs[ai][m];
                        u32x4 w; w.x = cvt_pk_bf16(v0[0], v0[1]); w.y = cvt_pk_bf16(v0[2], v0[3]); w.z = cvt_pk_bf16(v1[0], v1[1]); w.w = cvt_pk_bf16(v1[2], v1[3]);
                        *(u32x4*)(QH + ((((size_t)(which * 2 + b) * 3 + gi) * 8 + h) * 8192 + idx) * 64 + e) = w; } }
        } else {
            const int col0 = (u.pn - 18) * BM + wc * 32 + 8 * fq; const bool sg = u.pn >= 20;
#pragma unroll
            for (int ai = 0; ai < 2; ++ai)
#pragma unroll
                for (int m = 0; m < 4; ++m) { bf16_t* rowp = UG + (size_t)(row0 + ai * HALF + m * 16) * 2560 + col0;
#pragma unroll
                    for (int bj = 0; bj < 2; ++bj) { f32x4 v0 = acc[ai][bj][m][0] * rs[ai][m], v1 = acc[ai][bj][m][1] * rs[ai][m];
                        if (sg) {
#pragma unroll
                            for (int j = 0; j < 4; ++j) { v0[j] = sigmoidf_(v0[j]); v1[j] = sigmoidf_(v1[j]); } }
                        u32x4 w; w.x = cvt_pk_bf16(v0[0], v0[1]); w.y = cvt_pk_bf16(v0[2], v0[3]); w.z = cvt_pk_bf16(v1[0], v1[1]); w.w = cvt_pk_bf16(v1[2], v1[3]);
                        *(u32x4*)(rowp + bj * HALF) = w; } }
        }
    }
};
struct EpiGate1 {
    static constexpr bool PERM = true, AFTER_DRAIN = false;
    bf16_t* O; int ldc; const bf16_t* G; int ldg;
    __device__ __forceinline__ void operator()(const f32x4 (&acc)[2][2][4][2], const Unit& u, int wr, int wc, int fr, int fq) const {
        const int row0 = u.pm * BM + wr * 64 + fr, col0 = u.pn * BM + wc * 32 + 8 * fq;
#pragma unroll
        for (int ai = 0; ai < 2; ++ai)
#pragma unroll
            for (int m = 0; m < 4; ++m) { const size_t r = (size_t)(row0 + ai * HALF + m * 16);
#pragma unroll
                for (int bj = 0; bj < 2; ++bj) { const f32x4 v0 = acc[ai][bj][m][0], v1 = acc[ai][bj][m][1];
                    const u32x4 g = *(const u32x4*)(G + r * ldg + col0 + bj * HALF);
                    u32x4 w; w.x = cvt_pk_bf16(v0[0] * bf_lo(g.x), v0[1] * bf_hi(g.x)); w.y = cvt_pk_bf16(v0[2] * bf_lo(g.y), v0[3] * bf_hi(g.y));
                    w.z = cvt_pk_bf16(v1[0] * bf_lo(g.z), v1[1] * bf_hi(g.z)); w.w = cvt_pk_bf16(v1[2] * bf_lo(g.w), v1[3] * bf_hi(g.w));
                    *(u32x4*)(O + r * ldc + col0 + bj * HALF) = w; }
                asm volatile("" ::: "memory"); }
    }
};
struct EpiGlu {
    static constexpr bool PERM = true, AFTER_DRAIN = false;
    bf16_t* O; int ldc; const bf16_t* G; int ldg;
    __device__ __forceinline__ void operator()(const f32x4 (&acc)[2][2][4][2], const Unit& u, int wr, int wc, int fr, int fq) const {
        const int row0 = u.pm * BM + wr * 64 + fr, col0 = u.pn * HALF + wc * 32 + 8 * fq;
#pragma unroll
        for (int ai = 0; ai < 2; ++ai)
#pragma unroll
            for (int m = 0; m < 4; ++m) { const size_t r = (size_t)(row0 + ai * HALF + m * 16);
                const u32x4 g = *(const u32x4*)(G + r * ldg + col0); const u32x4 t = *(const u32x4*)(O + r * ldc + col0);
                const f32x4 a0 = acc[ai][0][m][0], a1 = acc[ai][0][m][1], b0 = acc[ai][1][m][0], b1 = acc[ai][1][m][1];
                u32x4 w;
                w.x = cvt_pk_bf16(bf_lo(t.x) + bf_lo(g.x) * a0[0] * sigmoidf_(b0[0]), bf_hi(t.x) + bf_hi(g.x) * a0[1] * sigmoidf_(b0[1]));
                w.y = cvt_pk_bf16(bf_lo(t.y) + bf_lo(g.y) * a0[2] * sigmoidf_(b0[2]), bf_hi(t.y) + bf_hi(g.y) * a0[3] * sigmoidf_(b0[3]));
                w.z = cvt_pk_bf16(bf_lo(t.z) + bf_lo(g.z) * a1[0] * sigmoidf_(b1[0]), bf_hi(t.z) + bf_hi(g.z) * a1[1] * sigmoidf_(b1[1]));
                w.w = cvt_pk_bf16(bf_lo(t.w) + bf_lo(g.w) * a1[2] * sigmoidf_(b1[2]), bf_hi(t.w) + bf_hi(g.w) * a1[3] * sigmoidf_(b1[3]));
                *(u32x4*)(O + r * ldc + col0) = w; asm volatile("" ::: "memory"); }
    }
};
struct EpiSwiglu {
    static constexpr bool PERM = true, AFTER_DRAIN = false;
    bf16_t* O; int ldc; const float* SS; const PG8_LAS float* rst; int pbase;
    __device__ __forceinline__ void operator()(const f32x4 (&acc)[2][2][4][2], const Unit& u, int wr, int wc, int fr, int fq) const {
        const int row0 = u.pm * BM + wr * 64 + fr, col0 = u.pn * HALF + wc * 32 + 8 * fq;
#pragma unroll
        for (int ai = 0; ai < 2; ++ai)
#pragma unroll
            for (int m = 0; m < 4; ++m) { const size_t r = (size_t)(row0 + ai * HALF + m * 16);
                const int rl = (int)r - pbase; const float rs = ((unsigned)rl < 2048u) ? rst[rl] : row_rstd(SS, r);
                const f32x4 a0 = acc[ai][0][m][0] * rs, a1 = acc[ai][0][m][1] * rs, b0 = acc[ai][1][m][0] * rs, b1 = acc[ai][1][m][1] * rs;
                u32x4 w;
                w.x = cvt_pk_bf16(a0[0] * sigmoidf_(a0[0]) * b0[0], a0[1] * sigmoidf_(a0[1]) * b0[1]);
                w.y = cvt_pk_bf16(a0[2] * sigmoidf_(a0[2]) * b0[2], a0[3] * sigmoidf_(a0[3]) * b0[3]);
                w.z = cvt_pk_bf16(a1[0] * sigmoidf_(a1[0]) * b1[0], a1[1] * sigmoidf_(a1[1]) * b1[1]);
                w.w = cvt_pk_bf16(a1[2] * sigmoidf_(a1[2]) * b1[2], a1[3] * sigmoidf_(a1[3]) * b1[3]);
                *(u32x4*)(O + r * ldc + col0) = w; }
    }
};
struct EpiResid {
    static constexpr bool PERM = false, AFTER_DRAIN = false;
    const float* R; float* C; int ldc; bf16_t* XB; float* SS;
    __device__ __forceinline__ void operator()(const f32x4 (&acc)[2][2][4][2], const Unit& u, int wr, int wc, int fr, int fq) const {
        const int row0 = u.pm * BM + wr * 64 + fr, col0 = u.pn * BM + wc * 32 + 4 * fq;
#pragma unroll
        for (int ai = 0; ai < 2; ++ai)
#pragma unroll
            for (int m = 0; m < 4; ++m) { const int row = row0 + ai * HALF + m * 16; const size_t off = (size_t)row * ldc + col0; float ss = 0.f;
#pragma unroll
                for (int bj = 0; bj < 2; ++bj)
#pragma unroll
                    for (int n = 0; n < 2; ++n) { const f32x4 rv = *(const f32x4*)(R + off + bj * HALF + n * 16); const f32x4 o = acc[ai][bj][m][n] + rv; *(f32x4*)(C + off + bj * HALF + n * 16) = o;
                        ss += (o[0] * o[0] + o[1] * o[1]) + (o[2] * o[2] + o[3] * o[3]);
                        unsigned w0 = cvt_pk_bf16(o[0], o[1]), w1 = cvt_pk_bf16(o[2], o[3]); typedef unsigned u32x2_ __attribute__((ext_vector_type(2))); *(u32x2_*)(XB + off + bj * HALF + n * 16) = (u32x2_){w0, w1}; }
                ss += __shfl_xor(ss, 16); ss += __shfl_xor(ss, 32);
                if (fq == 0) SS[(size_t)row * 16 + u.pn * 4 + wc] = ss;
                asm volatile("" ::: "memory"); }
    }
};

template <class Epi, class Sched, bool ALIGN_EPI = false, bool SP2 = false>
__device__ __forceinline__ void gemm_phase(PG8_LAS unsigned char* lds, const int tid, const Gemm g, const Sched& S, const Epi& E) {
    const int wid = __builtin_amdgcn_readfirstlane(tid >> 6), lane = tid & 63, wr = wid >> 2, wc = wid & 3, fr = lane & 15, fq = lane >> 4;
    const int K = g.K, nt = K / BK, lda = g.lda;
    unsigned voffA[2], voffB[2];
#pragma unroll
    for (int i = 0; i < 2; ++i) { int R, C; stage_rc(tid * 16 + i * 8192, R, C); const int Rb = Epi::PERM ? ((R & ~31) + perm32(R & 31)) : R;
        voffA[i] = (unsigned)(R * lda + C) * 2u; voffB[i] = (unsigned)(Rb * K + C) * 2u; }
    const size_t kstep = (size_t)(BK * 2);
    const size_t hA = (size_t)HALF * lda * 2, hB = (size_t)HALF * K * 2;
    const size_t tA = 2 * hA, tB = 2 * hB;
    const unsigned ldsw = (unsigned)wid * 1024u;
    const int aoff = lds_byte(wr * 64 + fr, fq * 8), boff = lds_byte(wc * 32 + fr, fq * 8);
#define PG8_SA(b, h) (((b) * 2 + (h)) * HTB)
#define PG8_SB(b, h) ((4 + (b) * 2 + (h)) * HTB)
#define PG8_STAGE(bufoff, gbase, voff) do { _Pragma("unroll") for (int _i = 0; _i < 2; ++_i) \
        __builtin_amdgcn_global_load_lds((const unsigned*)((const char*)(gbase) + (voff)[_i]), (PG8_LAS unsigned*)(lds + (bufoff) + ldsw + _i * 8192), 16, 0, 0); } while (0)
#define PG8_LDA(dst, b, h) do { _Pragma("unroll") for (int m = 0; m < 4; ++m) _Pragma("unroll") for (int k = 0; k < 2; ++k) dst[m][k] = *(const PG8_LAS bf16x8*)(lds + PG8_SA(b, h) + aoff + m * 2048 + k * 1024); } while (0)
#define PG8_LDB(dst, b, h) do { _Pragma("unroll") for (int n = 0; n < 2; ++n) _Pragma("unroll") for (int k = 0; k < 2; ++k) dst[n][k] = *(const PG8_LAS bf16x8*)(lds + PG8_SB(b, h) + boff + n * 2048 + k * 1024); } while (0)
#define PG8_MMA(ai, bj, At, Bt) do { __builtin_amdgcn_s_setprio(1); _Pragma("unroll") for (int m = 0; m < 4; ++m) _Pragma("unroll") for (int n = 0; n < 2; ++n) _Pragma("unroll") for (int k = 0; k < 2; ++k) \
        acc[ai][bj][m][n] = __builtin_amdgcn_mfma_f32_16x16x32_bf16(Bt[n][k], At[m][k], acc[ai][bj][m][n], 0, 0, 0); __builtin_amdgcn_s_setprio(0); } while (0)
#define PG8_WAIT_V(n) asm volatile("s_waitcnt vmcnt(" #n ")" ::: "memory")
#define PG8_WAIT_L(n) asm volatile("s_waitcnt lgkmcnt(" #n ")" ::: "memory")
#define PG8_BAR __builtin_amdgcn_s_barrier()
#define PG8_SCHED __builtin_amdgcn_sched_barrier(0)
    Unit cur, nxt; int ui = 0;
    if (!S.next(0, cur)) return;
    f32x4 acc[2][2][4][2];
#pragma unroll
    for (int a = 0; a < 2; ++a)
#pragma unroll
        for (int b = 0; b < 2; ++b)
#pragma unroll
            for (int m = 0; m < 4; ++m)
#pragma unroll
                for (int n = 0; n < 2; ++n) acc[a][b][m][n] = (f32x4){0.f, 0.f, 0.f, 0.f};
    bf16x8 At[4][2], B0[2][2], B1[2][2];
    const char* cA = (const char*)g.A + (size_t)cur.pm * tA; const char* cB = (const char*)g.Bt + (size_t)cur.pn * tB;
    S.a_ready(cur);
    if constexpr (SP2) {
        PG8_STAGE(PG8_SB(0, 0), cB, voffB); PG8_STAGE(PG8_SB(0, 1), cB + hB, voffB); PG8_STAGE(PG8_SA(0, 0), cA, voffA); PG8_STAGE(PG8_SA(0, 1), cA + hA, voffA);
        if (wr == 1) PG8_BAR;
        PG8_WAIT_V(2); PG8_BAR;
        PG8_STAGE(PG8_SB(1, 0), cB + kstep, voffB); PG8_STAGE(PG8_SA(1, 0), cA + kstep, voffA); PG8_STAGE(PG8_SB(1, 1), cB + hB + kstep, voffB);
        PG8_WAIT_V(6); PG8_BAR;
    } else {
        PG8_STAGE(PG8_SB(0, 0), cB, voffB); PG8_STAGE(PG8_SA(0, 0), cA, voffA); PG8_STAGE(PG8_SB(0, 1), cB + hB, voffB); PG8_STAGE(PG8_SA(0, 1), cA + hA, voffA);
        if (wr == 1) PG8_BAR;
        PG8_WAIT_V(4); PG8_BAR;
        PG8_STAGE(PG8_SB(1, 0), cB + kstep, voffB); PG8_STAGE(PG8_SA(1, 0), cA + kstep, voffA); PG8_STAGE(PG8_SB(1, 1), cB + hB + kstep, voffB);
        PG8_WAIT_V(6); PG8_BAR;
    }
    for (;;) {
        const bool has_next = S.next(ui + 1, nxt);
        const char* nA = has_next ? (const char*)g.A + (size_t)nxt.pm * tA : cA; const char* nB = has_next ? (const char*)g.Bt + (size_t)nxt.pn * tB : cB;
        for (int t = 0; t < nt; t += 2) {
            const bool last = (t == nt - 2);
            const char* a1 = cA + (size_t)(t + 1) * kstep;
            const char* a2 = last ? nA : cA + (size_t)(t + 2) * kstep; const char* b2 = last ? nB : cB + (size_t)(t + 2) * kstep;
            const char* a3 = a2 + kstep; const char* b3 = b2 + kstep;
            if (last && has_next) S.a_ready(nxt);
            if constexpr (SP2) {
            PG8_LDB(B0, 0, 0); PG8_LDB(B1, 0, 1); PG8_SCHED; PG8_LDA(At, 0, 0); PG8_STAGE(PG8_SA(1, 1), a1 + hA, voffA);
            PG8_WAIT_V(8); PG8_WAIT_L(0); PG8_BAR; PG8_MMA(0, 0, At, B0); PG8_MMA(0, 1, At, B1); PG8_BAR; PG8_SCHED;
            PG8_LDA(At, 0, 1); PG8_STAGE(PG8_SB(0, 0), b2, voffB); PG8_STAGE(PG8_SB(0, 1), b2 + hB, voffB); PG8_STAGE(PG8_SA(0, 0), a2, voffA);
            PG8_WAIT_V(8); PG8_WAIT_L(0); PG8_BAR; PG8_MMA(1, 0, At, B0); PG8_MMA(1, 1, At, B1); PG8_BAR; PG8_SCHED;
            PG8_LDB(B0, 1, 0); PG8_LDB(B1, 1, 1); PG8_SCHED; PG8_LDA(At, 1, 0); PG8_STAGE(PG8_SA(0, 1), a2 + hA, voffA);
            PG8_WAIT_V(8); PG8_WAIT_L(0); PG8_BAR; PG8_MMA(0, 0, At, B0); PG8_MMA(0, 1, At, B1); PG8_BAR; PG8_SCHED;
            PG8_LDA(At, 1, 1); PG8_STAGE(PG8_SB(1, 0), b3, voffB); PG8_STAGE(PG8_SB(1, 1), b3 + hB, voffB); PG8_STAGE(PG8_SA(1, 0), a3, voffA);
            PG8_WAIT_V(8); PG8_WAIT_L(0); PG8_BAR; PG8_MMA(1, 0, At, B0); PG8_MMA(1, 1, At, B1); PG8_BAR; PG8_SCHED;
            } else {
            PG8_LDB(B0, 0, 0); PG8_SCHED; PG8_LDA(At, 0, 0); PG8_STAGE(PG8_SA(1, 1), a1 + hA, voffA);
            PG8_WAIT_L(8); PG8_BAR; PG8_WAIT_L(0); PG8_MMA(0, 0, At, B0); PG8_BAR; PG8_SCHED;
            PG8_LDB(B1, 0, 1); PG8_STAGE(PG8_SB(0, 0), b2, voffB);
            PG8_BAR; PG8_WAIT_L(0); PG8_MMA(0, 1, At, B1); PG8_BAR;
            PG8_LDA(At, 0, 1); PG8_STAGE(PG8_SA(0, 0), a2, voffA);
            PG8_BAR; PG8_WAIT_L(0); PG8_MMA(1, 0, At, B0); PG8_BAR; PG8_SCHED;
            PG8_STAGE(PG8_SB(0, 1), b2 + hB, voffB);
            PG8_WAIT_V(6); PG8_BAR; PG8_MMA(1, 1, At, B1); PG8_BAR;
            PG8_LDB(B0, 1, 0); PG8_SCHED; PG8_LDA(At, 1, 0); PG8_STAGE(PG8_SA(0, 1), a2 + hA, voffA);
            PG8_WAIT_L(8); PG8_BAR; PG8_WAIT_L(0); PG8_MMA(0, 0, At, B0); PG8_BAR; PG8_SCHED;
            PG8_LDB(B1, 1, 1); PG8_STAGE(PG8_SB(1, 0), b3, voffB);
            PG8_BAR; PG8_WAIT_L(0); PG8_MMA(0, 1, At, B1); PG8_BAR;
            PG8_LDA(At, 1, 1); PG8_STAGE(PG8_SA(1, 0), a3, voffA);
            PG8_BAR; PG8_WAIT_L(0); PG8_MMA(1, 0, At, B0); PG8_BAR; PG8_SCHED;
            PG8_STAGE(PG8_SB(1, 1), b3 + hB, voffB);
            PG8_WAIT_V(6); PG8_BAR; PG8_MMA(1, 1, At, B1); PG8_BAR;
            }
        }
        if constexpr (ALIGN_EPI) { if (wr == 0) PG8_BAR; }
        if constexpr (!Epi::AFTER_DRAIN) { E(acc, cur, wr, wc, fr, fq); S.done(cur); }
        if (!has_next) break;
#pragma unroll
        for (int a = 0; a < 2; ++a)
#pragma unroll
            for (int b = 0; b < 2; ++b)
#pragma unroll
                for (int m = 0; m < 4; ++m)
#pragma unroll
                    for (int n = 0; n < 2; ++n) acc[a][b][m][n] = (f32x4){0.f, 0.f, 0.f, 0.f};
        cur = nxt; cA = nA; cB = nB; ++ui;
        if constexpr (ALIGN_EPI) { if (wr == 1) PG8_BAR; }
    }
    PG8_WAIT_V(0);
    if constexpr (!ALIGN_EPI) { if (wr == 0) PG8_BAR; }
    PG8_BAR;
#undef PG8_SA
#undef PG8_SB
#undef PG8_STAGE
#undef PG8_LDA
#undef PG8_LDB
#undef PG8_MMA
#undef PG8_WAIT_V
#undef PG8_WAIT_L
#undef PG8_BAR
#undef PG8_SCHED
}
}

typedef unsigned short bf16;
typedef short bf16x8 __attribute__((ext_vector_type(8)));
typedef float f32x4 __attribute__((ext_vector_type(4)));
typedef unsigned u32x4 __attribute__((ext_vector_type(4)));
typedef unsigned u32x2 __attribute__((ext_vector_type(2)));
#define LAS __attribute__((address_space(3)))

constexpr int NWAVES = 8, NTHR = 512;
constexpr int DM = 1024, SEQ = 8192, MTOK = 16384, DEPTH = 4;
constexpr int INC = 7168, DFF = 2816, AW = 512;
constexpr int COL_Q = 0, COL_K = 1536, COL_V = 3072, COL_U = 4608, COL_GA = 5120, COL_GS = 6144;
constexpr int UGP = 2560;
constexpr int TC = 32, NCH = MTOK / TC  , CHB = SEQ / TC  ;
constexpr float EPS = 1e-6f;

constexpr size_t OFF_IN = 0, OFF_P = 7340032, OFF_GLU = 7864320, OFF_OUT = 8912896, OFF_GU = 9961472, OFF_DN = 15728640, LAYER_W = 18612224;
constexpr size_t MiB = 1u << 20;
constexpr size_t WS_SS1 = 65536, WS_SS2 = 131072;
constexpr size_t WS_WB = 1 * MiB, WS_Z = 143 * MiB, WS_ACT = 367 * MiB, WS_Y = 399 * MiB, WS_LSE = 415 * MiB, WS_TAB = 417 * MiB, TAB_STRIDE = 9 * MiB,
                 WS_S = 435 * MiB, WS_XP = 443 * MiB, WS_END = 447 * MiB;
constexpr size_t TB_KT = 0, TB_AT = 768 * 1024, TB_E = 1 * MiB, TB_P = 5 * MiB;
static_assert(WS_WB + 4 * LAYER_W * 2 <= WS_Z && WS_Z + (size_t)MTOK * INC * 2 <= WS_ACT, "ws map");
constexpr int LDS_BYTES = 147456;

struct Args { const float* in[21]; float* out; unsigned char* ws; int ph_lo, ph_hi; };

__device__ __forceinline__ unsigned f2bf(float f) { unsigned u = __float_as_uint(f); return (u + 0x7fffu + ((u >> 16) & 1u)) >> 16; }
__device__ __forceinline__ unsigned pk2(float lo, float hi) { unsigned r; asm("v_cvt_pk_bf16_f32 %0, %1, %2" : "=v"(r) : "v"(lo), "v"(hi)); return r; }
__device__ __forceinline__ float bflo(unsigned w) { return __uint_as_float(w << 16); }
__device__ __forceinline__ float bfhi(unsigned w) { return __uint_as_float(w & 0xffff0000u); }
__device__ __forceinline__ float wave_sum(float v) {
#pragma unroll
    for (int o = 1; o < 64; o <<= 1) v += __shfl_xor(v, o);
    return v;
}

__device__ __forceinline__ void transpose_item(const float* W, int K, int N, bf16* WT, int il_off, float* scr, int item, int lane, const float* gk = nullptr) {
    const int nblk = N / 32, kb = item / nblk, nb = item % nblk, k0 = 64 * kb, n0 = 32 * nb;
#pragma unroll 8
    for (int i = 0; i < 32; ++i) { const int kk = 2 * i + (lane >> 5); float v = W[(size_t)(k0 + kk) * N + n0 + (lane & 31)]; if (gk) v *= gk[k0 + kk]; scr[kk * 33 + (lane & 31)] = v; }
    __builtin_amdgcn_s_waitcnt(0xc07f); asm volatile("" ::: "memory");
    const int drow = (il_off < 0) ? n0 : (n0 / 128) * 256 + il_off + (n0 % 128);
    const int c = lane & 7;
#pragma unroll
    for (int j = 0; j < 4; ++j) { const int n = (lane >> 3) + 8 * j; const float* s = scr + (8 * c) * 33 + n;
        u32x4 o; o.x = pk2(s[0 * 33], s[1 * 33]); o.y = pk2(s[2 * 33], s[3 * 33]); o.z = pk2(s[4 * 33], s[5 * 33]); o.w = pk2(s[6 * 33], s[7 * 33]);
        *(u32x4*)(WT + (size_t)(drow + n) * K + k0 + 8 * c) = o; }
    __builtin_amdgcn_s_waitcnt(0xc07f); asm volatile("" ::: "memory");
}
__device__ __forceinline__ void phase_weights(const Args& a, int zero, bf16* WB, float* ldsf, int gw, int ngw, int wave, int lane) {
    float* scr = ldsf + wave * 4096;
    constexpr int PER_LAYER = 9088;
    for (int it = gw; it < DEPTH * PER_LAYER; it += ngw) {
        const int l = it / PER_LAYER; int r = it % PER_LAYER; bf16* wl = WB + (size_t)l * LAYER_W;
        if (r < 3584) { transpose_item(a.in[2 + zero] + (size_t)l * DM * INC, DM, INC, wl + OFF_IN, -1, scr, r, lane, a.in[1 + zero] + l * DM); continue; } r -= 3584;
        if (r < 256) { transpose_item(a.in[5 + zero] + (size_t)l * AW * DM, AW, DM, wl + OFF_P, -1, scr, r, lane); continue; } r -= 256;
        if (r < 256) { transpose_item(a.in[14 + zero] + (size_t)l * AW * DM, AW, DM, wl + OFF_GLU, 0, scr, r, lane); continue; } r -= 256;
        if (r < 256) { transpose_item(a.in[15 + zero] + (size_t)l * AW * DM, AW, DM, wl + OFF_GLU, 128, scr, r, lane); continue; } r -= 256;
        if (r < 512) { transpose_item(a.in[16 + zero] + (size_t)l * DM * DM, DM, DM, wl + OFF_OUT, -1, scr, r, lane); continue; } r -= 512;
        if (r < 1408) { transpose_item(a.in[18 + zero] + (size_t)l * DM * DFF, DM, DFF, wl + OFF_GU, 0, scr, r, lane, a.in[17 + zero] + l * DM); continue; } r -= 1408;
        if (r < 1408) { transpose_item(a.in[19 + zero] + (size_t)l * DM * DFF, DM, DFF, wl + OFF_GU, 128, scr, r, lane, a.in[17 + zero] + l * DM); continue; } r -= 1408;
        transpose_item(a.in[20 + zero] + (size_t)l * DFF * DM, DFF, DM, wl + OFF_DN, -1, scr, r, lane);
    }
}

__device__ __forceinline__ void phase_xprep(const float* x, bf16* out, float* SS, int gw, int ngw, int lane) {
    for (int m = gw; m < MTOK; m += ngw) {
        const f32x4* xr = (const f32x4*)(x + (size_t)m * DM) + lane;
        f32x4 v[4]; float s = 0.f;
#pragma unroll
        for (int j = 0; j < 4; ++j) { v[j] = xr[64 * j]; s += (v[j].x * v[j].x + v[j].y * v[j].y) + (v[j].z * v[j].z + v[j].w * v[j].w); }
        s = wave_sum(s);
        u32x2* o8 = (u32x2*)(out + (size_t)m * DM) + lane;
#pragma unroll
        for (int j = 0; j < 4; ++j) { u32x2 w; w.x = pk2(v[j].x, v[j].y); w.y = pk2(v[j].z, v[j].w); o8[64 * j] = w; }
        if (lane < 16) SS[(size_t)m * 16 + lane] = (lane == 0) ? s : 0.f;
    }
}

__device__ __forceinline__ void ssm_pre_item(const Args& a, int zero, int l, int g, unsigned char* tab, float* L, int tid) {
    float* pw = L; float* bb = L + 4224; float* cc = L + 6272;
    const float* lam_re = a.in[6 + zero] + (size_t)(l * 32 + g) * 64; const float* lam_im = a.in[7 + zero] + (size_t)(l * 32 + g) * 64;
    const float* b_re = a.in[9 + zero] + (size_t)(l * 32 + g) * 1024; const float* b_im = a.in[10 + zero] + (size_t)(l * 32 + g) * 1024;
    const float* c_re = a.in[11 + zero] + (size_t)(l * 32 + g) * 1024; const float* c_im = a.in[12 + zero] + (size_t)(l * 32 + g) * 1024;
    const float ldt = a.in[8 + zero][l * 32 + g];
    const double INV_2PI = 0.15915494309189533577, TWO_PI = 6.283185307179586476925;
    float brv[2], biv[2], crv[2], civ[2], lrv[5], liv[5];
#pragma unroll
    for (int q = 0; q < 2; ++q) { const int i = tid + NTHR * q; brv[q] = b_re[i]; biv[q] = b_im[i]; crv[q] = c_re[i]; civ[q] = c_im[i]; }
#pragma unroll
    for (int q = 0; q < 5; ++q) { const int i = tid + NTHR * q, p = i & 63; lrv[q] = lam_re[p]; liv[q] = lam_im[p]; }
    const float dt = expf(ldt);
#pragma unroll
    for (int q = 0; q < 2; ++q) { const int i = tid + NTHR * q, p = i >> 4; const float lr = lam_re[p], li = lam_im[p];
        const double angle = (double)li * (double)dt; const double rr = angle - TWO_PI * rint(angle * INV_2PI);
        float sn, cs; sincosf((float)rr, &sn, &cs); const float mag = expf(lr * dt);
        const float nr = mag * cs - 1.0f, ni = mag * sn, den = lr * lr + li * li;
        const float cr = (nr * lr + ni * li) / den, ci = (ni * lr - nr * li) / den;
        bb[i * 2] = cr * brv[q] - ci * biv[q]; bb[i * 2 + 1] = cr * biv[q] + ci * brv[q];
        cc[i * 2] = crv[q]; cc[i * 2 + 1] = civ[q]; }
#pragma unroll
    for (int q = 0; q < 5; ++q) { const int i = tid + NTHR * q; if (i < 33 * 64) { const int j = i >> 6;
        const double angle = (double)liv[q] * (double)dt * (double)j; const double rr = angle - TWO_PI * rint(angle * INV_2PI);
        float sn, cs; sincosf((float)rr, &sn, &cs); const float mag = expf(lrv[q] * dt * (float)j);
        pw[i * 2] = mag * cs; pw[i * 2 + 1] = mag * sn; } }
    __syncthreads();
    bf16* KT = (bf16*)(tab + TB_KT) + (size_t)g * 32 * 256; bf16* E = (bf16*)(tab + TB_E) + (size_t)g * 128 * 512; bf16* P = (bf16*)(tab + TB_P) + (size_t)g * 512 * 128;
    float* AT = (float*)(tab + TB_AT) + g * 128;
    { const int j = tid >> 4, c = tid & 15; float acc16[16];
#pragma unroll
      for (int q = 0; q < 16; ++q) acc16[q] = 0.f;
      for (int p = 0; p < 64; ++p) { const float Cr = cc[(c * 64 + p) * 2], Ci = cc[(c * 64 + p) * 2 + 1], wr_ = pw[(j * 64 + p) * 2], wi_ = pw[(j * 64 + p) * 2 + 1];
          const float tr = Cr * wr_ - Ci * wi_, ti = Cr * wi_ + Ci * wr_; const f32x4* b4 = (const f32x4*)(bb + p * 32);
#pragma unroll
          for (int q = 0; q < 8; ++q) { const f32x4 bv = b4[q]; acc16[2 * q] += tr * bv.x - ti * bv.y; acc16[2 * q + 1] += tr * bv.z - ti * bv.w; } }
      u32x4 o0, o1; o0.x = pk2(acc16[0], acc16[1]); o0.y = pk2(acc16[2], acc16[3]); o0.z = pk2(acc16[4], acc16[5]); o0.w = pk2(acc16[6], acc16[7]);
      o1.x = pk2(acc16[8], acc16[9]); o1.y = pk2(acc16[10], acc16[11]); o1.z = pk2(acc16[12], acc16[13]); o1.w = pk2(acc16[14], acc16[15]);
      *(u32x4*)(KT + (size_t)tid * 16) = o0; *(u32x4*)(KT + (size_t)tid * 16 + 8) = o1; }
    for (int i8 = tid; i8 < 128 * 64; i8 += NTHR) { const int row = i8 >> 6, k8 = i8 & 63, p = row & 63, s_ = k8 >> 1, c0 = (k8 & 1) * 8, j = 31 - s_;
        const float wr_ = pw[(j * 64 + p) * 2], wi_ = pw[(j * 64 + p) * 2 + 1]; const f32x4* b4 = (const f32x4*)(bb + (p * 16 + c0) * 2); float v[8];
#pragma unroll
        for (int q = 0; q < 4; ++q) { const f32x4 bv = b4[q];
            v[2 * q] = (row < 64) ? (wr_ * bv.x - wi_ * bv.y) : (wr_ * bv.y + wi_ * bv.x); v[2 * q + 1] = (row < 64) ? (wr_ * bv.z - wi_ * bv.w) : (wr_ * bv.w + wi_ * bv.z); }
        u32x4 o; o.x = pk2(v[0], v[1]); o.y = pk2(v[2], v[3]); o.z = pk2(v[4], v[5]); o.w = pk2(v[6], v[7]);
        *(u32x4*)(E + (size_t)i8 * 8) = o; }
    for (int i8 = tid; i8 < 512 * 16; i8 += NTHR) { const int row = i8 >> 4, q0 = (i8 & 15) * 8, p0 = q0 & 63, t = row >> 4, c = row & 15, j = t + 1;
        const f32x4* c4 = (const f32x4*)(cc + (c * 64 + p0) * 2); const f32x4* w4 = (const f32x4*)(pw + (j * 64 + p0) * 2); float v[8];
#pragma unroll
        for (int q = 0; q < 4; ++q) { const f32x4 cv = c4[q], wv = w4[q];
            v[2 * q] = (q0 < 64) ? (cv.x * wv.x - cv.y * wv.y) : -(cv.x * wv.y + cv.y * wv.x); v[2 * q + 1] = (q0 < 64) ? (cv.z * wv.z - cv.w * wv.w) : -(cv.z * wv.w + cv.w * wv.z); }
        u32x4 o; o.x = pk2(v[0], v[1]); o.y = pk2(v[2], v[3]); o.z = pk2(v[4], v[5]); o.w = pk2(v[6], v[7]);
        *(u32x4*)(P + (size_t)i8 * 8) = o; }
    if (tid < 64) { AT[tid] = pw[(32 * 64 + tid) * 2]; AT[64 + tid] = pw[(32 * 64 + tid) * 2 + 1]; }
    __syncthreads();
}

constexpr int QP = 72, VP = 272;
constexpr int LQ_OFF = 0, LK_OFF = 128 * QP * 2, LV_OFF = LK_OFF + 256 * QP * 2;
constexpr size_t QPLANE = (size_t)2 * 3 * 8 * 8192 * 64;
struct AttnItem { int gi, h, b, n; size_t qrow0; };
__device__ __forceinline__ AttnItem attn_decode(int item) {
    AttnItem A; int it = item; const int rn = it & 63; it >>= 6; A.h = it & 7; it >>= 3; A.gi = it % 3; A.b = it / 3;
    const int dsh = 2 * A.gi, nbsh = 6 - dsh; const int r = rn >> nbsh; A.n = rn & ((1 << nbsh) - 1);
    A.qrow0 = ((size_t)(A.b * 3 + A.gi) * 8 + A.h) * 8192 + (size_t)r * (8192 >> dsh) + 128 * A.n;
    return A;
}
__device__ __forceinline__ void attn_load(const AttnItem& A, const bf16* QH, int tid, u32x4 (&qv)[2], u32x4 (&kv)[4], u32x4 (&vv)[4]) {
    const bf16* qp = QH + A.qrow0 * 64 + tid * 8;
#pragma unroll
    for (int rd = 0; rd < 2; ++rd) qv[rd] = *(const u32x4*)(qp + rd * 4096);
#pragma unroll
    for (int rd = 0; rd < 4; ++rd) {
        if (A.n > 0 || rd >= 2) { const bf16* p = qp + QPLANE + (rd - 2) * 4096; kv[rd] = *(const u32x4*)p; vv[rd] = *(const u32x4*)(p + QPLANE); }
        else { kv[rd] = (u32x4){0u, 0u, 0u, 0u}; vv[rd] = (u32x4){0u, 0u, 0u, 0u}; } }
}
__device__ __forceinline__ void attn_stage(const float* gq, const float* gk, unsigned char* lds, int tid, const u32x4 (&qv)[2], const u32x4 (&kv)[4], const u32x4 (&vv)[4]) {
    asm volatile("" : "+v"(tid));
    bf16* Qs = (bf16*)(lds + LQ_OFF); bf16* Ks = (bf16*)(lds + LK_OFF); bf16* Vt = (bf16*)(lds + LV_OFF);
    const int chunk = tid & 7, rowi = tid >> 3;
    float gqv[8], gkv[8];
#pragma unroll
    for (int i = 0; i < 8; ++i) { gqv[i] = gq[chunk * 8 + i] * 0.125f; gkv[i] = gk[chunk * 8 + i]; }
#pragma unroll
    for (int rd = 0; rd < 2; ++rd) { float f[8]; f[0] = bflo(qv[rd].x); f[1] = bfhi(qv[rd].x); f[2] = bflo(qv[rd].y); f[3] = bfhi(qv[rd].y); f[4] = bflo(qv[rd].z); f[5] = bfhi(qv[rd].z); f[6] = bflo(qv[rd].w); f[7] = bfhi(qv[rd].w);
        float ss = 0.f;
#pragma unroll
        for (int i = 0; i < 8; ++i) ss += f[i] * f[i];
        ss += __shfl_xor(ss, 1); ss += __shfl_xor(ss, 2); ss += __shfl_xor(ss, 4);
        const float rs = 1.0f / sqrtf(ss * (1.f / 64.f) + EPS);
        u32x4 w; w.x = pk2(f[0] * rs * gqv[0], f[1] * rs * gqv[1]); w.y = pk2(f[2] * rs * gqv[2], f[3] * rs * gqv[3]); w.z = pk2(f[4] * rs * gqv[4], f[5] * rs * gqv[5]); w.w = pk2(f[6] * rs * gqv[6], f[7] * rs * gqv[7]);
        *(u32x4*)(Qs + (rowi + 64 * rd) * QP + chunk * 8) = w; }
#pragma unroll
    for (int rd = 0; rd < 4; ++rd) { float f[8]; f[0] = bflo(kv[rd].x); f[1] = bfhi(kv[rd].x); f[2] = bflo(kv[rd].y); f[3] = bfhi(kv[rd].y); f[4] = bflo(kv[rd].z); f[5] = bfhi(kv[rd].z); f[6] = bflo(kv[rd].w); f[7] = bfhi(kv[rd].w);
        float ss = 0.f;
#pragma unroll
        for (int i = 0; i < 8; ++i) ss += f[i] * f[i];
        ss += __shfl_xor(ss, 1); ss += __shfl_xor(ss, 2); ss += __shfl_xor(ss, 4);
        const float rs = 1.0f / sqrtf(ss * (1.f / 64.f) + EPS);
        u32x4 w; w.x = pk2(f[0] * rs * gkv[0], f[1] * rs * gkv[1]); w.y = pk2(f[2] * rs * gkv[2], f[3] * rs * gkv[3]); w.z = pk2(f[4] * rs * gkv[4], f[5] * rs * gkv[5]); w.w = pk2(f[6] * rs * gkv[6], f[7] * rs * gkv[7]);
        const int ki = rowi + 64 * rd;
        *(u32x4*)(Ks + ki * QP + chunk * 8) = w;
        bf16* vp = Vt + (chunk * 8) * VP + (ki ^ (chunk << 2));
        vp[0 * VP] = (bf16)(vv[rd].x & 0xffffu); vp[1 * VP] = (bf16)(vv[rd].x >> 16); vp[2 * VP] = (bf16)(vv[rd].y & 0xffffu); vp[3 * VP] = (bf16)(vv[rd].y >> 16);
        vp[4 * VP] = (bf16)(vv[rd].z & 0xffffu); vp[5 * VP] = (bf16)(vv[rd].z >> 16); vp[6 * VP] = (bf16)(vv[rd].w & 0xffffu); vp[7 * VP] = (bf16)(vv[rd].w >> 16); }
}
__device__ __forceinline__ void attn_compute(const AttnItem& A, bf16* QH, float* LSE, unsigned char* lds, int tid) {
    asm volatile("" : "+v"(tid));
    const bf16* Qs = (const bf16*)(lds + LQ_OFF); const bf16* Ks = (const bf16*)(lds + LK_OFF); const bf16* Vt = (const bf16*)(lds + LV_OFF);
    const int n = A.n;
    const int w = tid >> 6, lane = tid & 63, fr = lane & 15, fq = lane >> 4, kt0 = w & ~1;
    bf16x8 qf[2];
#pragma unroll
    for (int kk = 0; kk < 2; ++kk) qf[kk] = *(const bf16x8*)(Qs + (16 * w + fr) * QP + 32 * kk + 8 * fq);
    f32x4 s[10];
#pragma unroll
    for (int t = 0; t < 10; ++t) { s[t] = (f32x4){0.f, 0.f, 0.f, 0.f};
#pragma unroll
        for (int kk = 0; kk < 2; ++kk) { const bf16x8 kf = *(const bf16x8*)(Ks + (16 * (kt0 + t) + fr) * QP + 32 * kk + 8 * fq); s[t] = __builtin_amdgcn_mfma_f32_16x16x32_bf16(kf, qf[kk], s[t], 0, 0, 0); }
        if (t & 1) __builtin_amdgcn_sched_barrier(0); }
    const int qi = 16 * w + fr; float mx = -INFINITY;
    const int dbase = 16 * (kt0 - w) + 4 * fq - fr, kbase = 16 * kt0 + 4 * fq - ((n > 0) ? 0 : 128);
#pragma unroll
    for (int t = 0; t < 10; ++t)
#pragma unroll
        for (int j = 0; j < 4; ++j) { const int dlt = dbase + 16 * t + j; const int bad = (dlt | (128 - dlt) | (kbase + 16 * t + j)) >> 31;
            s[t][j] += __int_as_float(bad & (int)0xff800000); mx = fmaxf(mx, s[t][j]); }
    mx = fmaxf(mx, __shfl_xor(mx, 16)); mx = fmaxf(mx, __shfl_xor(mx, 32));
    float sum = 0.f;
#pragma unroll
    for (int t = 0; t < 10; ++t)
#pragma unroll
        for (int j = 0; j < 4; ++j) { const float p = __builtin_amdgcn_exp2f((s[t][j] - mx) * 1.44269504089f); s[t][j] = p; sum += p; }
    sum += __shfl_xor(sum, 16); sum += __shfl_xor(sum, 32);
    f32x4 o[4];
#pragma unroll
    for (int dt = 0; dt < 4; ++dt) o[dt] = (f32x4){0.f, 0.f, 0.f, 0.f};
#pragma unroll
    for (int jj = 0; jj < 5; ++jj) {
        u32x4 pw; pw.x = pk2(s[2 * jj][0], s[2 * jj][1]); pw.y = pk2(s[2 * jj][2], s[2 * jj][3]); pw.z = pk2(s[2 * jj + 1][0], s[2 * jj + 1][1]); pw.w = pk2(s[2 * jj + 1][2], s[2 * jj + 1][3]);
        const bf16x8 pf = __builtin_bit_cast(bf16x8, pw);
#pragma unroll
        for (int dt = 0; dt < 4; ++dt) { const int dd = 16 * dt + fr, sw = ((dd >> 3) & 7) << 2, kb = 32 * (kt0 / 2 + jj) + 4 * fq;
            const bf16* vr = Vt + dd * VP;
            const u32x2 lo = *(const u32x2*)(vr + (kb ^ sw)), hi = *(const u32x2*)(vr + ((kb + 16) ^ sw)); u32x4 vw; vw.x = lo.x; vw.y = lo.y; vw.z = hi.x; vw.w = hi.y;
            o[dt] = __builtin_amdgcn_mfma_f32_16x16x32_bf16(__builtin_bit_cast(bf16x8, vw), pf, o[dt], 0, 0, 0); }
        __builtin_amdgcn_sched_barrier(0); }
    const float inv = 1.0f / sum;
    const size_t prow = A.qrow0 + qi;
    bf16* op = QH + prow * 64 + 4 * fq;
#pragma unroll
    for (int dt = 0; dt < 4; ++dt) { u32x2 w2; w2.x = pk2(o[dt][0] * inv, o[dt][1] * inv); w2.y = pk2(o[dt][2] * inv, o[dt][3] * inv); *(u32x2*)(op + 16 * dt) = w2; }
    if (fq == 0) LSE[prow] = mx + logf(sum);
}

__device__ __forceinline__ void ssm_s1_item(int item, const bf16* Z, unsigned char* ws, const unsigned char* tab, int tid) {
    const int g = item >> 3, mt = item & 7, w = tid >> 6, lane = tid & 63, fr = lane & 15, fq = lane >> 4, sub = w & 3, nh = w >> 2;
    const int chunk = 64 * mt + 16 * sub + fr;
    const bf16* E = (const bf16*)(tab + TB_E) + (size_t)g * 128 * 512; float* S = (float*)(ws + WS_S);
    const bf16* up = Z + ((size_t)chunk * TC + (fq >> 1)) * UGP + 16 * g + 8 * (fq & 1);
    const bf16* ep = E + (size_t)(64 * nh + fr) * 512 + 8 * fq;
    f32x4 acc[4];
#pragma unroll
    for (int nt = 0; nt < 4; ++nt) acc[nt] = (f32x4){0.f, 0.f, 0.f, 0.f};
#pragma unroll 4
    for (int ks = 0; ks < 16; ++ks) {
        const bf16x8 uf = *(const bf16x8*)(up + (size_t)(2 * ks) * UGP);
#pragma unroll
        for (int nt = 0; nt < 4; ++nt) { const bf16x8 ef = *(const bf16x8*)(ep + (size_t)(16 * nt) * 512 + 32 * ks); acc[nt] = __builtin_amdgcn_mfma_f32_16x16x32_bf16(ef, uf, acc[nt], 0, 0, 0); }
    }
#pragma unroll
    for (int nt = 0; nt < 4; ++nt) *(f32x4*)(S + ((size_t)chunk * 32 + g) * 128 + 64 * nh + 16 * nt + 4 * fq) = acc[nt];
}

__device__ __forceinline__ void ssm_carry_item(int item, unsigned char* ws, const unsigned char* tab, float* L, int tid) {
    const int b = item >> 5, g = item & 31;
    const float* S = (const float*)(ws + WS_S); bf16* XP = (bf16*)(ws + WS_XP); const float* AT = (const float*)(tab + TB_AT) + g * 128;
#pragma unroll 4
    for (int i = 0; i < 16; ++i) { const int idx = i * NTHR + tid, k = idx >> 5, q4 = idx & 31;
        *(f32x4*)(L + k * 128 + 4 * q4) = *(const f32x4*)(S + ((size_t)(b * CHB + k) * 32 + g) * 128 + 4 * q4); }
    __syncthreads();
    if (tid < 64) {
        const int p = tid; const float ar = AT[p], ai = AT[64 + p]; float xr = 0.f, xi = 0.f;
        bf16* xo = XP + ((size_t)(b * CHB) * 32 + g) * 128 + p;
#pragma unroll 8
        for (int k = 0; k < CHB; ++k) {
            xo[(size_t)k * 32 * 128] = (bf16)f2bf(xr); xo[(size_t)k * 32 * 128 + 64] = (bf16)f2bf(xi);
            const float sr = L[k * 128 + p], si = L[k * 128 + 64 + p];
            const float nr = ar * xr - ai * xi + sr, ni = ar * xi + ai * xr + si; xr = nr; xi = ni;
        }
    }
    __syncthreads();
}

__device__ __forceinline__ void phase_merge(const bf16* QH, bf16* Aout, const float* LSE, int vt, int nvt) {
    for (int i = vt; i < MTOK * 64; i += nvt) { const int row = i >> 6, h = (i >> 3) & 7, ch = i & 7, b = row >> 13, t = row & 8191;
        const size_t r0 = ((size_t)(b * 3 + 0) * 8 + h) * 8192 + t;
        const size_t r1 = ((size_t)(b * 3 + 1) * 8 + h) * 8192 + ((t & 3) << 11) + (t >> 2);
        const size_t r2 = ((size_t)(b * 3 + 2) * 8 + h) * 8192 + ((t & 15) << 9) + (t >> 4);
        const float l0 = LSE[r0], l1 = LSE[r1], l2 = LSE[r2];
        const float mx = fmaxf(l0, fmaxf(l1, l2)); float w0 = expf(l0 - mx), w1 = expf(l1 - mx), w2 = expf(l2 - mx); const float inv = 1.0f / (w0 + w1 + w2); w0 *= inv; w1 *= inv; w2 *= inv;
        const u32x4 a0 = *(const u32x4*)(QH + r0 * 64 + ch * 8), a1 = *(const u32x4*)(QH + r1 * 64 + ch * 8), a2 = *(const u32x4*)(QH + r2 * 64 + ch * 8);
        u32x4 o;
        o.x = pk2(w0 * bflo(a0.x) + w1 * bflo(a1.x) + w2 * bflo(a2.x), w0 * bfhi(a0.x) + w1 * bfhi(a1.x) + w2 * bfhi(a2.x));
        o.y = pk2(w0 * bflo(a0.y) + w1 * bflo(a1.y) + w2 * bflo(a2.y), w0 * bfhi(a0.y) + w1 * bfhi(a1.y) + w2 * bfhi(a2.y));
        o.z = pk2(w0 * bflo(a0.z) + w1 * bflo(a1.z) + w2 * bflo(a2.z), w0 * bfhi(a0.z) + w1 * bfhi(a1.z) + w2 * bfhi(a2.z));
        o.w = pk2(w0 * bflo(a0.w) + w1 * bflo(a1.w) + w2 * bflo(a2.w), w0 * bfhi(a0.w) + w1 * bfhi(a1.w) + w2 * bfhi(a2.w));
        *(u32x4*)(Aout + (size_t)row * AW + h * 64 + ch * 8) = o; }
}

__device__ __forceinline__ float gelu_tanh(float y) { const float z = 1.5957691216f * (y + 0.044715f * y * y * y); return y * __builtin_amdgcn_rcpf(1.0f + __builtin_amdgcn_exp2f(-1.44269504089f * z)); }
__device__ __forceinline__ void ssm_s3_item(int item, const float* dskip, const bf16* Z, bf16* Y, unsigned char* ws, const unsigned char* tab, int tid) {
    const int g = item >> 3, mt = item & 7, w = tid >> 6, lane = tid & 63, fr = lane & 15, fq = lane >> 4;
    const bf16* KT = (const bf16*)(tab + TB_KT) + (size_t)g * 32 * 256; const bf16* P = (const bf16*)(tab + TB_P) + (size_t)g * 512 * 128; const bf16* XP = (const bf16*)(ws + WS_XP);
    const float* dsk = dskip + g * 16 + 4 * fq;
    const float d0 = dsk[0], d1 = dsk[1], d2 = dsk[2], d3 = dsk[3];
    const int chunk0 = 64 * mt + fr;
    const int shalf = fq >> 1, c20 = 8 * (fq & 1);
#pragma unroll 1
    for (int ti = 0; ti < 4; ++ti) {
        const int t = (ti == 0) ? w : (ti == 1) ? 15 - w : (ti == 2) ? 16 + w : 31 - w;
        f32x4 acc[4];
#pragma unroll
        for (int mi = 0; mi < 4; ++mi) acc[mi] = (f32x4){0.f, 0.f, 0.f, 0.f};
        const int nks = (t >> 1) + 1;
#pragma unroll 2
        for (int ks = 0; ks < nks; ++ks) {
            const int s = 2 * ks + shalf, lag = t - s;
            bf16x8 wf = (bf16x8){0, 0, 0, 0, 0, 0, 0, 0};
            if (lag >= 0) wf = *(const bf16x8*)(KT + (size_t)lag * 256 + fr * 16 + c20);
#pragma unroll
            for (int mi = 0; mi < 4; ++mi) { const bf16x8 uf = *(const bf16x8*)(Z + ((size_t)(chunk0 + 16 * mi) * TC + s) * UGP + 16 * g + c20);
                acc[mi] = __builtin_amdgcn_mfma_f32_16x16x32_bf16(wf, uf, acc[mi], 0, 0, 0); }
        }
#pragma unroll
        for (int k2 = 0; k2 < 4; ++k2) {
            const bf16x8 wf = *(const bf16x8*)(P + (size_t)(t * 16 + fr) * 128 + 32 * k2 + 8 * fq);
#pragma unroll
            for (int mi = 0; mi < 4; ++mi) { const bf16x8 xf = *(const bf16x8*)(XP + ((size_t)(chunk0 + 16 * mi) * 32 + g) * 128 + 32 * k2 + 8 * fq);
                acc[mi] = __builtin_amdgcn_mfma_f32_16x16x32_bf16(wf, xf, acc[mi], 0, 0, 0); }
        }
#pragma unroll
        for (int mi = 0; mi < 4; ++mi) { const size_t tok = (size_t)(chunk0 + 16 * mi) * TC + t;
            const u32x2 uu = *(const u32x2*)(Z + tok * UGP + 16 * g + 4 * fq);
            const float y0 = acc[mi][0] + d0 * bflo(uu.x), y1 = acc[mi][1] + d1 * bfhi(uu.x), y2 = acc[mi][2] + d2 * bflo(uu.y), y3 = acc[mi][3] + d3 * bfhi(uu.y);
            u32x2 o; o.x = pk2(gelu_tanh(y0), gelu_tanh(y1)); o.y = pk2(gelu_tanh(y2), gelu_tanh(y3));
            *(u32x2*)(Y + tok * AW + 16 * g + 4 * fq) = o; }
    }
}


#define XB_TMO      128
#define XB_XCNT(j)  (256  + 64 * (j))
#define XB_XSUB(j)  (1280 + 64 * (j))
#define XB_XGEN(j)  (2304 + 64 * (j))
#define XB_TOP      3328
#define XB_TOPGEN   3392
#define XCD_BAR_WORDS 3456
#define XB_SPIN_CAP (1u << 20)
__device__ __forceinline__ unsigned xb_ld(unsigned* p)              { return __hip_atomic_load(p, __ATOMIC_RELAXED, __HIP_MEMORY_SCOPE_AGENT); }
__device__ __forceinline__ unsigned xb_add(unsigned* p, unsigned v) { return __hip_atomic_fetch_add(p, v, __ATOMIC_RELAXED, __HIP_MEMORY_SCOPE_AGENT); }
__device__ __forceinline__ unsigned xb_xcc_id() { return (unsigned)__builtin_amdgcn_s_getreg((3 << 11) | 20) & 0xFu; }
#define XB_SPIN(cond, bar) do { unsigned _sp = 0; while (cond) { __builtin_amdgcn_s_sleep(1); \
    if ((++_sp & 255u) == 0u) { if (xb_ld(&(bar)[XB_TMO])) break; if (_sp > XB_SPIN_CAP) { atomicAdd(&(bar)[XB_TMO], 1u); break; } } } } while (0)
struct XcdBarrier { unsigned* bar; unsigned x; volatile LAS unsigned* st; };
__device__ __forceinline__ XcdBarrier xcd_barrier_post(unsigned* bar, volatile LAS unsigned* st) {
    XcdBarrier b; b.bar = bar; b.x = xb_xcc_id(); b.st = st;
    if (threadIdx.x == 0) (void)xb_add(&bar[XB_XCNT(b.x)], 1u);
    return b;
}
__device__ __forceinline__ void xcd_barrier_complete(unsigned* bar, unsigned x, unsigned& nloc, unsigned& nx) {
    const unsigned G = gridDim.x * gridDim.y * gridDim.z;
    unsigned sum, cnt, mine, sp = 0u;
    for (;;) {
        sum = 0u; cnt = 0u; mine = 0u;
#pragma unroll
        for (unsigned j = 0; j < 16; ++j) { const unsigned c = xb_ld(&bar[XB_XCNT(j)]); sum += c; cnt += (c > 0u) ? 1u : 0u; mine = (j == x) ? c : mine; }
        if (sum == G) break;
        __builtin_amdgcn_s_sleep(1);
        if ((++sp & 255u) == 0u) { if (xb_ld(&bar[XB_TMO])) break; if (sp > XB_SPIN_CAP) { atomicAdd(&bar[XB_TMO], 1u); break; } }
    }
    nloc = mine > 0u ? mine : 1u; nx = cnt > 0u ? cnt : 1u;
}
__device__ __forceinline__ void xcd_barrier(const XcdBarrier& b) {
    asm volatile("s_waitcnt vmcnt(0)" ::: "memory");
    __syncthreads();
    if (threadIdx.x == 0) {
        unsigned* bar = b.bar;
        __builtin_amdgcn_s_waitcnt(0);
        unsigned nloc = b.st[0], nx = b.st[1];
        if (nloc == 0u) { xcd_barrier_complete(bar, b.x, nloc, nx); b.st[0] = nloc; b.st[1] = nx; }
        const unsigned old = xb_add(&bar[XB_XSUB(b.x)], 1u);
        const unsigned gen = old / nloc;
        if (old + 1u == (gen + 1u) * nloc) {
            __builtin_amdgcn_fence(__ATOMIC_RELEASE, "agent");
            asm volatile("s_waitcnt vmcnt(0)" ::: "memory");
            const unsigned og = xb_add(&bar[XB_TOP], 1u);
            const unsigned tg = og / nx;
            if (og + 1u == (tg + 1u) * nx) xb_add(&bar[XB_TOPGEN], 1u);
            else XB_SPIN(xb_ld(&bar[XB_TOPGEN]) == tg, bar);
            __builtin_amdgcn_fence(__ATOMIC_ACQUIRE, "agent");
            xb_add(&bar[XB_XGEN(b.x)], 1u);
            asm volatile("s_waitcnt vmcnt(0)" ::: "memory");
        } else {
            XB_SPIN(xb_ld(&bar[XB_XGEN(b.x)]) == gen, bar);
            __builtin_amdgcn_fence(__ATOMIC_ACQUIRE, "agent");
            asm volatile("s_waitcnt vmcnt(0)" ::: "memory");
        }
    }
    __syncthreads();
}

constexpr int KPL = 8, N_PHASES = 1 + KPL * DEPTH;
__global__ void __launch_bounds__(NTHR, 2) mega_fwd(Args a) {
    extern __shared__ __attribute__((aligned(16))) unsigned char lds[];
    cg::grid_group grid = cg::this_grid();
    LAS unsigned char* ldsl = (LAS unsigned char*)lds;
    volatile LAS unsigned* bst = (volatile LAS unsigned*)(ldsl + 131072);
    if (threadIdx.x < 2) bst[threadIdx.x] = 0u;
    __syncthreads();
    XcdBarrier xbar; xbar.bar = (unsigned*)a.ws; xbar.x = 0; xbar.st = bst;
    if (a.ph_hi - a.ph_lo > 1) xbar = xcd_barrier_post((unsigned*)a.ws, bst);
    int prep = 0;
    for (int ph = a.ph_lo; ph < a.ph_hi; ++ph) {
        int zero; asm volatile("s_mov_b32 %0, 0" : "=s"(zero));
        int tid = threadIdx.x; asm volatile("" : "+v"(tid));
        const int lane = tid & 63, wave = __builtin_amdgcn_readfirstlane(tid >> 6);
        const int G = (int)gridDim.x + zero, bx = (int)blockIdx.x + zero;
        const int gw = bx * NWAVES + wave, ngw = G * NWAVES;
        unsigned char* ws = a.ws + zero; float* outp = a.out + zero;
        bf16* WB = (bf16*)(ws + WS_WB); bf16* QH = (bf16*)(ws + WS_Z); bf16* UG = (bf16*)(ws + WS_Z + 144 * MiB); bf16* AK = QH + QPLANE; bf16* ACT = (bf16*)(ws + WS_ACT); bf16* Y = (bf16*)(ws + WS_Y); float* LSE = (float*)(ws + WS_LSE);
        bf16* MIX = QH;
        float* SS1 = (float*)(ws + WS_S); float* SS2 = (float*)(ws + WS_S + MiB);
        if (ph == 0) {
            for (int rep = 0; rep < NREP(15); ++rep) phase_weights(a, zero, WB, (float*)lds, gw, ngw, wave, lane);
            __syncthreads();
            for (int rep = 0; rep < NREP(12); ++rep) {
            for (int g = bx; g < 32; g += G) ssm_pre_item(a, zero, 0, g, ws + WS_TAB, (float*)lds, tid);
            phase_xprep(a.in[zero], ACT, SS2, gw, ngw, lane); }
        } else {
            const int l = (ph - 1) / KPL, k = (ph - 1) % KPL;
            const bf16* wl = WB + (size_t)l * LAYER_W;
            const float* xin = (l == 0) ? a.in[zero] : outp;
            unsigned char* tab = ws + WS_TAB + (size_t)(l & 1) * TAB_STRIDE;
            if (k == 0) {
                pg8::Gemm gm{ACT, wl + OFF_IN, MTOK, INC, DM, DM}; pg8::StaticOrder S; S.init(MTOK, INC, G, bx);
                PG8_LAS float* rst = (PG8_LAS float*)(ldsl + 131088); int pbase = 0;
                { pg8::Unit u0; if (S.next(0, u0)) { pbase = (u0.pm & ~7) * 256; for (int i = tid; i < 2048; i += NTHR) rst[i] = pg8::row_rstd(SS2, (size_t)(pbase + i)); } }
                __syncthreads();
                pg8::EpiZ E{QH, UG, SS2, rst, pbase};
                pg8::gemm_phase<pg8::EpiZ, pg8::StaticOrder, true, true>(ldsl, tid, gm, S, E);
            } else if (k == 1) {
                const float* gq = a.in[3 + zero] + l * 64; const float* gk = a.in[4 + zero] + l * 64;
                u32x4 qv[2], kv[4], vv[4];
#pragma unroll
                for (int i = 0; i < 4; ++i) { qv[i & 1] = (u32x4){0u, 0u, 0u, 0u}; kv[i] = (u32x4){0u, 0u, 0u, 0u}; vv[i] = (u32x4){0u, 0u, 0u, 0u}; }
                for (int arep = 0; arep < (REP_ATT ? 2 : 1); ++arep) {
                bf16* OD = (REP_ATT && arep == 0) ? ACT : QH;
                if (bx < 3072) { const AttnItem A0 = attn_decode(bx); attn_load(A0, QH, tid, qv, kv, vv); }
                for (int it = bx; it < 3072; it += G) {
                    const AttnItem A = attn_decode(it);
                    attn_stage(gq, gk, lds, tid, qv, kv, vv);
                    __builtin_amdgcn_sched_barrier(0);
                    __syncthreads();
                    if (it + G < 3072) { const AttnItem An = attn_decode(it + G); attn_load(An, QH, tid, qv, kv, vv); }
                    __builtin_amdgcn_sched_barrier(0);
                    attn_compute(A, OD, LSE, lds, tid);
                    __builtin_amdgcn_sched_barrier(0);
                    __syncthreads();
                }
                }
                for (int it = bx; it < 256; it += G) for (int rep = 0; rep < NREP(2); ++rep) ssm_s1_item(it, UG, ws, tab, tid);
            } else if (k == 2) {
                if (G >= 256) {
                    if (bx < 64) { for (int rep = 0; rep < NREP(3); ++rep) ssm_carry_item(bx, ws, tab, (float*)lds, tid); }
                    else if (bx < 96) { if (l + 1 < DEPTH) for (int rep = 0; rep < NREP(11); ++rep) ssm_pre_item(a, zero, l + 1, bx - 64, ws + WS_TAB + (size_t)((l + 1) & 1) * TAB_STRIDE, (float*)lds, tid); }
                    else { for (int rep = 0; rep < NREP(10); ++rep) phase_merge(QH, AK, LSE, (bx - 96) * NTHR + tid, (G - 96) * NTHR); }
                } else {
                    for (int it = bx; it < 64; it += G) ssm_carry_item(it, ws, tab, (float*)lds, tid);
                    if (l + 1 < DEPTH) for (int g = bx; g < 32; g += G) ssm_pre_item(a, zero, l + 1, g, ws + WS_TAB + (size_t)((l + 1) & 1) * TAB_STRIDE, (float*)lds, tid);
                    phase_merge(QH, AK, LSE, bx * NTHR + tid, G * NTHR);
                }
            } else if (k == 3) {
                const float* dskip = a.in[13 + zero] + l * 512;
                for (int rep = 0; rep < NREP(4); ++rep) for (int it = bx; it < 256; it += G) ssm_s3_item(it, dskip, UG, Y, ws, tab, tid);
            } else if (k == 4) {
                { pg8::Gemm gm{AK, wl + OFF_P, MTOK, DM, AW, AW}; pg8::StaticOrder S; S.init(MTOK, DM, G, bx);
                  pg8::EpiGate1 E{MIX, DM, UG + 512, UGP};
                  pg8::gemm_phase<pg8::EpiGate1, pg8::StaticOrder, true, true>(ldsl, tid, gm, S, E); }
                { pg8::Gemm gm{Y, wl + OFF_GLU, MTOK, 2 * DM, AW, AW}; pg8::PairOrder S; S.base.init(MTOK, DM, G, bx);
                  pg8::EpiGlu E{MIX, DM, UG + 1536, UGP};
                  pg8::gemm_phase<pg8::EpiGlu, pg8::PairOrder, true, true>(ldsl, tid, gm, S, E); }
            } else if (k == 5) {
                pg8::Gemm gm{MIX, wl + OFF_OUT, MTOK, DM, DM, DM}; pg8::StaticOrder S; S.init(MTOK, DM, G, bx);
                pg8::EpiResid E{xin, outp, DM, ACT, SS1};
                pg8::gemm_phase<pg8::EpiResid, pg8::StaticOrder, true, true>(ldsl, tid, gm, S, E);
            } else if (k == 6) {
                pg8::Gemm gm{ACT, wl + OFF_GU, MTOK, 2 * DFF, DM, DM}; pg8::StaticOrder S; S.init(MTOK, 2 * DFF, G, bx);
                PG8_LAS float* rst = (PG8_LAS float*)(ldsl + 131088); int pbase = 0;
                { pg8::Unit u0; if (S.next(0, u0)) { pbase = (u0.pm & ~7) * 256; for (int i = tid; i < 2048; i += NTHR) rst[i] = pg8::row_rstd(SS1, (size_t)(pbase + i)); } }
                __syncthreads();
                pg8::EpiSwiglu E{QH, DFF, SS1, rst, pbase};
                pg8::gemm_phase<pg8::EpiSwiglu, pg8::StaticOrder, true, true>(ldsl, tid, gm, S, E);
            } else {
                pg8::Gemm gm{QH, wl + OFF_DN, MTOK, DM, DFF, DFF}; pg8::StaticOrder S; S.init(MTOK, DM, G, bx);
                pg8::EpiResid E{outp, outp, DM, ACT, SS2};
                pg8::gemm_phase<pg8::EpiResid, pg8::StaticOrder, true, true>(ldsl, tid, gm, S, E);
            }
        }
        if (REP_PH != 0 && ph > 0 && ((REP_PH >> ((ph - 1) % KPL)) & 1) && prep == 0) { prep = 1; --ph; xcd_barrier(xbar); continue; }
        prep = 0;
        if (ph + 1 < a.ph_hi) { if (ph == a.ph_lo) grid.sync(); else { for (int sx = 0; sx < SYNC_X; ++sx) xcd_barrier(xbar); } }
    }
}

extern "C" void kernel_launch(void* const* d_in, const int* in_sizes, int n_in, void* d_out, int out_size, void* d_ws, size_t ws_size, hipStream_t stream) {
    static int grid = 0;
    if (grid == 0) {
        if (n_in != 21 || in_sizes[0] != MTOK * DM || out_size != MTOK * DM || ws_size < WS_END) { fprintf(stderr, "kernel_launch: unexpected shapes / workspace (n_in %d, ws %zu)\n", n_in, ws_size); grid = -1; return; }
        int dev = 0, cus = 0, per_cu = 0;
        (void)hipGetDevice(&dev); (void)hipDeviceGetAttribute(&cus, hipDeviceAttributeMultiprocessorCount, dev);
        (void)hipFuncSetAttribute((const void*)mega_fwd, hipFuncAttributeMaxDynamicSharedMemorySize, LDS_BYTES);
        (void)hipOccupancyMaxActiveBlocksPerMultiprocessor(&per_cu, (const void*)mega_fwd, NTHR, LDS_BYTES);
        if (per_cu < 1) per_cu = 1;
        (void)hipGetLastError();
        grid = cus * per_cu;
    }
    if (grid < 0) return;
    (void)hipMemsetAsync(d_ws, 0, 16384, stream);
    Args a{};
    for (int i = 0; i < 21; ++i) a.in[i] = (const float*)d_in[i];
    a.out = (float*)d_out; a.ws = (unsigned char*)d_ws;
#if MK_SINGLE
    a.ph_lo = 0; a.ph_hi = N_PHASES;
    void* args[] = {&a};
    hipError_t e = hipLaunchCooperativeKernel((const void*)mega_fwd, dim3(grid), dim3(NTHR), args, LDS_BYTES, stream);
    if (e != hipSuccess) fprintf(stderr, "cooperative launch failed: %s (grid %d)\n", hipGetErrorString(e), grid);
#else
    for (int ph = 0; ph < N_PHASES; ++ph) { a.ph_lo = ph; a.ph_hi = ph + 1; hipLaunchKernelGGL(mega_fwd, dim3(grid), dim3(NTHR), LDS_BYTES, stream, a); }
#endif
}
```

```cpp
#include <hip/hip_runtime.h>
#include <hip/hip_cooperative_groups.h>
#include <cstdio>
#include <cstdint>
namespace cg = cooperative_groups;

#ifndef REP_MASK
#define REP_MASK 0
#endif
#ifndef REP_PH
#define REP_PH 0
#endif
#ifndef REP_ATT
#define REP_ATT 0
#endif
#ifndef SYNC_X
#define SYNC_X 1
#endif
#define NREP(k) (((REP_MASK >> (k)) & 1) ? 2 : 1)
#ifndef MK_SINGLE
#define MK_SINGLE 1
#endif

namespace pg8 {
#define PG8_LAS __attribute__((address_space(3)))
typedef unsigned short bf16_t;
typedef short bf16x8 __attribute__((ext_vector_type(8)));
typedef float f32x4 __attribute__((ext_vector_type(4)));
typedef unsigned u32x4 __attribute__((ext_vector_type(4)));
constexpr int BM = 256, BK = 64, HALF = 128, HTB = HALF * BK * 2, STAGE_BYTES = 8 * HTB, NXCD = 8, WGM = 8;

__host__ __device__ __forceinline__ int lds_byte(int r, int c) { const int st = (r >> 4) * 2 + (c >> 5), rr = r & 15, cc = c & 31, ob = rr * 64 + cc * 2; return st * 1024 + (ob ^ (((ob >> 9) & 1) << 5)); }
__host__ __device__ __forceinline__ void stage_rc(int b, int& R, int& C) { const int st = b / 1024, sb = b % 1024, swz = sb ^ (((sb >> 9) & 1) << 5); R = (st >> 1) * 16 + swz / 64; C = (st & 1) * 32 + (swz % 64) / 2; }
__host__ __device__ __forceinline__ int perm32(int rho) { const int n = rho >> 4, i = rho & 15; return 8 * (i >> 2) + 4 * n + (i & 3); }

struct Unit { int pm, pn; };
struct Gemm { const bf16_t* A; const bf16_t* Bt; int M, N, K, lda; };

struct StaticOrder {
    int nM, nN, nwg, G, c;
    __host__ __device__ void init(int M, int N, int G_, int c_) { nM = M / BM; nN = N / BM; nwg = nM * nN; G = G_; c = c_; }
    __host__ __device__ bool next(int i, Unit& u) const {
        const long L = (long)i * G + c; if (L >= nwg) return false;
        int wgid = (int)L; { const int q = nwg / NXCD, r = nwg % NXCD, xcd = wgid % NXCD, off = wgid / NXCD; wgid = (xcd < r ? xcd * (q + 1) : r * (q + 1) + (xcd - r) * q) + off; }
        const int nig = WGM * nN, gid = wgid / nig, fm = gid * WGM, gsz = (nM - fm) < WGM ? (nM - fm) : WGM;
        u.pm = fm + ((wgid % nig) % gsz); u.pn = (wgid % nig) / gsz; return true;
    }
    __device__ __forceinline__ void a_ready(const Unit&) const {}
    __device__ __forceinline__ void done(const Unit&) const {}
};
struct PairOrder {
    StaticOrder base;
    __host__ __device__ bool next(int i, Unit& u) const { Unit b; if (!base.next(i >> 1, b)) return false; u.pm = b.pm; u.pn = 2 * b.pn + (i & 1); return true; }
    __device__ __forceinline__ void a_ready(const Unit&) const {}
    __device__ __forceinline__ void done(const Unit&) const {}
};

typedef float f32x2c_ __attribute__((ext_vector_type(2))); typedef __bf16 bf16x2c_ __attribute__((ext_vector_type(2)));
__device__ __forceinline__ unsigned cvt_pk_bf16(float lo, float hi) { const f32x2c_ v = {lo, hi}; const bf16x2c_ b = __builtin_convertvector(v, bf16x2c_); return __builtin_bit_cast(unsigned, b); }
__device__ __forceinline__ float bf_lo(unsigned w) { return __uint_as_float(w << 16); }
__device__ __forceinline__ float bf_hi(unsigned w) { return __uint_as_float(w & 0xffff0000u); }
__device__ __forceinline__ float sigmoidf_(float x) { return __builtin_amdgcn_rcpf(1.0f + __builtin_amdgcn_exp2f(-1.44269504089f * x)); }

__device__ __forceinline__ float row_rstd(const float* SSP, size_t row) {
    const f32x4* p = (const f32x4*)(SSP + row * 16); const f32x4 a = p[0], b = p[1], c = p[2], d = p[3];
    const float ss = ((a[0] + a[1]) + (a[2] + a[3])) + ((b[0] + b[1]) + (b[2] + b[3])) + ((c[0] + c[1]) + (c[2] + c[3])) + ((d[0] + d[1]) + (d[2] + d[3]));
    return rsqrtf(ss * (1.0f / 1024.0f) + 1e-6f);
}
struct EpiZ {
    static constexpr bool PERM = true, AFTER_DRAIN = false;
    bf16_t* QH; bf16_t* UG; bf16_t* UH; const float* SS; const PG8_LAS float* rst; int pbase;
    __device__ __forceinline__ void operator()(const f32x4 (&acc)[2][2][4][2], const Unit& u, int wr, int wc, int fr, int fq) const {
        const int row0 = u.pm * BM + wr * 64 + fr;
        float rs[2][4];
#pragma unroll
        for (int ai = 0; ai < 2; ++ai)
#pragma unroll
            for (int m = 0; m < 4; ++m) { const int rr = row0 + ai * HALF + m * 16, rl = rr - pbase; rs[ai][m] = ((unsigned)rl < 2048u) ? rst[rl] : row_rstd(SS, (size_t)rr); }
        if (u.pn < 18) {
            const int which = u.pn / 6, colt = (u.pn % 6) * 256;
#pragma unroll
            for (int bj = 0; bj < 2; ++bj) { const int col = colt + bj * HALF + wc * 32 + 8 * fq, gi = col >> 9, h = (col >> 6) & 7, e = col & 63, dsh = 2 * gi;
#pragma unroll
                for (int ai = 0; ai < 2; ++ai)
#pragma unroll
                    for (int m = 0; m < 4; ++m) { const int row = row0 + ai * HALF + m * 16, b = row >> 13, t = row & 8191, idx = ((t & ((1 << dsh) - 1)) << (13 - dsh)) + (t >> dsh);
                        const f32x4 v0 = acc[ai][bj][m][0] * rs[ai][m], v1 = acc[ai][bj][m][1] * rs[ai][m];
                        u32x4 w; w.x = cvt_pk_bf16(v0[0], v0[1]); w.y = cvt_pk_bf16(v0[2], v0[3]); w.z = cvt_pk_bf16(v1[0], v1[1]); w.w = cvt_pk_bf16(v1[2], v1[3]);
                        *(u32x4*)(QH + ((((size_t)(which * 2 + b) * 3 + gi) * 8 + h) * 8192 + idx) * 64 + e) = w; } }
        } else if (u.pn < 20) {
#pragma unroll
            for (int bj = 0; bj < 2; ++bj) { const int col = (u.pn - 18) * BM + bj * HALF + wc * 32 + 8 * fq, g = col >> 4, c0 = col & 15;
#pragma unroll
                for (int ai = 0; ai < 2; ++ai)
#pragma unroll
                    for (int m = 0; m < 4; ++m) { const int row = row0 + ai * HALF + m * 16;
                        const f32x4 v0 = acc[ai][bj][m][0] * rs[ai][m], v1 = acc[ai][bj][m][1] * rs[ai][m];
                        u32x4 w; w.x = cvt_pk_bf16(v0[0], v0[1]); w.y = cvt_pk_bf16(v0[2], v0[3]); w.z = cvt_pk_bf16(v1[0], v1[1]); w.w = cvt_pk_bf16(v1[2], v1[3]);
                        *(u32x4*)(UH + ((size_t)g * 16384 + row) * 16 + c0) = w; } }
        } else {
            const int col0 = (u.pn - 20) * BM + wc * 32 + 8 * fq;
#pragma unroll
            for (int ai = 0; ai < 2; ++ai)
#pragma unroll
                for (int m = 0; m < 4; ++m) { bf16_t* rowp = UG + (size_t)(row0 + ai * HALF + m * 16) * 2048 + col0;
#pragma unroll
                    for (int bj = 0; bj < 2; ++bj) { f32x4 v0 = acc[ai][bj][m][0] * rs[ai][m], v1 = acc[ai][bj][m][1] * rs[ai][m];
#pragma unroll
                        for (int j = 0; j < 4; ++j) { v0[j] = sigmoidf_(v0[j]); v1[j] = sigmoidf_(v1[j]); }
                        u32x4 w; w.x = cvt_pk_bf16(v0[0], v0[1]); w.y = cvt_pk_bf16(v0[2], v0[3]); w.z = cvt_pk_bf16(v1[0], v1[1]); w.w = cvt_pk_bf16(v1[2], v1[3]);
                        *(u32x4*)(rowp + bj * HALF) = w; } }
        }
    }
};
struct EpiGate1 {
    static constexpr bool PERM = true, AFTER_DRAIN = false;
    bf16_t* O; int ldc; const bf16_t* G; int ldg;
    __device__ __forceinline__ void operator()(const f32x4 (&acc)[2][2][4][2], const Unit& u, int wr, int wc, int fr, int fq) const {
        const int row0 = u.pm * BM + wr * 64 + fr, col0 = u.pn * BM + wc * 32 + 8 * fq;
#pragma unroll
        for (int ai = 0; ai < 2; ++ai)
#pragma unroll
            for (int m = 0; m < 4; ++m) { const size_t r = (size_t)(row0 + ai * HALF + m * 16);
#pragma unroll
                for (int bj = 0; bj < 2; ++bj) { const f32x4 v0 = acc[ai][bj][m][0], v1 = acc[ai][bj][m][1];
                    const u32x4 g = *(const u32x4*)(G + r * ldg + col0 + bj * HALF);
                    u32x4 w; w.x = cvt_pk_bf16(v0[0] * bf_lo(g.x), v0[1] * bf_hi(g.x)); w.y = cvt_pk_bf16(v0[2] * bf_lo(g.y), v0[3] * bf_hi(g.y));
                    w.z = cvt_pk_bf16(v1[0] * bf_lo(g.z), v1[1] * bf_hi(g.z)); w.w = cvt_pk_bf16(v1[2] * bf_lo(g.w), v1[3] * bf_hi(g.w));
                    *(u32x4*)(O + r * ldc + col0 + bj * HALF) = w; }
                asm volatile("" ::: "memory"); }
    }
};
struct EpiGlu {
    static constexpr bool PERM = true, AFTER_DRAIN = false;
    bf16_t* O; int ldc; const bf16_t* G; int ldg;
    __device__ __forceinline__ void operator()(const f32x4 (&acc)[2][2][4][2], const Unit& u, int wr, int wc, int fr, int fq) const {
        const int row0 = u.pm * BM + wr * 64 + fr, col0 = u.pn * HALF + wc * 32 + 8 * fq;
#pragma unroll
        for (int ai = 0; ai < 2; ++ai)
#pragma unroll
            for (int m = 0; m < 4; ++m) { const size_t r = (size_t)(row0 + ai * HALF + m * 16);
                const u32x4 g = *(const u32x4*)(G + r * ldg + col0); const u32x4 t = *(const u32x4*)(O + r * ldc + col0);
                const f32x4 a0 = acc[ai][0][m][0], a1 = acc[ai][0][m][1], b0 = acc[ai][1][m][0], b1 = acc[ai][1][m][1];
                u32x4 w;
                w.x = cvt_pk_bf16(bf_lo(t.x) + bf_lo(g.x) * a0[0] * sigmoidf_(b0[0]), bf_hi(t.x) + bf_hi(g.x) * a0[1] * sigmoidf_(b0[1]));
                w.y = cvt_pk_bf16(bf_lo(t.y) + bf_lo(g.y) * a0[2] * sigmoidf_(b0[2]), bf_hi(t.y) + bf_hi(g.y) * a0[3] * sigmoidf_(b0[3]));
                w.z = cvt_pk_bf16(bf_lo(t.z) + bf_lo(g.z) * a1[0] * sigmoidf_(b1[0]), bf_hi(t.z) + bf_hi(g.z) * a1[1] * sigmoidf_(b1[1]));
                w.w = cvt_pk_bf16(bf_lo(t.w) + bf_lo(g.w) * a1[2] * sigmoidf_(b1[2]), bf_hi(t.w) + bf_hi(g.w) * a1[3] * sigmoidf_(b1[3]));
                *(u32x4*)(O + r * ldc + col0) = w; asm volatile("" ::: "memory"); }
    }
};
struct EpiSwiglu {
    static constexpr bool PERM = true, AFTER_DRAIN = false;
    bf16_t* O; int ldc; const float* SS; const PG8_LAS float* rst; int pbase;
    __device__ __forceinline__ void operator()(const f32x4 (&acc)[2][2][4][2], const Unit& u, int wr, int wc, int fr, int fq) const {
        const int row0 = u.pm * BM + wr * 64 + fr, col0 = u.pn * HALF + wc * 32 + 8 * fq;
#pragma unroll
        for (int ai = 0; ai < 2; ++ai)
#pragma unroll
            for (int m = 0; m < 4; ++m) { const size_t r = (size_t)(row0 + ai * HALF + m * 16);
                const int rl = (int)r - pbase; const float rs = ((unsigned)rl < 2048u) ? rst[rl] : row_rstd(SS, r);
                const f32x4 a0 = acc[ai][0][m][0] * rs, a1 = acc[ai][0][m][1] * rs, b0 = acc[ai][1][m][0] * rs, b1 = acc[ai][1][m][1] * rs;
                u32x4 w;
                w.x = cvt_pk_bf16(a0[0] * sigmoidf_(a0[0]) * b0[0], a0[1] * sigmoidf_(a0[1]) * b0[1]);
                w.y = cvt_pk_bf16(a0[2] * sigmoidf_(a0[2]) * b0[2], a0[3] * sigmoidf_(a0[3]) * b0[3]);
                w.z = cvt_pk_bf16(a1[0] * sigmoidf_(a1[0]) * b1[0], a1[1] * sigmoidf_(a1[1]) * b1[1]);
                w.w = cvt_pk_bf16(a1[2] * sigmoidf_(a1[2]) * b1[2], a1[3] * sigmoidf_(a1[3]) * b1[3]);
                *(u32x4*)(O + r * ldc + col0) = w; }
    }
};
struct EpiResid {
    static constexpr bool PERM = false, AFTER_DRAIN = false;
    const float* R; float* C; int ldc; bf16_t* XB; float* SS;
    __device__ __forceinline__ void operator()(const f32x4 (&acc)[2][2][4][2], const Unit& u, int wr, int wc, int fr, int fq) const {
        const int row0 = u.pm * BM + wr * 64 + fr, col0 = u.pn * BM + wc * 32 + 4 * fq;
#pragma unroll
        for (int ai = 0; ai < 2; ++ai)
#pragma unroll
            for (int m = 0; m < 4; ++m) { const int row = row0 + ai * HALF + m * 16; const size_t off = (size_t)row * ldc + col0; float ss = 0.f;
#pragma unroll
                for (int bj = 0; bj < 2; ++bj)
#pragma unroll
                    for (int n = 0; n < 2; ++n) { const f32x4 rv = *(const f32x4*)(R + off + bj * HALF + n * 16); const f32x4 o = acc[ai][bj][m][n] + rv; *(f32x4*)(C + off + bj * HALF + n * 16) = o;
                        ss += (o[0] * o[0] + o[1] * o[1]) + (o[2] * o[2] + o[3] * o[3]);
                        unsigned w0 = cvt_pk_bf16(o[0], o[1]), w1 = cvt_pk_bf16(o[2], o[3]); typedef unsigned u32x2_ __attribute__((ext_vector_type(2))); *(u32x2_*)(XB + off + bj * HALF + n * 16) = (u32x2_){w0, w1}; }
                ss += __shfl_xor(ss, 16); ss += __shfl_xor(ss, 32);
                if (fq == 0) SS[(size_t)row * 16 + u.pn * 4 + wc] = ss;
                asm volatile("" ::: "memory"); }
    }
};

template <class Epi, class Sched, bool ALIGN_EPI = false, bool SP2 = false>
__device__ __forceinline__ void gemm_phase(PG8_LAS unsigned char* lds, const int tid, const Gemm g, const Sched& S, const Epi& E) {
    const int wid = __builtin_amdgcn_readfirstlane(tid >> 6), lane = tid & 63, wr = wid >> 2, wc = wid & 3, fr = lane & 15, fq = lane >> 4;
    const int K = g.K, nt = K / BK, lda = g.lda;
    unsigned voffA[2], voffB[2];
#pragma unroll
    for (int i = 0; i < 2; ++i) { int R, C; stage_rc(tid * 16 + i * 8192, R, C); const int Rb = Epi::PERM ? ((R & ~31) + perm32(R & 31)) : R;
        voffA[i] = (unsigned)(R * lda + C) * 2u; voffB[i] = (unsigned)(Rb * K + C) * 2u; }
    const size_t kstep = (size_t)(BK * 2);
    const size_t hA = (size_t)HALF * lda * 2, hB = (size_t)HALF * K * 2;
    const size_t tA = 2 * hA, tB = 2 * hB;
    const unsigned ldsw = (unsigned)wid * 1024u;
    const int aoff = lds_byte(wr * 64 + fr, fq * 8), boff = lds_byte(wc * 32 + fr, fq * 8);
#define PG8_SA(b, h) (((b) * 2 + (h)) * HTB)
#define PG8_SB(b, h) ((4 + (b) * 2 + (h)) * HTB)
#define PG8_STAGE(bufoff, gbase, voff) do { _Pragma("unroll") for (int _i = 0; _i < 2; ++_i) \
        __builtin_amdgcn_global_load_lds((const unsigned*)((const char*)(gbase) + (voff)[_i]), (PG8_LAS unsigned*)(lds + (bufoff) + ldsw + _i * 8192), 16, 0, 0); } while (0)
#define PG8_LDA(dst, b, h) do { _Pragma("unroll") for (int m = 0; m < 4; ++m) _Pragma("unroll") for (int k = 0; k < 2; ++k) dst[m][k] = *(const PG8_LAS bf16x8*)(lds + PG8_SA(b, h) + aoff + m * 2048 + k * 1024); } while (0)
#define PG8_LDB(dst, b, h) do { _Pragma("unroll") for (int n = 0; n < 2; ++n) _Pragma("unroll") for (int k = 0; k < 2; ++k) dst[n][k] = *(const PG8_LAS bf16x8*)(lds + PG8_SB(b, h) + boff + n * 2048 + k * 1024); } while (0)
#define PG8_MMA(ai, bj, At, Bt) do { __builtin_amdgcn_s_setprio(1); _Pragma("unroll") for (int m = 0; m < 4; ++m) _Pragma("unroll") for (int n = 0; n < 2; ++n) _Pragma("unroll") for (int k = 0; k < 2; ++k) \
        acc[ai][bj][m][n] = __builtin_amdgcn_mfma_f32_16x16x32_bf16(Bt[n][k], At[m][k], acc[ai][bj][m][n], 0, 0, 0); __builtin_amdgcn_s_setprio(0); } while (0)
#define PG8_WAIT_V(n) asm volatile("s_waitcnt vmcnt(" #n ")" ::: "memory")
#define PG8_WAIT_L(n) asm volatile("s_waitcnt lgkmcnt(" #n ")" ::: "memory")
#define PG8_BAR __builtin_amdgcn_s_barrier()
#define PG8_SCHED __builtin_amdgcn_sched_barrier(0)
    Unit cur, nxt; int ui = 0;
    if (!S.next(0, cur)) return;
    f32x4 acc[2][2][4][2];
#pragma unroll
    for (int a = 0; a < 2; ++a)
#pragma unroll
        for (int b = 0; b < 2; ++b)
#pragma unroll
            for (int m = 0; m < 4; ++m)
#pragma unroll
                for (int n = 0; n < 2; ++n) acc[a][b][m][n] = (f32x4){0.f, 0.f, 0.f, 0.f};
    bf16x8 At[4][2], B0[2][2], B1[2][2];
    const char* cA = (const char*)g.A + (size_t)cur.pm * tA; const char* cB = (const char*)g.Bt + (size_t)cur.pn * tB;
    S.a_ready(cur);
    if constexpr (SP2) {
        PG8_STAGE(PG8_SB(0, 0), cB, voffB); PG8_STAGE(PG8_SB(0, 1), cB + hB, voffB); PG8_STAGE(PG8_SA(0, 0), cA, voffA); PG8_STAGE(PG8_SA(0, 1), cA + hA, voffA);
        if (wr == 1) PG8_BAR;
        PG8_WAIT_V(2); PG8_BAR;
        PG8_STAGE(PG8_SB(1, 0), cB + kstep, voffB); PG8_STAGE(PG8_SA(1, 0), cA + kstep, voffA); PG8_STAGE(PG8_SB(1, 1), cB + hB + kstep, voffB);
        PG8_WAIT_V(6); PG8_BAR;
    } else {
        PG8_STAGE(PG8_SB(0, 0), cB, voffB); PG8_STAGE(PG8_SA(0, 0), cA, voffA); PG8_STAGE(PG8_SB(0, 1), cB + hB, voffB); PG8_STAGE(PG8_SA(0, 1), cA + hA, voffA);
        if (wr == 1) PG8_BAR;
        PG8_WAIT_V(4); PG8_BAR;
        PG8_STAGE(PG8_SB(1, 0), cB + kstep, voffB); PG8_STAGE(PG8_SA(1, 0), cA + kstep, voffA); PG8_STAGE(PG8_SB(1, 1), cB + hB + kstep, voffB);
        PG8_WAIT_V(6); PG8_BAR;
    }
    for (;;) {
        const bool has_next = S.next(ui + 1, nxt);
        const char* nA = has_next ? (const char*)g.A + (size_t)nxt.pm * tA : cA; const char* nB = has_next ? (const char*)g.Bt + (size_t)nxt.pn * tB : cB;
        for (int t = 0; t < nt; t += 2) {
            const bool last = (t == nt - 2);
            const char* a1 = cA + (size_t)(t + 1) * kstep;
            const char* a2 = last ? nA : cA + (size_t)(t + 2) * kstep; const char* b2 = last ? nB : cB + (size_t)(t + 2) * kstep;
            const char* a3 = a2 + kstep; const char* b3 = b2 + kstep;
            if (last && has_next) S.a_ready(nxt);
            if constexpr (SP2) {
            PG8_LDB(B0, 0, 0); PG8_LDB(B1, 0, 1); PG8_SCHED; PG8_LDA(At, 0, 0); PG8_STAGE(PG8_SA(1, 1), a1 + hA, voffA);
            PG8_WAIT_V(8); PG8_WAIT_L(0); PG8_BAR; PG8_MMA(0, 0, At, B0); PG8_MMA(0, 1, At, B1); PG8_BAR; PG8_SCHED;
            PG8_LDA(At, 0, 1); PG8_STAGE(PG8_SB(0, 0), b2, voffB); PG8_STAGE(PG8_SB(0, 1), b2 + hB, voffB); PG8_STAGE(PG8_SA(0, 0), a2, voffA);
            PG8_WAIT_V(8); PG8_WAIT_L(0); PG8_BAR; PG8_MMA(1, 0, At, B0); PG8_MMA(1, 1, At, B1); PG8_BAR; PG8_SCHED;
            PG8_LDB(B0, 1, 0); PG8_LDB(B1, 1, 1); PG8_SCHED; PG8_LDA(At, 1, 0); PG8_STAGE(PG8_SA(0, 1), a2 + hA, voffA);
            PG8_WAIT_V(8); PG8_WAIT_L(0); PG8_BAR; PG8_MMA(0, 0, At, B0); PG8_MMA(0, 1, At, B1); PG8_BAR; PG8_SCHED;
            PG8_LDA(At, 1, 1); PG8_STAGE(PG8_SB(1, 0), b3, voffB); PG8_STAGE(PG8_SB(1, 1), b3 + hB, voffB); PG8_STAGE(PG8_SA(1, 0), a3, voffA);
            PG8_WAIT_V(8); PG8_WAIT_L(0); PG8_BAR; PG8_MMA(1, 0, At, B0); PG8_MMA(1, 1, At, B1); PG8_BAR; PG8_SCHED;
            } else {
            PG8_LDB(B0, 0, 0); PG8_SCHED; PG8_LDA(At, 0, 0); PG8_STAGE(PG8_SA(1, 1), a1 + hA, voffA);
            PG8_WAIT_L(8); PG8_BAR; PG8_WAIT_L(0); PG8_MMA(0, 0, At, B0); PG8_BAR; PG8_SCHED;
            PG8_LDB(B1, 0, 1); PG8_STAGE(PG8_SB(0, 0), b2, voffB);
            PG8_BAR; PG8_WAIT_L(0); PG8_MMA(0, 1, At, B1); PG8_BAR;
            PG8_LDA(At, 0, 1); PG8_STAGE(PG8_SA(0, 0), a2, voffA);
            PG8_BAR; PG8_WAIT_L(0); PG8_MMA(1, 0, At, B0); PG8_BAR; PG8_SCHED;
            PG8_STAGE(PG8_SB(0, 1), b2 + hB, voffB);
            PG8_WAIT_V(6); PG8_BAR; PG8_MMA(1, 1, At, B1); PG8_BAR;
            PG8_LDB(B0, 1, 0); PG8_SCHED; PG8_LDA(At, 1, 0); PG8_STAGE(PG8_SA(0, 1), a2 + hA, voffA);
            PG8_WAIT_L(8); PG8_BAR; PG8_WAIT_L(0); PG8_MMA(0, 0, At, B0); PG8_BAR; PG8_SCHED;
            PG8_LDB(B1, 1, 1); PG8_STAGE(PG8_SB(1, 0), b3, voffB);
            PG8_BAR; PG8_WAIT_L(0); PG8_MMA(0, 1, At, B1); PG8_BAR;
            PG8_LDA(At, 1, 1); PG8_STAGE(PG8_SA(1, 0), a3, voffA);
            PG8_BAR; PG8_WAIT_L(0); PG8_MMA(1, 0, At, B0); PG8_BAR; PG8_SCHED;
            PG8_STAGE(PG8_SB(1, 1), b3 + hB, voffB);
            PG8_WAIT_V(6); PG8_BAR; PG8_MMA(1, 1, At, B1); PG8_BAR;
            }
        }
        if constexpr (ALIGN_EPI) { if (wr == 0) PG8_BAR; }
        if constexpr (!Epi::AFTER_DRAIN) { E(acc, cur, wr, wc, fr, fq); S.done(cur); }
        if (!has_next) break;
#pragma unroll
        for (int a = 0; a < 2; ++a)
#pragma unroll
            for (int b = 0; b < 2; ++b)
#pragma unroll
                for (int m = 0; m < 4; ++m)
#pragma unroll
                    for (int n = 0; n < 2; ++n) acc[a][b][m][n] = (f32x4){0.f, 0.f, 0.f, 0.f};
        cur = nxt; cA = nA; cB = nB; ++ui;
        if constexpr (ALIGN_EPI) { if (wr == 1) PG8_BAR; }
    }
    PG8_WAIT_V(0);
    if constexpr (!ALIGN_EPI) { if (wr == 0) PG8_BAR; }
    PG8_BAR;
#undef PG8_SA
#undef PG8_SB
#undef PG8_STAGE
#undef PG8_LDA
#undef PG8_LDB
#undef PG8_MMA
#undef PG8_WAIT_V
#undef PG8_WAIT_L
#undef PG8_BAR
#undef PG8_SCHED
}
}

typedef unsigned short bf16;
typedef short bf16x8 __attribute__((ext_vector_type(8)));
typedef float f32x4 __attribute__((ext_vector_type(4)));
typedef unsigned u32x4 __attribute__((ext_vector_type(4)));
typedef unsigned u32x2 __attribute__((ext_vector_type(2)));
#define LAS __attribute__((address_space(3)))

constexpr int NWAVES = 8, NTHR = 512;
constexpr int DM = 1024, SEQ = 8192, MTOK = 16384, DEPTH = 4;
constexpr int INC = 7168, DFF = 2816, AW = 512;
constexpr int COL_Q = 0, COL_K = 1536, COL_V = 3072, COL_U = 4608, COL_GA = 5120, COL_GS = 6144;
constexpr int UGP = 2048;
constexpr int TC = 32, NCH = MTOK / TC  , CHB = SEQ / TC  ;
constexpr float EPS = 1e-6f;

constexpr size_t OFF_IN = 0, OFF_P = 7340032, OFF_GLU = 7864320, OFF_OUT = 8912896, OFF_GU = 9961472, OFF_DN = 15728640, LAYER_W = 18612224;
constexpr size_t MiB = 1u << 20;
constexpr size_t WS_SS1 = 65536, WS_SS2 = 131072;
constexpr size_t WS_WB = 1 * MiB, WS_Z = 143 * MiB, WS_ACT = 367 * MiB, WS_Y = 399 * MiB, WS_LSE = 415 * MiB, WS_TAB = 417 * MiB, TAB_STRIDE = 9 * MiB,
                 WS_S = 435 * MiB, WS_XP = 443 * MiB, WS_END = 447 * MiB;
constexpr size_t TB_KT = 0, TB_AT = 768 * 1024, TB_E = 1 * MiB, TB_P = 5 * MiB;
static_assert(WS_WB + 4 * LAYER_W * 2 <= WS_Z && WS_Z + (size_t)MTOK * INC * 2 <= WS_ACT, "ws map");
constexpr int LDS_BYTES = 147456;

struct Args { const float* in[21]; float* out; unsigned char* ws; int ph_lo, ph_hi; };

__device__ __forceinline__ unsigned f2bf(float f) { unsigned u = __float_as_uint(f); return (u + 0x7fffu + ((u >> 16) & 1u)) >> 16; }
__device__ __forceinline__ unsigned pk2(float lo, float hi) { return pg8::cvt_pk_bf16(lo, hi); }
__device__ __forceinline__ float bflo(unsigned w) { return __uint_as_float(w << 16); }
__device__ __forceinline__ float bfhi(unsigned w) { return __uint_as_float(w & 0xffff0000u); }
__device__ __forceinline__ float wave_sum(float v) {
#pragma unroll
    for (int o = 1; o < 64; o <<= 1) v += __shfl_xor(v, o);
    return v;
}

__device__ __forceinline__ void transpose_item(const float* W, int K, int N, bf16* WT, int il_off, float* scr, int item, int lane, const float* gk = nullptr) {
    const int nblk = N / 32, kb = item / nblk, nb = item % nblk, k0 = 64 * kb, n0 = 32 * nb;
#pragma unroll 8
    for (int i = 0; i < 32; ++i) { const int kk = 2 * i + (lane >> 5); float v = W[(size_t)(k0 + kk) * N + n0 + (lane & 31)]; if (gk) v *= gk[k0 + kk]; scr[kk * 33 + (lane & 31)] = v; }
    __builtin_amdgcn_s_waitcnt(0xc07f); asm volatile("" ::: "memory");
    const int drow = (il_off < 0) ? n0 : (n0 / 128) * 256 + il_off + (n0 % 128);
    const int c = lane & 7;
#pragma unroll
    for (int j = 0; j < 4; ++j) { const int n = (lane >> 3) + 8 * j; const float* s = scr + (8 * c) * 33 + n;
        u32x4 o; o.x = pk2(s[0 * 33], s[1 * 33]); o.y = pk2(s[2 * 33], s[3 * 33]); o.z = pk2(s[4 * 33], s[5 * 33]); o.w = pk2(s[6 * 33], s[7 * 33]);
        *(u32x4*)(WT + (size_t)(drow + n) * K + k0 + 8 * c) = o; }
    __builtin_amdgcn_s_waitcnt(0xc07f); asm volatile("" ::: "memory");
}
__device__ __forceinline__ void phase_weights(const Args& a, int zero, bf16* WB, float* ldsf, int gw, int ngw, int wave, int lane) {
    float* scr = ldsf + wave * 4096;
    constexpr int PER_LAYER = 9088;
    for (int it = gw; it < DEPTH * PER_LAYER; it += ngw) {
        const int l = it / PER_LAYER; int r = it % PER_LAYER; bf16* wl = WB + (size_t)l * LAYER_W;
        if (r < 3584) { transpose_item(a.in[2 + zero] + (size_t)l * DM * INC, DM, INC, wl + OFF_IN, -1, scr, r, lane, a.in[1 + zero] + l * DM); continue; } r -= 3584;
        if (r < 256) { transpose_item(a.in[5 + zero] + (size_t)l * AW * DM, AW, DM, wl + OFF_P, -1, scr, r, lane); continue; } r -= 256;
        if (r < 256) { transpose_item(a.in[14 + zero] + (size_t)l * AW * DM, AW, DM, wl + OFF_GLU, 0, scr, r, lane); continue; } r -= 256;
        if (r < 256) { transpose_item(a.in[15 + zero] + (size_t)l * AW * DM, AW, DM, wl + OFF_GLU, 128, scr, r, lane); continue; } r -= 256;
        if (r < 512) { transpose_item(a.in[16 + zero] + (size_t)l * DM * DM, DM, DM, wl + OFF_OUT, -1, scr, r, lane); continue; } r -= 512;
        if (r < 1408) { transpose_item(a.in[18 + zero] + (size_t)l * DM * DFF, DM, DFF, wl + OFF_GU, 0, scr, r, lane, a.in[17 + zero] + l * DM); continue; } r -= 1408;
        if (r < 1408) { transpose_item(a.in[19 + zero] + (size_t)l * DM * DFF, DM, DFF, wl + OFF_GU, 128, scr, r, lane, a.in[17 + zero] + l * DM); continue; } r -= 1408;
        transpose_item(a.in[20 + zero] + (size_t)l * DFF * DM, DFF, DM, wl + OFF_DN, -1, scr, r, lane);
    }
}

__device__ __forceinline__ void phase_xprep(const float* x, bf16* out, float* SS, int gw, int ngw, int lane) {
    for (int m = gw; m < MTOK; m += ngw) {
        const f32x4* xr = (const f32x4*)(x + (size_t)m * DM) + lane;
        f32x4 v[4]; float s = 0.f;
#pragma unroll
        for (int j = 0; j < 4; ++j) { v[j] = xr[64 * j]; s += (v[j].x * v[j].x + v[j].y * v[j].y) + (v[j].z * v[j].z + v[j].w * v[j].w); }
        s = wave_sum(s);
        u32x2* o8 = (u32x2*)(out + (size_t)m * DM) + lane;
#pragma unroll
        for (int j = 0; j < 4; ++j) { u32x2 w; w.x = pk2(v[j].x, v[j].y); w.y = pk2(v[j].z, v[j].w); o8[64 * j] = w; }
        if (lane < 16) SS[(size_t)m * 16 + lane] = (lane == 0) ? s : 0.f;
    }
}

__device__ __forceinline__ void ssm_pre_item(const Args& a, int zero, int l, int g, unsigned char* tab, float* L, int tid) {
    float* pw = L; float* bb = L + 4224; float* cc = L + 6272;
    const float* lam_re = a.in[6 + zero] + (size_t)(l * 32 + g) * 64; const float* lam_im = a.in[7 + zero] + (size_t)(l * 32 + g) * 64;
    const float* b_re = a.in[9 + zero] + (size_t)(l * 32 + g) * 1024; const float* b_im = a.in[10 + zero] + (size_t)(l * 32 + g) * 1024;
    const float* c_re = a.in[11 + zero] + (size_t)(l * 32 + g) * 1024; const float* c_im = a.in[12 + zero] + (size_t)(l * 32 + g) * 1024;
    const float ldt = a.in[8 + zero][l * 32 + g];
    const double INV_2PI = 0.15915494309189533577, TWO_PI = 6.283185307179586476925;
    float brv[2], biv[2], crv[2], civ[2], lrv[5], liv[5];
#pragma unroll
    for (int q = 0; q < 2; ++q) { const int i = tid + NTHR * q; brv[q] = b_re[i]; biv[q] = b_im[i]; crv[q] = c_re[i]; civ[q] = c_im[i]; }
#pragma unroll
    for (int q = 0; q < 5; ++q) { const int i = tid + NTHR * q, p = i & 63; lrv[q] = lam_re[p]; liv[q] = lam_im[p]; }
    const float dt = expf(ldt);
#pragma unroll
    for (int q = 0; q < 2; ++q) { const int i = tid + NTHR * q, p = i >> 4; const float lr = lam_re[p], li = lam_im[p];
        const double angle = (double)li * (double)dt; const double rr = angle - TWO_PI * rint(angle * INV_2PI);
        float sn, cs; sincosf((float)rr, &sn, &cs); const float mag = expf(lr * dt);
        const float nr = mag * cs - 1.0f, ni = mag * sn, den = lr * lr + li * li;
        const float cr = (nr * lr + ni * li) / den, ci = (ni * lr - nr * li) / den;
        bb[i * 2] = cr * brv[q] - ci * biv[q]; bb[i * 2 + 1] = cr * biv[q] + ci * brv[q];
        cc[i * 2] = crv[q]; cc[i * 2 + 1] = civ[q]; }
#pragma unroll
    for (int q = 0; q < 5; ++q) { const int i = tid + NTHR * q; if (i < 33 * 64) { const int j = i >> 6;
        const double angle = (double)liv[q] * (double)dt * (double)j; const double rr = angle - TWO_PI * rint(angle * INV_2PI);
        float sn, cs; sincosf((float)rr, &sn, &cs); const float mag = expf(lrv[q] * dt * (float)j);
        pw[i * 2] = mag * cs; pw[i * 2 + 1] = mag * sn; } }
    __syncthreads();
    bf16* KT = (bf16*)(tab + TB_KT) + (size_t)g * 32 * 256; bf16* E = (bf16*)(tab + TB_E) + (size_t)g * 128 * 512; bf16* P = (bf16*)(tab + TB_P) + (size_t)g * 512 * 128;
    float* AT = (float*)(tab + TB_AT) + g * 128;
    { const int j = tid >> 4, c = tid & 15; float acc16[16];
#pragma unroll
      for (int q = 0; q < 16; ++q) acc16[q] = 0.f;
      for (int p = 0; p < 64; ++p) { const float Cr = cc[(c * 64 + p) * 2], Ci = cc[(c * 64 + p) * 2 + 1], wr_ = pw[(j * 64 + p) * 2], wi_ = pw[(j * 64 + p) * 2 + 1];
          const float tr = Cr * wr_ - Ci * wi_, ti = Cr * wi_ + Ci * wr_; const f32x4* b4 = (const f32x4*)(bb + p * 32);
#pragma unroll
          for (int q = 0; q < 8; ++q) { const f32x4 bv = b4[q]; acc16[2 * q] += tr * bv.x - ti * bv.y; acc16[2 * q + 1] += tr * bv.z - ti * bv.w; } }
      u32x4 o0, o1; o0.x = pk2(acc16[0], acc16[1]); o0.y = pk2(acc16[2], acc16[3]); o0.z = pk2(acc16[4], acc16[5]); o0.w = pk2(acc16[6], acc16[7]);
      o1.x = pk2(acc16[8], acc16[9]); o1.y = pk2(acc16[10], acc16[11]); o1.z = pk2(acc16[12], acc16[13]); o1.w = pk2(acc16[14], acc16[15]);
      *(u32x4*)(KT + (size_t)tid * 16) = o0; *(u32x4*)(KT + (size_t)tid * 16 + 8) = o1; }
    for (int i8 = tid; i8 < 128 * 64; i8 += NTHR) { const int row = i8 >> 6, k8 = i8 & 63, p = row & 63, s_ = k8 >> 1, c0 = (k8 & 1) * 8, j = 31 - s_;
        const float wr_ = pw[(j * 64 + p) * 2], wi_ = pw[(j * 64 + p) * 2 + 1]; const f32x4* b4 = (const f32x4*)(bb + (p * 16 + c0) * 2); float v[8];
#pragma unroll
        for (int q = 0; q < 4; ++q) { const f32x4 bv = b4[q];
            v[2 * q] = (row < 64) ? (wr_ * bv.x - wi_ * bv.y) : (wr_ * bv.y + wi_ * bv.x); v[2 * q + 1] = (row < 64) ? (wr_ * bv.z - wi_ * bv.w) : (wr_ * bv.w + wi_ * bv.z); }
        u32x4 o; o.x = pk2(v[0], v[1]); o.y = pk2(v[2], v[3]); o.z = pk2(v[4], v[5]); o.w = pk2(v[6], v[7]);
        *(u32x4*)(E + (size_t)i8 * 8) = o; }
    for (int i8 = tid; i8 < 512 * 16; i8 += NTHR) { const int row = i8 >> 4, q0 = (i8 & 15) * 8, p0 = q0 & 63, t = row >> 4, c = row & 15, j = t + 1;
        const f32x4* c4 = (const f32x4*)(cc + (c * 64 + p0) * 2); const f32x4* w4 = (const f32x4*)(pw + (j * 64 + p0) * 2); float v[8];
#pragma unroll
        for (int q = 0; q < 4; ++q) { const f32x4 cv = c4[q], wv = w4[q];
            v[2 * q] = (q0 < 64) ? (cv.x * wv.x - cv.y * wv.y) : -(cv.x * wv.y + cv.y * wv.x); v[2 * q + 1] = (q0 < 64) ? (cv.z * wv.z - cv.w * wv.w) : -(cv.z * wv.w + cv.w * wv.z); }
        u32x4 o; o.x = pk2(v[0], v[1]); o.y = pk2(v[2], v[3]); o.z = pk2(v[4], v[5]); o.w = pk2(v[6], v[7]);
        *(u32x4*)(P + (size_t)i8 * 8) = o; }
    if (tid < 64) { AT[tid] = pw[(32 * 64 + tid) * 2]; AT[64 + tid] = pw[(32 * 64 + tid) * 2 + 1]; }
    __syncthreads();
}

constexpr int QP = 72, VP = 272;
constexpr int LQ_OFF = 0, LK_OFF = 128 * QP * 2, LV_OFF = LK_OFF + 256 * QP * 2;
constexpr size_t QPLANE = (size_t)2 * 3 * 8 * 8192 * 64;
struct AttnItem { int gi, h, b, n; size_t qrow0; };
__device__ __forceinline__ AttnItem attn_decode(int item) {
    AttnItem A; int it = item; const int rn = it & 63; it >>= 6; A.h = it & 7; it >>= 3; A.gi = it % 3; A.b = it / 3;
    const int dsh = 2 * A.gi, nbsh = 6 - dsh; const int r = rn >> nbsh; A.n = rn & ((1 << nbsh) - 1);
    A.qrow0 = ((size_t)(A.b * 3 + A.gi) * 8 + A.h) * 8192 + (size_t)r * (8192 >> dsh) + 128 * A.n;
    return A;
}
__device__ __forceinline__ void attn_load(const AttnItem& A, const bf16* QH, int tid, u32x4 (&qv)[2], u32x4 (&kv)[4], u32x4 (&vv)[4]) {
    const bf16* qp = QH + A.qrow0 * 64 + tid * 8;
#pragma unroll
    for (int rd = 0; rd < 2; ++rd) qv[rd] = *(const u32x4*)(qp + rd * 4096);
#pragma unroll
    for (int rd = 0; rd < 4; ++rd) {
        if (A.n > 0 || rd >= 2) { const bf16* p = qp + QPLANE + (rd - 2) * 4096; kv[rd] = *(const u32x4*)p; vv[rd] = *(const u32x4*)(p + QPLANE); }
        else { kv[rd] = (u32x4){0u, 0u, 0u, 0u}; vv[rd] = (u32x4){0u, 0u, 0u, 0u}; } }
}
__device__ __forceinline__ void attn_stage(const float* gq, const float* gk, unsigned char* lds, int tid, const u32x4 (&qv)[2], const u32x4 (&kv)[4], const u32x4 (&vv)[4]) {
    asm volatile("" : "+v"(tid));
    bf16* Qs = (bf16*)(lds + LQ_OFF); bf16* Ks = (bf16*)(lds + LK_OFF); bf16* Vt = (bf16*)(lds + LV_OFF);
    const int chunk = tid & 7, rowi = tid >> 3;
    float gqv[8], gkv[8];
#pragma unroll
    for (int i = 0; i < 8; ++i) { gqv[i] = gq[chunk * 8 + i] * 0.125f; gkv[i] = gk[chunk * 8 + i]; }
#pragma unroll
    for (int rd = 0; rd < 2; ++rd) { float f[8]; f[0] = bflo(qv[rd].x); f[1] = bfhi(qv[rd].x); f[2] = bflo(qv[rd].y); f[3] = bfhi(qv[rd].y); f[4] = bflo(qv[rd].z); f[5] = bfhi(qv[rd].z); f[6] = bflo(qv[rd].w); f[7] = bfhi(qv[rd].w);
        float ss = 0.f;
#pragma unroll
        for (int i = 0; i < 8; ++i) ss += f[i] * f[i];
        ss += __shfl_xor(ss, 1); ss += __shfl_xor(ss, 2); ss += __shfl_xor(ss, 4);
        const float rs = rsqrtf(ss * (1.f / 64.f) + EPS);
        u32x4 w; w.x = pk2(f[0] * rs * gqv[0], f[1] * rs * gqv[1]); w.y = pk2(f[2] * rs * gqv[2], f[3] * rs * gqv[3]); w.z = pk2(f[4] * rs * gqv[4], f[5] * rs * gqv[5]); w.w = pk2(f[6] * rs * gqv[6], f[7] * rs * gqv[7]);
        *(u32x4*)(Qs + (rowi + 64 * rd) * QP + chunk * 8) = w; }
#pragma unroll
    for (int rd = 0; rd < 4; ++rd) { float f[8]; f[0] = bflo(kv[rd].x); f[1] = bfhi(kv[rd].x); f[2] = bflo(kv[rd].y); f[3] = bfhi(kv[rd].y); f[4] = bflo(kv[rd].z); f[5] = bfhi(kv[rd].z); f[6] = bflo(kv[rd].w); f[7] = bfhi(kv[rd].w);
        float ss = 0.f;
#pragma unroll
        for (int i = 0; i < 8; ++i) ss += f[i] * f[i];
        ss += __shfl_xor(ss, 1); ss += __shfl_xor(ss, 2); ss += __shfl_xor(ss, 4);
        const float rs = rsqrtf(ss * (1.f / 64.f) + EPS);
        u32x4 w; w.x = pk2(f[0] * rs * gkv[0], f[1] * rs * gkv[1]); w.y = pk2(f[2] * rs * gkv[2], f[3] * rs * gkv[3]); w.z = pk2(f[4] * rs * gkv[4], f[5] * rs * gkv[5]); w.w = pk2(f[6] * rs * gkv[6], f[7] * rs * gkv[7]);
        const int ki = rowi + 64 * rd;
        *(u32x4*)(Ks + ki * QP + chunk * 8) = w;
        bf16* vp = Vt + (chunk * 8) * VP + (ki ^ (chunk << 2));
        vp[0 * VP] = (bf16)(vv[rd].x & 0xffffu); vp[1 * VP] = (bf16)(vv[rd].x >> 16); vp[2 * VP] = (bf16)(vv[rd].y & 0xffffu); vp[3 * VP] = (bf16)(vv[rd].y >> 16);
        vp[4 * VP] = (bf16)(vv[rd].z & 0xffffu); vp[5 * VP] = (bf16)(vv[rd].z >> 16); vp[6 * VP] = (bf16)(vv[rd].w & 0xffffu); vp[7 * VP] = (bf16)(vv[rd].w >> 16); }
}
__device__ __forceinline__ void attn_compute(const AttnItem& A, bf16* QH, float* LSE, unsigned char* lds, int tid) {
    asm volatile("" : "+v"(tid));
    const bf16* Qs = (const bf16*)(lds + LQ_OFF); const bf16* Ks = (const bf16*)(lds + LK_OFF); const bf16* Vt = (const bf16*)(lds + LV_OFF);
    const int n = A.n;
    const int w = tid >> 6, lane = tid & 63, fr = lane & 15, fq = lane >> 4, kt0 = w & ~1;
    bf16x8 qf[2];
#pragma unroll
    for (int kk = 0; kk < 2; ++kk) qf[kk] = *(const bf16x8*)(Qs + (16 * w + fr) * QP + 32 * kk + 8 * fq);
    f32x4 s[10];
#pragma unroll
    for (int t = 0; t < 10; ++t) { s[t] = (f32x4){0.f, 0.f, 0.f, 0.f};
#pragma unroll
        for (int kk = 0; kk < 2; ++kk) { const bf16x8 kf = *(const bf16x8*)(Ks + (16 * (kt0 + t) + fr) * QP + 32 * kk + 8 * fq); s[t] = __builtin_amdgcn_mfma_f32_16x16x32_bf16(kf, qf[kk], s[t], 0, 0, 0); }
    }
    const int qi = 16 * w + fr; float mx = -INFINITY;
    const int dbase = 16 * (kt0 - w) + 4 * fq - fr, kbase = 16 * kt0 + 4 * fq - ((n > 0) ? 0 : 128);
#pragma unroll
    for (int t = 0; t < 10; ++t)
#pragma unroll
        for (int j = 0; j < 4; ++j) { const int dlt = dbase + 16 * t + j; const int bad = (dlt | (128 - dlt) | (kbase + 16 * t + j)) >> 31;
            s[t][j] += __int_as_float(bad & (int)0xff800000); mx = fmaxf(mx, s[t][j]); }
    mx = fmaxf(mx, __shfl_xor(mx, 16)); mx = fmaxf(mx, __shfl_xor(mx, 32));
    float sum = 0.f;
#pragma unroll
    for (int t = 0; t < 10; ++t)
#pragma unroll
        for (int j = 0; j < 4; ++j) { const float p = __builtin_amdgcn_exp2f((s[t][j] - mx) * 1.44269504089f); s[t][j] = p; sum += p; }
    sum += __shfl_xor(sum, 16); sum += __shfl_xor(sum, 32);
    f32x4 o[4];
#pragma unroll
    for (int dt = 0; dt < 4; ++dt) o[dt] = (f32x4){0.f, 0.f, 0.f, 0.f};
#pragma unroll
    for (int jj = 0; jj < 5; ++jj) {
        u32x4 pw; pw.x = pk2(s[2 * jj][0], s[2 * jj][1]); pw.y = pk2(s[2 * jj][2], s[2 * jj][3]); pw.z = pk2(s[2 * jj + 1][0], s[2 * jj + 1][1]); pw.w = pk2(s[2 * jj + 1][2], s[2 * jj + 1][3]);
        const bf16x8 pf = __builtin_bit_cast(bf16x8, pw);
#pragma unroll
        for (int dt = 0; dt < 4; ++dt) { const int dd = 16 * dt + fr, sw = ((dd >> 3) & 7) << 2, kb = 32 * (kt0 / 2 + jj) + 4 * fq;
            const bf16* vr = Vt + dd * VP;
            const u32x2 lo = *(const u32x2*)(vr + (kb ^ sw)), hi = *(const u32x2*)(vr + ((kb + 16) ^ sw)); u32x4 vw; vw.x = lo.x; vw.y = lo.y; vw.z = hi.x; vw.w = hi.y;
            o[dt] = __builtin_amdgcn_mfma_f32_16x16x32_bf16(__builtin_bit_cast(bf16x8, vw), pf, o[dt], 0, 0, 0); } }
    const float inv = 1.0f / sum;
    const size_t prow = A.qrow0 + qi;
    bf16* op = QH + prow * 64 + 4 * fq;
#pragma unroll
    for (int dt = 0; dt < 4; ++dt) { u32x2 w2; w2.x = pk2(o[dt][0] * inv, o[dt][1] * inv); w2.y = pk2(o[dt][2] * inv, o[dt][3] * inv); *(u32x2*)(op + 16 * dt) = w2; }
    if (fq == 0) LSE[prow] = mx + logf(sum);
}

constexpr int ULP = 520;
__device__ __forceinline__ void ssm_stage_u(const bf16* UH, int g, int mt, unsigned char* lds, int tid) {
    const bf16* src = UH + ((size_t)g * 16384 + (size_t)mt * 2048) * 16;
    u32x4 v[8];
#pragma unroll
    for (int k = 0; k < 8; ++k) v[k] = *(const u32x4*)(src + (size_t)(tid + NTHR * k) * 8);
#pragma unroll
    for (int k = 0; k < 8; ++k) { const int i = tid + NTHR * k; *(u32x4*)(lds + (i >> 6) * (ULP * 2) + (i & 63) * 16) = v[k]; }
}
__device__ __forceinline__ void ssm_s1_item(int item, const bf16* UH, unsigned char* ws, const unsigned char* tab, unsigned char* lds, int tid) {
    const int g = item >> 3, mt = item & 7, w = tid >> 6, lane = tid & 63, fr = lane & 15, fq = lane >> 4;
    const bf16* E = (const bf16*)(tab + TB_E) + (size_t)g * 128 * 512; float* S = (float*)(ws + WS_S);
    const bf16* ep = E + (size_t)(16 * w + fr) * 512 + 8 * fq;
    bf16x8 ef[16];
#pragma unroll
    for (int ks = 0; ks < 16; ++ks) ef[ks] = *(const bf16x8*)(ep + 32 * ks);
    ssm_stage_u(UH, g, mt, lds, tid);
    __syncthreads();
    const bf16* UL = (const bf16*)lds;
    f32x4 acc[4];
#pragma unroll
    for (int mi = 0; mi < 4; ++mi) acc[mi] = (f32x4){0.f, 0.f, 0.f, 0.f};
#pragma unroll
    for (int ks = 0; ks < 16; ++ks)
#pragma unroll
        for (int mi = 0; mi < 4; ++mi) { const bf16x8 uf = *(const bf16x8*)(UL + (16 * mi + fr) * ULP + (2 * ks + (fq >> 1)) * 16 + 8 * (fq & 1)); acc[mi] = __builtin_amdgcn_mfma_f32_16x16x32_bf16(ef[ks], uf, acc[mi], 0, 0, 0); }
#pragma unroll
    for (int mi = 0; mi < 4; ++mi) *(f32x4*)(S + ((size_t)(64 * mt + 16 * mi + fr) * 32 + g) * 128 + 16 * w + 4 * fq) = acc[mi];
    __syncthreads();
}

__device__ __forceinline__ void ssm_carry_item(int item, unsigned char* ws, const unsigned char* tab, float* L, int tid) {
    const int b = item >> 5, g = item & 31;
    const float* S = (const float*)(ws + WS_S); bf16* XP = (bf16*)(ws + WS_XP); const float* AT = (const float*)(tab + TB_AT) + g * 128;
#pragma unroll 4
    for (int i = 0; i < 16; ++i) { const int idx = i * NTHR + tid, k = idx >> 5, q4 = idx & 31;
        *(f32x4*)(L + k * 128 + 4 * q4) = *(const f32x4*)(S + ((size_t)(b * CHB + k) * 32 + g) * 128 + 4 * q4); }
    __syncthreads();
    if (tid < 64) {
        const int p = tid; const float ar = AT[p], ai = AT[64 + p]; float xr = 0.f, xi = 0.f;
        bf16* xo = XP + ((size_t)(b * CHB) * 32 + g) * 128 + p;
#pragma unroll 8
        for (int k = 0; k < CHB; ++k) {
            xo[(size_t)k * 32 * 128] = (bf16)f2bf(xr); xo[(size_t)k * 32 * 128 + 64] = (bf16)f2bf(xi);
            const float sr = L[k * 128 + p], si = L[k * 128 + 64 + p];
            const float nr = ar * xr - ai * xi + sr, ni = ar * xi + ai * xr + si; xr = nr; xi = ni;
        }
    }
    __syncthreads();
}

__device__ __forceinline__ void phase_merge(const bf16* QH, bf16* Aout, const float* LSE, int vt, int nvt) {
    for (int i = vt; i < MTOK * 64; i += nvt) { const int row = i >> 6, h = (i >> 3) & 7, ch = i & 7, b = row >> 13, t = row & 8191;
        const size_t r0 = ((size_t)(b * 3 + 0) * 8 + h) * 8192 + t;
        const size_t r1 = ((size_t)(b * 3 + 1) * 8 + h) * 8192 + ((t & 3) << 11) + (t >> 2);
        const size_t r2 = ((size_t)(b * 3 + 2) * 8 + h) * 8192 + ((t & 15) << 9) + (t >> 4);
        const float l0 = LSE[r0], l1 = LSE[r1], l2 = LSE[r2];
        const float mx = fmaxf(l0, fmaxf(l1, l2)); float w0 = expf(l0 - mx), w1 = expf(l1 - mx), w2 = expf(l2 - mx); const float inv = 1.0f / (w0 + w1 + w2); w0 *= inv; w1 *= inv; w2 *= inv;
        const u32x4 a0 = *(const u32x4*)(QH + r0 * 64 + ch * 8), a1 = *(const u32x4*)(QH + r1 * 64 + ch * 8), a2 = *(const u32x4*)(QH + r2 * 64 + ch * 8);
        u32x4 o;
        o.x = pk2(w0 * bflo(a0.x) + w1 * bflo(a1.x) + w2 * bflo(a2.x), w0 * bfhi(a0.x) + w1 * bfhi(a1.x) + w2 * bfhi(a2.x));
        o.y = pk2(w0 * bflo(a0.y) + w1 * bflo(a1.y) + w2 * bflo(a2.y), w0 * bfhi(a0.y) + w1 * bfhi(a1.y) + w2 * bfhi(a2.y));
        o.z = pk2(w0 * bflo(a0.z) + w1 * bflo(a1.z) + w2 * bflo(a2.z), w0 * bfhi(a0.z) + w1 * bfhi(a1.z) + w2 * bfhi(a2.z));
        o.w = pk2(w0 * bflo(a0.w) + w1 * bflo(a1.w) + w2 * bflo(a2.w), w0 * bfhi(a0.w) + w1 * bfhi(a1.w) + w2 * bfhi(a2.w));
        *(u32x4*)(Aout + (size_t)row * AW + h * 64 + ch * 8) = o; }
}

__device__ __forceinline__ float gelu_tanh(float y) { const float z = 1.5957691216f * (y + 0.044715f * y * y * y); return y * __builtin_amdgcn_rcpf(1.0f + __builtin_amdgcn_exp2f(-1.44269504089f * z)); }
constexpr int XLP = 136;
constexpr int S3_XL = 64 * ULP * 2, S3_KL = S3_XL + 64 * XLP * 2;
__device__ __forceinline__ void ssm_s3_item(int item, const float* dskip, const bf16* UH, bf16* Y, unsigned char* ws, const unsigned char* tab, unsigned char* lds, int tid) {
    const int g = item >> 3, mt = item & 7, w = tid >> 6, lane = tid & 63, fr = lane & 15, fq = lane >> 4;
    const bf16* KT = (const bf16*)(tab + TB_KT) + (size_t)g * 32 * 256; const bf16* P = (const bf16*)(tab + TB_P) + (size_t)g * 512 * 128; const bf16* XP = (const bf16*)(ws + WS_XP);
    { u32x4 xv[2], kv2[2];
#pragma unroll
      for (int k = 0; k < 2; ++k) { const int i = tid + NTHR * k; xv[k] = *(const u32x4*)(XP + ((size_t)(64 * mt + (i >> 4)) * 32 + g) * 128 + (i & 15) * 8); kv2[k] = *(const u32x4*)(KT + (size_t)i * 8); }
      ssm_stage_u(UH, g, mt, lds, tid);
#pragma unroll
      for (int k = 0; k < 2; ++k) { const int i = tid + NTHR * k; *(u32x4*)(lds + S3_XL + (i >> 4) * (XLP * 2) + (i & 15) * 16) = xv[k]; *(u32x4*)(lds + S3_KL + i * 16) = kv2[k]; } }
    const float* dsk = dskip + g * 16 + 4 * fq;
    const float d0 = dsk[0], d1 = dsk[1], d2 = dsk[2], d3 = dsk[3];
    __syncthreads();
    const bf16* UL = (const bf16*)lds; const bf16* XL = (const bf16*)(lds + S3_XL); const bf16* KL = (const bf16*)(lds + S3_KL);
    const int shalf = fq >> 1, c20 = 8 * (fq & 1);
#pragma unroll 1
    for (int ti = 0; ti < 4; ++ti) {
        const int t = (ti == 0) ? w : (ti == 1) ? 15 - w : (ti == 2) ? 16 + w : 31 - w;
        bf16x8 pf[4];
#pragma unroll
        for (int k2 = 0; k2 < 4; ++k2) pf[k2] = *(const bf16x8*)(P + (size_t)(t * 16 + fr) * 128 + 32 * k2 + 8 * fq);
        f32x4 acc[4];
#pragma unroll
        for (int mi = 0; mi < 4; ++mi) acc[mi] = (f32x4){0.f, 0.f, 0.f, 0.f};
        const int nks = (t >> 1) + 1;
#pragma unroll 2
        for (int ks = 0; ks < nks; ++ks) {
            const int s = 2 * ks + shalf, lag = t - s;
            bf16x8 wf = (bf16x8){0, 0, 0, 0, 0, 0, 0, 0};
            if (lag >= 0) wf = *(const bf16x8*)(KL + lag * 256 + fr * 16 + c20);
#pragma unroll
            for (int mi = 0; mi < 4; ++mi) { const bf16x8 uf = *(const bf16x8*)(UL + (16 * mi + fr) * ULP + s * 16 + c20);
                acc[mi] = __builtin_amdgcn_mfma_f32_16x16x32_bf16(wf, uf, acc[mi], 0, 0, 0); }
        }
#pragma unroll
        for (int k2 = 0; k2 < 4; ++k2)
#pragma unroll
            for (int mi = 0; mi < 4; ++mi) { const bf16x8 xf = *(const bf16x8*)(XL + (16 * mi + fr) * XLP + 32 * k2 + 8 * fq);
                acc[mi] = __builtin_amdgcn_mfma_f32_16x16x32_bf16(pf[k2], xf, acc[mi], 0, 0, 0); }
#pragma unroll
        for (int mi = 0; mi < 4; ++mi) { const size_t tok = (size_t)(64 * mt + 16 * mi + fr) * TC + t;
            const u32x2 uu = *(const u32x2*)(UL + (16 * mi + fr) * ULP + t * 16 + 4 * fq);
            const float y0 = acc[mi][0] + d0 * bflo(uu.x), y1 = acc[mi][1] + d1 * bfhi(uu.x), y2 = acc[mi][2] + d2 * bflo(uu.y), y3 = acc[mi][3] + d3 * bfhi(uu.y);
            u32x2 o; o.x = pk2(gelu_tanh(y0), gelu_tanh(y1)); o.y = pk2(gelu_tanh(y2), gelu_tanh(y3));
            *(u32x2*)(Y + tok * AW + 16 * g + 4 * fq) = o; }
    }
    __syncthreads();
}

#define XB_TMO      128
#define XB_XCNT(j)  (256  + 64 * (j))
#define XB_XSUB(j)  (1280 + 64 * (j))
#define XB_XGEN(j)  (2304 + 64 * (j))
#define XB_TOP      3328
#define XB_TOPGEN   3392
#define XCD_BAR_WORDS 3456
#define XB_SPIN_CAP (1u << 20)
__device__ __forceinline__ unsigned xb_ld(unsigned* p)              { return __hip_atomic_load(p, __ATOMIC_RELAXED, __HIP_MEMORY_SCOPE_AGENT); }
__device__ __forceinline__ unsigned xb_add(unsigned* p, unsigned v) { return __hip_atomic_fetch_add(p, v, __ATOMIC_RELAXED, __HIP_MEMORY_SCOPE_AGENT); }
__device__ __forceinline__ unsigned xb_xcc_id() { return (unsigned)__builtin_amdgcn_s_getreg((3 << 11) | 20) & 0xFu; }
#define XB_SPIN(cond, bar) do { unsigned _sp = 0; while (cond) { __builtin_amdgcn_s_sleep(1); \
    if ((++_sp & 255u) == 0u) { if (xb_ld(&(bar)[XB_TMO])) break; if (_sp > XB_SPIN_CAP) { atomicAdd(&(bar)[XB_TMO], 1u); break; } } } } while (0)
struct XcdBarrier { unsigned* bar; unsigned x; volatile LAS unsigned* st; };
__device__ __forceinline__ XcdBarrier xcd_barrier_post(unsigned* bar, volatile LAS unsigned* st) {
    XcdBarrier b; b.bar = bar; b.x = xb_xcc_id(); b.st = st;
    if (threadIdx.x == 0) (void)xb_add(&bar[XB_XCNT(b.x)], 1u);
    return b;
}
__device__ __forceinline__ void xcd_barrier_complete(unsigned* bar, unsigned x, unsigned& nloc, unsigned& nx) {
    const unsigned G = gridDim.x * gridDim.y * gridDim.z;
    unsigned sum, cnt, mine, sp = 0u;
    for (;;) {
        sum = 0u; cnt = 0u; mine = 0u;
#pragma unroll
        for (unsigned j = 0; j < 16; ++j) { const unsigned c = xb_ld(&bar[XB_XCNT(j)]); sum += c; cnt += (c > 0u) ? 1u : 0u; mine = (j == x) ? c : mine; }
        if (sum == G) break;
        __builtin_amdgcn_s_sleep(1);
        if ((++sp & 255u) == 0u) { if (xb_ld(&bar[XB_TMO])) break; if (sp > XB_SPIN_CAP) { atomicAdd(&bar[XB_TMO], 1u); break; } }
    }
    nloc = mine > 0u ? mine : 1u; nx = cnt > 0u ? cnt : 1u;
}
__device__ __forceinline__ void xcd_barrier(const XcdBarrier& b) {
    asm volatile("s_waitcnt vmcnt(0)" ::: "memory");
    __syncthreads();
    if (threadIdx.x == 0) {
        unsigned* bar = b.bar;
        __builtin_amdgcn_s_waitcnt(0);
        unsigned nloc = b.st[0], nx = b.st[1];
        if (nloc == 0u) { xcd_barrier_complete(bar, b.x, nloc, nx); b.st[0] = nloc; b.st[1] = nx; }
        const unsigned old = xb_add(&bar[XB_XSUB(b.x)], 1u);
        const unsigned gen = old / nloc;
        if (old + 1u == (gen + 1u) * nloc) {
            __builtin_amdgcn_fence(__ATOMIC_RELEASE, "agent");
            asm volatile("s_waitcnt vmcnt(0)" ::: "memory");
            const unsigned og = xb_add(&bar[XB_TOP], 1u);
            const unsigned tg = og / nx;
            if (og + 1u == (tg + 1u) * nx) xb_add(&bar[XB_TOPGEN], 1u);
            else XB_SPIN(xb_ld(&bar[XB_TOPGEN]) == tg, bar);
            __builtin_amdgcn_fence(__ATOMIC_ACQUIRE, "agent");
            xb_add(&bar[XB_XGEN(b.x)], 1u);
            asm volatile("s_waitcnt vmcnt(0)" ::: "memory");
        } else {
            XB_SPIN(xb_ld(&bar[XB_XGEN(b.x)]) == gen, bar);
            __builtin_amdgcn_fence(__ATOMIC_ACQUIRE, "agent");
            asm volatile("s_waitcnt vmcnt(0)" ::: "memory");
        }
    }
    __syncthreads();
}

constexpr int KPL = 8, N_PHASES = 1 + KPL * DEPTH;
__global__ void __launch_bounds__(NTHR, 2) mega_fwd(Args a) {
    extern __shared__ __attribute__((aligned(16))) unsigned char lds[];
    cg::grid_group grid = cg::this_grid();
    LAS unsigned char* ldsl = (LAS unsigned char*)lds;
    volatile LAS unsigned* bst = (volatile LAS unsigned*)(ldsl + 131072);
    if (threadIdx.x < 2) bst[threadIdx.x] = 0u;
    __syncthreads();
    XcdBarrier xbar; xbar.bar = (unsigned*)a.ws; xbar.x = 0; xbar.st = bst;
    if (a.ph_hi - a.ph_lo > 1) xbar = xcd_barrier_post((unsigned*)a.ws, bst);
    int prep = 0;
    for (int ph = a.ph_lo; ph < a.ph_hi; ++ph) {
        int zero; asm volatile("s_mov_b32 %0, 0" : "=s"(zero));
        int tid = threadIdx.x; asm volatile("" : "+v"(tid));
        const int lane = tid & 63, wave = __builtin_amdgcn_readfirstlane(tid >> 6);
        const int G = (int)gridDim.x + zero, bx = (int)blockIdx.x + zero;
        const int gw = bx * NWAVES + wave, ngw = G * NWAVES;
        unsigned char* ws = a.ws + zero; float* outp = a.out + zero;
        bf16* WB = (bf16*)(ws + WS_WB); bf16* QH = (bf16*)(ws + WS_Z); bf16* UG = (bf16*)(ws + WS_Z + 144 * MiB); bf16* UH = (bf16*)(ws + WS_Z + 208 * MiB); bf16* AK = QH + QPLANE; bf16* ACT = (bf16*)(ws + WS_ACT); bf16* Y = (bf16*)(ws + WS_Y); float* LSE = (float*)(ws + WS_LSE);
        bf16* MIX = QH;
        float* SS1 = (float*)(ws + WS_S); float* SS2 = (float*)(ws + WS_S + MiB);
        if (ph == 0) {
            for (int rep = 0; rep < NREP(15); ++rep) phase_weights(a, zero, WB, (float*)lds, gw, ngw, wave, lane);
            __syncthreads();
            for (int rep = 0; rep < NREP(12); ++rep) {
            for (int g = bx; g < 32; g += G) ssm_pre_item(a, zero, 0, g, ws + WS_TAB, (float*)lds, tid);
            phase_xprep(a.in[zero], ACT, SS2, gw, ngw, lane); }
        } else {
            const int l = (ph - 1) / KPL, k = (ph - 1) % KPL;
            const bf16* wl = WB + (size_t)l * LAYER_W;
            const float* xin = (l == 0) ? a.in[zero] : outp;
            unsigned char* tab = ws + WS_TAB + (size_t)(l & 1) * TAB_STRIDE;
            if (k == 0) {
                pg8::Gemm gm{ACT, wl + OFF_IN, MTOK, INC, DM, DM}; pg8::StaticOrder S; S.init(MTOK, INC, G, bx);
                PG8_LAS float* rst = (PG8_LAS float*)(ldsl + 131088); int pbase = 0;
                { pg8::Unit u0; if (S.next(0, u0)) { pbase = (u0.pm & ~7) * 256; for (int i = tid; i < 2048; i += NTHR) rst[i] = pg8::row_rstd(SS2, (size_t)(pbase + i)); } }
                __syncthreads();
                pg8::EpiZ E{QH, UG, UH, SS2, rst, pbase};
                pg8::gemm_phase<pg8::EpiZ, pg8::StaticOrder, true, true>(ldsl, tid, gm, S, E);
            } else if (k == 1) {
                const float* gq = a.in[3 + zero] + l * 64; const float* gk = a.in[4 + zero] + l * 64;
                u32x4 qv[2], kv[4], vv[4], qv2[2], kv2[4], vv2[4];
#pragma unroll
                for (int i = 0; i < 4; ++i) { qv[i & 1] = (u32x4){0u, 0u, 0u, 0u}; kv[i] = (u32x4){0u, 0u, 0u, 0u}; vv[i] = (u32x4){0u, 0u, 0u, 0u}; qv2[i & 1] = (u32x4){0u, 0u, 0u, 0u}; kv2[i] = (u32x4){0u, 0u, 0u, 0u}; vv2[i] = (u32x4){0u, 0u, 0u, 0u}; }
                if (bx < 3072) { const AttnItem A0 = attn_decode(bx); attn_load(A0, QH, tid, qv, kv, vv); }
                if (bx + G < 3072) { const AttnItem A1 = attn_decode(bx + G); attn_load(A1, QH, tid, qv2, kv2, vv2); }
                for (int it = bx; it < 3072; it += 2 * G) {
                    { const AttnItem A = attn_decode(it);
                      attn_stage(gq, gk, lds, tid, qv, kv, vv);
                      __builtin_amdgcn_sched_barrier(0);
                      __syncthreads();
                      if (it + 2 * G < 3072) { const AttnItem An = attn_decode(it + 2 * G); attn_load(An, QH, tid, qv, kv, vv); }
                      __builtin_amdgcn_sched_barrier(0);
                      attn_compute(A, QH, LSE, lds, tid);
                      __builtin_amdgcn_sched_barrier(0);
                      __syncthreads(); }
                    if (it + G < 3072) { const AttnItem A = attn_decode(it + G);
                      attn_stage(gq, gk, lds, tid, qv2, kv2, vv2);
                      __builtin_amdgcn_sched_barrier(0);
                      __syncthreads();
                      if (it + 3 * G < 3072) { const AttnItem An = attn_decode(it + 3 * G); attn_load(An, QH, tid, qv2, kv2, vv2); }
                      __builtin_amdgcn_sched_barrier(0);
                      attn_compute(A, QH, LSE, lds, tid);
                      __builtin_amdgcn_sched_barrier(0);
                      __syncthreads(); }
                }
                for (int it = bx; it < 256; it += G) for (int rep = 0; rep < NREP(2); ++rep) ssm_s1_item(it, UH, ws, tab, lds, tid);
            } else if (k == 2) {
                if (G >= 256) {
                    if (bx < 64) { for (int rep = 0; rep < NREP(3); ++rep) ssm_carry_item(bx, ws, tab, (float*)lds, tid); }
                    else if (bx < 96) { if (l + 1 < DEPTH) for (int rep = 0; rep < NREP(11); ++rep) ssm_pre_item(a, zero, l + 1, bx - 64, ws + WS_TAB + (size_t)((l + 1) & 1) * TAB_STRIDE, (float*)lds, tid); }
                    else { for (int rep = 0; rep < NREP(10); ++rep) phase_merge(QH, AK, LSE, (bx - 96) * NTHR + tid, (G - 96) * NTHR); }
                } else {
                    for (int it = bx; it < 64; it += G) ssm_carry_item(it, ws, tab, (float*)lds, tid);
                    if (l + 1 < DEPTH) for (int g = bx; g < 32; g += G) ssm_pre_item(a, zero, l + 1, g, ws + WS_TAB + (size_t)((l + 1) & 1) * TAB_STRIDE, (float*)lds, tid);
                    phase_merge(QH, AK, LSE, bx * NTHR + tid, G * NTHR);
                }
            } else if (k == 3) {
                const float* dskip = a.in[13 + zero] + l * 512;
                for (int rep = 0; rep < NREP(4); ++rep) for (int it = bx; it < 256; it += G) ssm_s3_item(it, dskip, UH, Y, ws, tab, lds, tid);
            } else if (k == 4) {
                { pg8::Gemm gm{AK, wl + OFF_P, MTOK, DM, AW, AW}; pg8::StaticOrder S; S.init(MTOK, DM, G, bx);
                  pg8::EpiGate1 E{MIX, DM, UG, UGP};
                  pg8::gemm_phase<pg8::EpiGate1, pg8::StaticOrder, true, true>(ldsl, tid, gm, S, E); }
                { pg8::Gemm gm{Y, wl + OFF_GLU, MTOK, 2 * DM, AW, AW}; pg8::PairOrder S; S.base.init(MTOK, DM, G, bx);
                  pg8::EpiGlu E{MIX, DM, UG + 1024, UGP};
                  pg8::gemm_phase<pg8::EpiGlu, pg8::PairOrder, true, true>(ldsl, tid, gm, S, E); }
            } else if (k == 5) {
                pg8::Gemm gm{MIX, wl + OFF_OUT, MTOK, DM, DM, DM}; pg8::StaticOrder S; S.init(MTOK, DM, G, bx);
                pg8::EpiResid E{xin, outp, DM, ACT, SS1};
                pg8::gemm_phase<pg8::EpiResid, pg8::StaticOrder, true, true>(ldsl, tid, gm, S, E);
            } else if (k == 6) {
                pg8::Gemm gm{ACT, wl + OFF_GU, MTOK, 2 * DFF, DM, DM}; pg8::StaticOrder S; S.init(MTOK, 2 * DFF, G, bx);
                PG8_LAS float* rst = (PG8_LAS float*)(ldsl + 131088); int pbase = 0;
                { pg8::Unit u0; if (S.next(0, u0)) { pbase = (u0.pm & ~7) * 256; for (int i = tid; i < 2048; i += NTHR) rst[i] = pg8::row_rstd(SS1, (size_t)(pbase + i)); } }
                __syncthreads();
                pg8::EpiSwiglu E{QH, DFF, SS1, rst, pbase};
                pg8::gemm_phase<pg8::EpiSwiglu, pg8::StaticOrder, true, true>(ldsl, tid, gm, S, E);
            } else {
                pg8::Gemm gm{QH, wl + OFF_DN, MTOK, DM, DFF, DFF}; pg8::StaticOrder S; S.init(MTOK, DM, G, bx);
                pg8::EpiResid E{outp, outp, DM, ACT, SS2};
                pg8::gemm_phase<pg8::EpiResid, pg8::StaticOrder, true, true>(ldsl, tid, gm, S, E);
            }
        }
        if (REP_PH != 0 && ph > 0 && ((REP_PH >> ((ph - 1) % KPL)) & 1) && prep == 0) { prep = 1; --ph; xcd_barrier(xbar); continue; }
        prep = 0;
        if (ph + 1 < a.ph_hi) { if (ph == a.ph_lo) grid.sync(); else { for (int sx = 0; sx < SYNC_X; ++sx) xcd_barrier(xbar); } }
    }
}

extern "C" void kernel_launch(void* const* d_in, const int* in_sizes, int n_in, void* d_out, int out_size, void* d_ws, size_t ws_size, hipStream_t stream) {
    static int grid = 0;
    if (grid == 0) {
        if (n_in != 21 || in_sizes[0] != MTOK * DM || out_size != MTOK * DM || ws_size < WS_END) { fprintf(stderr, "kernel_launch: unexpected shapes / workspace (n_in %d, ws %zu)\n", n_in, ws_size); grid = -1; return; }
        int dev = 0, cus = 0, per_cu = 0;
        (void)hipGetDevice(&dev); (void)hipDeviceGetAttribute(&cus, hipDeviceAttributeMultiprocessorCount, dev);
        (void)hipFuncSetAttribute((const void*)mega_fwd, hipFuncAttributeMaxDynamicSharedMemorySize, LDS_BYTES);
        (void)hipOccupancyMaxActiveBlocksPerMultiprocessor(&per_cu, (const void*)mega_fwd, NTHR, LDS_BYTES);
        if (per_cu < 1) per_cu = 1;
        (void)hipGetLastError();
        grid = cus * per_cu;
    }
    if (grid < 0) return;
    (void)hipMemsetAsync(d_ws, 0, 16384, stream);
    Args a{};
    for (int i = 0; i < 21; ++i) a.in[i] = (const float*)d_in[i];
    a.out = (float*)d_out; a.ws = (unsigned char*)d_ws;
#if MK_SINGLE
    a.ph_lo = 0; a.ph_hi = N_PHASES;
    void* args[] = {&a};
    hipError_t e = hipLaunchCooperativeKernel((const void*)mega_fwd, dim3(grid), dim3(NTHR), args, LDS_BYTES, stream);
    if (e != hipSuccess) fprintf(stderr, "cooperative launch failed: %s (grid %d)\n", hipGetErrorString(e), grid);
#else
    for (int ph = 0; ph < N_PHASES; ++ph) { a.ph_lo = ph; a.ph_hi = ph + 1; hipLaunchKernelGGL(mega_fwd, dim3(grid), dim3(NTHR), LDS_BYTES, stream, a); }
#endif
}
```

```cpp
#include <hip/hip_runtime.h>
#include <hip/hip_cooperative_groups.h>
#include <cstdio>
#include <cstdint>
namespace cg = cooperative_groups;

#ifndef REP_MASK
#define REP_MASK 0
#endif
#ifndef REP_PH
#define REP_PH 0
#endif
#ifndef REP_ATT
#define REP_ATT 0
#endif
#ifndef SYNC_X
#define SYNC_X 1
#endif
#define NREP(k) (((REP_MASK >> (k)) & 1) ? 2 : 1)
#ifndef MK_SINGLE
#define MK_SINGLE 1
#endif

namespace pg8 {
#define PG8_LAS __attribute__((address_space(3)))
typedef unsigned short bf16_t;
typedef short bf16x8 __attribute__((ext_vector_type(8)));
typedef float f32x4 __attribute__((ext_vector_type(4)));
typedef unsigned u32x4 __attribute__((ext_vector_type(4)));
constexpr int BM = 256, BK = 64, HALF = 128, HTB = HALF * BK * 2, STAGE_BYTES = 8 * HTB, NXCD = 8, WGM = 8;

__host__ __device__ __forceinline__ int lds_byte(int r, int c) { const int st = (r >> 4) * 2 + (c >> 5), rr = r & 15, cc = c & 31, ob = rr * 64 + cc * 2; return st * 1024 + (ob ^ (((ob >> 9) & 1) << 5)); }
__host__ __device__ __forceinline__ void stage_rc(int b, int& R, int& C) { const int st = b / 1024, sb = b % 1024, swz = sb ^ (((sb >> 9) & 1) << 5); R = (st >> 1) * 16 + swz / 64; C = (st & 1) * 32 + (swz % 64) / 2; }
__host__ __device__ __forceinline__ int perm32(int rho) { const int n = rho >> 4, i = rho & 15; return 8 * (i >> 2) + 4 * n + (i & 3); }

struct Unit { int pm, pn; };
struct Gemm { const bf16_t* A; const bf16_t* Bt; int M, N, K, lda; };

struct StaticOrder {
    int nM, nN, nwg, G, c;
    __host__ __device__ void init(int M, int N, int G_, int c_) { nM = M / BM; nN = N / BM; nwg = nM * nN; G = G_; c = c_; }
    __host__ __device__ bool next(int i, Unit& u) const {
        const long L = (long)i * G + c; if (L >= nwg) return false;
        int wgid = (int)L; { const int q = nwg / NXCD, r = nwg % NXCD, xcd = wgid % NXCD, off = wgid / NXCD; wgid = (xcd < r ? xcd * (q + 1) : r * (q + 1) + (xcd - r) * q) + off; }
        const int nig = WGM * nN, gid = wgid / nig, fm = gid * WGM, gsz = (nM - fm) < WGM ? (nM - fm) : WGM;
        u.pm = fm + ((wgid % nig) % gsz); u.pn = (wgid % nig) / gsz; return true;
    }
    __device__ __forceinline__ void a_ready(const Unit&) const {}
    __device__ __forceinline__ void done(const Unit&) const {}
};
struct PairOrder {
    StaticOrder base;
    __host__ __device__ bool next(int i, Unit& u) const { Unit b; if (!base.next(i >> 1, b)) return false; u.pm = b.pm; u.pn = 2 * b.pn + (i & 1); return true; }
    __device__ __forceinline__ void a_ready(const Unit&) const {}
    __device__ __forceinline__ void done(const Unit&) const {}
};

typedef float f32x2c_ __attribute__((ext_vector_type(2))); typedef __bf16 bf16x2c_ __attribute__((ext_vector_type(2)));
__device__ __forceinline__ unsigned cvt_pk_bf16(float lo, float hi) { const f32x2c_ v = {lo, hi}; const bf16x2c_ b = __builtin_convertvector(v, bf16x2c_); return __builtin_bit_cast(unsigned, b); }
__device__ __forceinline__ float bf_lo(unsigned w) { return __uint_as_float(w << 16); }
__device__ __forceinline__ float bf_hi(unsigned w) { return __uint_as_float(w & 0xffff0000u); }
__device__ __forceinline__ float sigmoidf_(float x) { return __builtin_amdgcn_rcpf(1.0f + __builtin_amdgcn_exp2f(-1.44269504089f * x)); }

__device__ __forceinline__ float row_rstd(const float* SSP, size_t row) {
    const f32x4* p = (const f32x4*)(SSP + row * 16); const f32x4 a = p[0], b = p[1], c = p[2], d = p[3];
    const float ss = ((a[0] + a[1]) + (a[2] + a[3])) + ((b[0] + b[1]) + (b[2] + b[3])) + ((c[0] + c[1]) + (c[2] + c[3])) + ((d[0] + d[1]) + (d[2] + d[3]));
    return rsqrtf(ss * (1.0f / 1024.0f) + 1e-6f);
}
struct EpiZ {
    static constexpr bool PERM = true, AFTER_DRAIN = false;
    bf16_t* QH; bf16_t* UG; bf16_t* UH; const float* SS; const PG8_LAS float* rst; int pbase;
    __device__ __forceinline__ void operator()(const f32x4 (&acc)[2][2][4][2], const Unit& u, int wr, int wc, int fr, int fq) const {
        const int row0 = u.pm * BM + wr * 64 + fr;
        float rs[2][4];
#pragma unroll
        for (int ai = 0; ai < 2; ++ai)
#pragma unroll
            for (int m = 0; m < 4; ++m) { const int rr = row0 + ai * HALF + m * 16, rl = rr - pbase; rs[ai][m] = ((unsigned)rl < 2048u) ? rst[rl] : row_rstd(SS, (size_t)rr); }
        if (u.pn < 18) {
            const int which = u.pn / 6, colt = (u.pn % 6) * 256;
#pragma unroll
            for (int bj = 0; bj < 2; ++bj) { const int col = colt + bj * HALF + wc * 32 + 8 * fq, gi = col >> 9, h = (col >> 6) & 7, e = col & 63, dsh = 2 * gi;
#pragma unroll
                for (int ai = 0; ai < 2; ++ai)
#pragma unroll
                    for (int m = 0; m < 4; ++m) { const int row = row0 + ai * HALF + m * 16, b = row >> 13, t = row & 8191, idx = ((t & ((1 << dsh) - 1)) << (13 - dsh)) + (t >> dsh);
                        const f32x4 v0 = acc[ai][bj][m][0] * rs[ai][m], v1 = acc[ai][bj][m][1] * rs[ai][m];
                        u32x4 w; w.x = cvt_pk_bf16(v0[0], v0[1]); w.y = cvt_pk_bf16(v0[2], v0[3]); w.z = cvt_pk_bf16(v1[0], v1[1]); w.w = cvt_pk_bf16(v1[2], v1[3]);
                        *(u32x4*)(QH + ((((size_t)(which * 2 + b) * 3 + gi) * 8 + h) * 8192 + idx) * 64 + e) = w; } }
        } else if (u.pn < 20) {
#pragma unroll
            for (int bj = 0; bj < 2; ++bj) { const int col = (u.pn - 18) * BM + bj * HALF + wc * 32 + 8 * fq, g = col >> 4, c0 = col & 15;
#pragma unroll
                for (int ai = 0; ai < 2; ++ai)
#pragma unroll
                    for (int m = 0; m < 4; ++m) { const int row = row0 + ai * HALF + m * 16;
                        const f32x4 v0 = acc[ai][bj][m][0] * rs[ai][m], v1 = acc[ai][bj][m][1] * rs[ai][m];
                        u32x4 w; w.x = cvt_pk_bf16(v0[0], v0[1]); w.y = cvt_pk_bf16(v0[2], v0[3]); w.z = cvt_pk_bf16(v1[0], v1[1]); w.w = cvt_pk_bf16(v1[2], v1[3]);
                        *(u32x4*)(UH + ((size_t)g * 16384 + row) * 16 + c0) = w; } }
        } else {
            const int col0 = (u.pn - 20) * BM + wc * 32 + 8 * fq;
#pragma unroll
            for (int ai = 0; ai < 2; ++ai)
#pragma unroll
                for (int m = 0; m < 4; ++m) { bf16_t* rowp = UG + (size_t)(row0 + ai * HALF + m * 16) * 2048 + col0;
#pragma unroll
                    for (int bj = 0; bj < 2; ++bj) { f32x4 v0 = acc[ai][bj][m][0] * rs[ai][m], v1 = acc[ai][bj][m][1] * rs[ai][m];
#pragma unroll
                        for (int j = 0; j < 4; ++j) { v0[j] = sigmoidf_(v0[j]); v1[j] = sigmoidf_(v1[j]); }
                        u32x4 w; w.x = cvt_pk_bf16(v0[0], v0[1]); w.y = cvt_pk_bf16(v0[2], v0[3]); w.z = cvt_pk_bf16(v1[0], v1[1]); w.w = cvt_pk_bf16(v1[2], v1[3]);
                        *(u32x4*)(rowp + bj * HALF) = w; } }
        }
    }
};
struct EpiGate1 {
    static constexpr bool PERM = true, AFTER_DRAIN = false;
    bf16_t* O; int ldc; const bf16_t* G; int ldg;
    __device__ __forceinline__ void operator()(const f32x4 (&acc)[2][2][4][2], const Unit& u, int wr, int wc, int fr, int fq) const {
        const int row0 = u.pm * BM + wr * 64 + fr, col0 = u.pn * BM + wc * 32 + 8 * fq;
#pragma unroll
        for (int ai = 0; ai < 2; ++ai)
#pragma unroll
            for (int m = 0; m < 4; ++m) { const size_t r = (size_t)(row0 + ai * HALF + m * 16);
#pragma unroll
                for (int bj = 0; bj < 2; ++bj) { const f32x4 v0 = acc[ai][bj][m][0], v1 = acc[ai][bj][m][1];
                    const u32x4 g = *(const u32x4*)(G + r * ldg + col0 + bj * HALF);
                    u32x4 w; w.x = cvt_pk_bf16(v0[0] * bf_lo(g.x), v0[1] * bf_hi(g.x)); w.y = cvt_pk_bf16(v0[2] * bf_lo(g.y), v0[3] * bf_hi(g.y));
                    w.z = cvt_pk_bf16(v1[0] * bf_lo(g.z), v1[1] * bf_hi(g.z)); w.w = cvt_pk_bf16(v1[2] * bf_lo(g.w), v1[3] * bf_hi(g.w));
                    *(u32x4*)(O + r * ldc + col0 + bj * HALF) = w; }
                asm volatile("" ::: "memory"); }
    }
};
struct EpiGlu {
    static constexpr bool PERM = true, AFTER_DRAIN = false;
    bf16_t* O; int ldc; const bf16_t* G; int ldg;
    __device__ __forceinline__ void operator()(const f32x4 (&acc)[2][2][4][2], const Unit& u, int wr, int wc, int fr, int fq) const {
        const int row0 = u.pm * BM + wr * 64 + fr, col0 = u.pn * HALF + wc * 32 + 8 * fq;
#pragma unroll
        for (int ai = 0; ai < 2; ++ai)
#pragma unroll
            for (int m = 0; m < 4; ++m) { const size_t r = (size_t)(row0 + ai * HALF + m * 16);
                const u32x4 g = *(const u32x4*)(G + r * ldg + col0); const u32x4 t = *(const u32x4*)(O + r * ldc + col0);
                const f32x4 a0 = acc[ai][0][m][0], a1 = acc[ai][0][m][1], b0 = acc[ai][1][m][0], b1 = acc[ai][1][m][1];
                u32x4 w;
                w.x = cvt_pk_bf16(bf_lo(t.x) + bf_lo(g.x) * a0[0] * sigmoidf_(b0[0]), bf_hi(t.x) + bf_hi(g.x) * a0[1] * sigmoidf_(b0[1]));
                w.y = cvt_pk_bf16(bf_lo(t.y) + bf_lo(g.y) * a0[2] * sigmoidf_(b0[2]), bf_hi(t.y) + bf_hi(g.y) * a0[3] * sigmoidf_(b0[3]));
                w.z = cvt_pk_bf16(bf_lo(t.z) + bf_lo(g.z) * a1[0] * sigmoidf_(b1[0]), bf_hi(t.z) + bf_hi(g.z) * a1[1] * sigmoidf_(b1[1]));
                w.w = cvt_pk_bf16(bf_lo(t.w) + bf_lo(g.w) * a1[2] * sigmoidf_(b1[2]), bf_hi(t.w) + bf_hi(g.w) * a1[3] * sigmoidf_(b1[3]));
                *(u32x4*)(O + r * ldc + col0) = w; asm volatile("" ::: "memory"); }
    }
};
struct EpiSwiglu {
    static constexpr bool PERM = true, AFTER_DRAIN = false;
    bf16_t* O; int ldc; const float* SS; const PG8_LAS float* rst; int pbase;
    __device__ __forceinline__ void operator()(const f32x4 (&acc)[2][2][4][2], const Unit& u, int wr, int wc, int fr, int fq) const {
        const int row0 = u.pm * BM + wr * 64 + fr, col0 = u.pn * HALF + wc * 32 + 8 * fq;
#pragma unroll
        for (int ai = 0; ai < 2; ++ai)
#pragma unroll
            for (int m = 0; m < 4; ++m) { const size_t r = (size_t)(row0 + ai * HALF + m * 16);
                const int rl = (int)r - pbase; const float rs = ((unsigned)rl < 2048u) ? rst[rl] : row_rstd(SS, r);
                const f32x4 a0 = acc[ai][0][m][0] * rs, a1 = acc[ai][0][m][1] * rs, b0 = acc[ai][1][m][0] * rs, b1 = acc[ai][1][m][1] * rs;
                u32x4 w;
                w.x = cvt_pk_bf16(a0[0] * sigmoidf_(a0[0]) * b0[0], a0[1] * sigmoidf_(a0[1]) * b0[1]);
                w.y = cvt_pk_bf16(a0[2] * sigmoidf_(a0[2]) * b0[2], a0[3] * sigmoidf_(a0[3]) * b0[3]);
                w.z = cvt_pk_bf16(a1[0] * sigmoidf_(a1[0]) * b1[0], a1[1] * sigmoidf_(a1[1]) * b1[1]);
                w.w = cvt_pk_bf16(a1[2] * sigmoidf_(a1[2]) * b1[2], a1[3] * sigmoidf_(a1[3]) * b1[3]);
                *(u32x4*)(O + r * ldc + col0) = w; }
    }
};
struct EpiResid {
    static constexpr bool PERM = false, AFTER_DRAIN = false;
    const float* R; float* C; int ldc; bf16_t* XB; float* SS;
    __device__ __forceinline__ void operator()(const f32x4 (&acc)[2][2][4][2], const Unit& u, int wr, int wc, int fr, int fq) const {
        const int row0 = u.pm * BM + wr * 64 + fr, col0 = u.pn * BM + wc * 32 + 4 * fq;
#pragma unroll
        for (int ai = 0; ai < 2; ++ai)
#pragma unroll
            for (int m = 0; m < 4; ++m) { const int row = row0 + ai * HALF + m * 16; const size_t off = (size_t)row * ldc + col0; float ss = 0.f;
#pragma unroll
                for (int bj = 0; bj < 2; ++bj)
#pragma unroll
                    for (int n = 0; n < 2; ++n) { const f32x4 rv = *(const f32x4*)(R + off + bj * HALF + n * 16); const f32x4 o = acc[ai][bj][m][n] + rv; *(f32x4*)(C + off + bj * HALF + n * 16) = o;
                        ss += (o[0] * o[0] + o[1] * o[1]) + (o[2] * o[2] + o[3] * o[3]);
                        unsigned w0 = cvt_pk_bf16(o[0], o[1]), w1 = cvt_pk_bf16(o[2], o[3]); typedef unsigned u32x2_ __attribute__((ext_vector_type(2))); *(u32x2_*)(XB + off + bj * HALF + n * 16) = (u32x2_){w0, w1}; }
                ss += __shfl_xor(ss, 16); ss += __shfl_xor(ss, 32);
                if (fq == 0) SS[(size_t)row * 16 + u.pn * 4 + wc] = ss;
                asm volatile("" ::: "memory"); }
    }
};

template <class Epi, class Sched, bool ALIGN_EPI = false, bool SP2 = false>
__device__ __forceinline__ void gemm_phase(PG8_LAS unsigned char* lds, const int tid, const Gemm g, const Sched& S, const Epi& E) {
    const int wid = __builtin_amdgcn_readfirstlane(tid >> 6), lane = tid & 63, wr = wid >> 2, wc = wid & 3, fr = lane & 15, fq = lane >> 4;
    const int K = g.K, nt = K / BK, lda = g.lda;
    unsigned voffA[2], voffB[2];
#pragma unroll
    for (int i = 0; i < 2; ++i) { int R, C; stage_rc(tid * 16 + i * 8192, R, C); const int Rb = Epi::PERM ? ((R & ~31) + perm32(R & 31)) : R;
        voffA[i] = (unsigned)(R * lda + C) * 2u; voffB[i] = (unsigned)(Rb * K + C) * 2u; }
    const size_t kstep = (size_t)(BK * 2);
    const size_t hA = (size_t)HALF * lda * 2, hB = (size_t)HALF * K * 2;
    const size_t tA = 2 * hA, tB = 2 * hB;
    const unsigned ldsw = (unsigned)wid * 1024u;
    const int aoff = lds_byte(wr * 64 + fr, fq * 8), boff = lds_byte(wc * 32 + fr, fq * 8);
#define PG8_SA(b, h) (((b) * 2 + (h)) * HTB)
#define PG8_SB(b, h) ((4 + (b) * 2 + (h)) * HTB)
#define PG8_STAGE(bufoff, gbase, voff) do { _Pragma("unroll") for (int _i = 0; _i < 2; ++_i) \
        __builtin_amdgcn_global_load_lds((const unsigned*)((const char*)(gbase) + (voff)[_i]), (PG8_LAS unsigned*)(lds + (bufoff) + ldsw + _i * 8192), 16, 0, 0); } while (0)
#define PG8_LDA(dst, b, h) do { _Pragma("unroll") for (int m = 0; m < 4; ++m) _Pragma("unroll") for (int k = 0; k < 2; ++k) dst[m][k] = *(const PG8_LAS bf16x8*)(lds + PG8_SA(b, h) + aoff + m * 2048 + k * 1024); } while (0)
#define PG8_LDB(dst, b, h) do { _Pragma("unroll") for (int n = 0; n < 2; ++n) _Pragma("unroll") for (int k = 0; k < 2; ++k) dst[n][k] = *(const PG8_LAS bf16x8*)(lds + PG8_SB(b, h) + boff + n * 2048 + k * 1024); } while (0)
#define PG8_MMA(ai, bj, At, Bt) do { __builtin_amdgcn_s_setprio(1); _Pragma("unroll") for (int m = 0; m < 4; ++m) _Pragma("unroll") for (int n = 0; n < 2; ++n) _Pragma("unroll") for (int k = 0; k < 2; ++k) \
        acc[ai][bj][m][n] = __builtin_amdgcn_mfma_f32_16x16x32_bf16(Bt[n][k], At[m][k], acc[ai][bj][m][n], 0, 0, 0); __builtin_amdgcn_s_setprio(0); } while (0)
#define PG8_WAIT_V(n) asm volatile("s_waitcnt vmcnt(" #n ")" ::: "memory")
#define PG8_WAIT_L(n) asm volatile("s_waitcnt lgkmcnt(" #n ")" ::: "memory")
#define PG8_BAR __builtin_amdgcn_s_barrier()
#define PG8_SCHED __builtin_amdgcn_sched_barrier(0)
    Unit cur, nxt; int ui = 0;
    if (!S.next(0, cur)) return;
    f32x4 acc[2][2][4][2];
#pragma unroll
    for (int a = 0; a < 2; ++a)
#pragma unroll
        for (int b = 0; b < 2; ++b)
#pragma unroll
            for (int m = 0; m < 4; ++m)
#pragma unroll
                for (int n = 0; n < 2; ++n) acc[a][b][m][n] = (f32x4){0.f, 0.f, 0.f, 0.f};
    bf16x8 At[4][2], B0[2][2], B1[2][2];
    const char* cA = (const char*)g.A + (size_t)cur.pm * tA; const char* cB = (const char*)g.Bt + (size_t)cur.pn * tB;
    S.a_ready(cur);
    if constexpr (SP2) {
        PG8_STAGE(PG8_SB(0, 0), cB, voffB); PG8_STAGE(PG8_SB(0, 1), cB + hB, voffB); PG8_STAGE(PG8_SA(0, 0), cA, voffA); PG8_STAGE(PG8_SA(0, 1), cA + hA, voffA);
        if (wr == 1) PG8_BAR;
        PG8_WAIT_V(2); PG8_BAR;
        PG8_STAGE(PG8_SB(1, 0), cB + kstep, voffB); PG8_STAGE(PG8_SA(1, 0), cA + kstep, voffA); PG8_STAGE(PG8_SB(1, 1), cB + hB + kstep, voffB);
        PG8_WAIT_V(6); PG8_BAR;
    } else {
        PG8_STAGE(PG8_SB(0, 0), cB, voffB); PG8_STAGE(PG8_SA(0, 0), cA, voffA); PG8_STAGE(PG8_SB(0, 1), cB + hB, voffB); PG8_STAGE(PG8_SA(0, 1), cA + hA, voffA);
        if (wr == 1) PG8_BAR;
        PG8_WAIT_V(4); PG8_BAR;
        PG8_STAGE(PG8_SB(1, 0), cB + kstep, voffB); PG8_STAGE(PG8_SA(1, 0), cA + kstep, voffA); PG8_STAGE(PG8_SB(1, 1), cB + hB + kstep, voffB);
        PG8_WAIT_V(6); PG8_BAR;
    }
    for (;;) {
        const bool has_next = S.next(ui + 1, nxt);
        const char* nA = has_next ? (const char*)g.A + (size_t)nxt.pm * tA : cA; const char* nB = has_next ? (const char*)g.Bt + (size_t)nxt.pn * tB : cB;
        for (int t = 0; t < nt; t += 2) {
            const bool last = (t == nt - 2);
            const char* a1 = cA + (size_t)(t + 1) * kstep;
            const char* a2 = last ? nA : cA + (size_t)(t + 2) * kstep; const char* b2 = last ? nB : cB + (size_t)(t + 2) * kstep;
            const char* a3 = a2 + kstep; const char* b3 = b2 + kstep;
            if (last && has_next) S.a_ready(nxt);
            if constexpr (SP2) {
            PG8_LDB(B0, 0, 0); PG8_LDB(B1, 0, 1); PG8_SCHED; PG8_LDA(At, 0, 0); PG8_STAGE(PG8_SA(1, 1), a1 + hA, voffA);
            PG8_WAIT_V(8); PG8_WAIT_L(0); PG8_BAR; PG8_MMA(0, 0, At, B0); PG8_MMA(0, 1, At, B1); PG8_BAR; PG8_SCHED;
            PG8_LDA(At, 0, 1); PG8_STAGE(PG8_SB(0, 0), b2, voffB); PG8_STAGE(PG8_SB(0, 1), b2 + hB, voffB); PG8_STAGE(PG8_SA(0, 0), a2, voffA);
            PG8_WAIT_V(8); PG8_WAIT_L(0); PG8_BAR; PG8_MMA(1, 0, At, B0); PG8_MMA(1, 1, At, B1); PG8_BAR; PG8_SCHED;
            PG8_LDB(B0, 1, 0); PG8_LDB(B1, 1, 1); PG8_SCHED; PG8_LDA(At, 1, 0); PG8_STAGE(PG8_SA(0, 1), a2 + hA, voffA);
            PG8_WAIT_V(8); PG8_WAIT_L(0); PG8_BAR; PG8_MMA(0, 0, At, B0); PG8_MMA(0, 1, At, B1); PG8_BAR; PG8_SCHED;
            PG8_LDA(At, 1, 1); PG8_STAGE(PG8_SB(1, 0), b3, voffB); PG8_STAGE(PG8_SB(1, 1), b3 + hB, voffB); PG8_STAGE(PG8_SA(1, 0), a3, voffA);
            PG8_WAIT_V(8); PG8_WAIT_L(0); PG8_BAR; PG8_MMA(1, 0, At, B0); PG8_MMA(1, 1, At, B1); PG8_BAR; PG8_SCHED;
            } else {
            PG8_LDB(B0, 0, 0); PG8_SCHED; PG8_LDA(At, 0, 0); PG8_STAGE(PG8_SA(1, 1), a1 + hA, voffA);
            PG8_WAIT_L(8); PG8_BAR; PG8_WAIT_L(0); PG8_MMA(0, 0, At, B0); PG8_BAR; PG8_SCHED;
            PG8_LDB(B1, 0, 1); PG8_STAGE(PG8_SB(0, 0), b2, voffB);
            PG8_BAR; PG8_WAIT_L(0); PG8_MMA(0, 1, At, B1); PG8_BAR;
            PG8_LDA(At, 0, 1); PG8_STAGE(PG8_SA(0, 0), a2, voffA);
            PG8_BAR; PG8_WAIT_L(0); PG8_MMA(1, 0, At, B0); PG8_BAR; PG8_SCHED;
            PG8_STAGE(PG8_SB(0, 1), b2 + hB, voffB);
            PG8_WAIT_V(6); PG8_BAR; PG8_MMA(1, 1, At, B1); PG8_BAR;
            PG8_LDB(B0, 1, 0); PG8_SCHED; PG8_LDA(At, 1, 0); PG8_STAGE(PG8_SA(0, 1), a2 + hA, voffA);
            PG8_WAIT_L(8); PG8_BAR; PG8_WAIT_L(0); PG8_MMA(0, 0, At, B0); PG8_BAR; PG8_SCHED;
            PG8_LDB(B1, 1, 1); PG8_STAGE(PG8_SB(1, 0), b3, voffB);
            PG8_BAR; PG8_WAIT_L(0); PG8_MMA(0, 1, At, B1); PG8_BAR;
            PG8_LDA(At, 1, 1); PG8_STAGE(PG8_SA(1, 0), a3, voffA);
            PG8_BAR; PG8_WAIT_L(0); PG8_MMA(1, 0, At, B0); PG8_BAR; PG8_SCHED;
            PG8_STAGE(PG8_SB(1, 1), b3 + hB, voffB);
            PG8_WAIT_V(6); PG8_BAR; PG8_MMA(1, 1, At, B1); PG8_BAR;
            }
        }
        if constexpr (ALIGN_EPI) { if (wr == 0) PG8_BAR; }
        if constexpr (!Epi::AFTER_DRAIN) { E(acc, cur, wr, wc, fr, fq); S.done(cur); }
        if (!has_next) break;
#pragma unroll
        for (int a = 0; a < 2; ++a)
#pragma unroll
            for (int b = 0; b < 2; ++b)
#pragma unroll
                for (int m = 0; m < 4; ++m)
#pragma unroll
                    for (int n = 0; n < 2; ++n) acc[a][b][m][n] = (f32x4){0.f, 0.f, 0.f, 0.f};
        cur = nxt; cA = nA; cB = nB; ++ui;
        if constexpr (ALIGN_EPI) { if (wr == 1) PG8_BAR; }
    }
    PG8_WAIT_V(0);
    if constexpr (!ALIGN_EPI) { if (wr == 0) PG8_BAR; }
    PG8_BAR;
#undef PG8_SA
#undef PG8_SB
#undef PG8_STAGE
#undef PG8_LDA
#undef PG8_LDB
#undef PG8_MMA
#undef PG8_WAIT_V
#undef PG8_WAIT_L
#undef PG8_BAR
#undef PG8_SCHED
}
}

typedef unsigned short bf16;
typedef short bf16x8 __attribute__((ext_vector_type(8)));
typedef float f32x4 __attribute__((ext_vector_type(4)));
typedef unsigned u32x4 __attribute__((ext_vector_type(4)));
typedef unsigned u32x2 __attribute__((ext_vector_type(2)));
#define LAS __attribute__((address_space(3)))

constexpr int NWAVES = 8, NTHR = 512;
constexpr int DM = 1024, SEQ = 8192, MTOK = 16384, DEPTH = 4;
constexpr int INC = 7168, DFF = 2816, AW = 512;
constexpr int COL_Q = 0, COL_K = 1536, COL_V = 3072, COL_U = 4608, COL_GA = 5120, COL_GS = 6144;
constexpr int UGP = 2048;
constexpr int TC = 32, NCH = MTOK / TC  , CHB = SEQ / TC  ;
constexpr float EPS = 1e-6f;

constexpr size_t OFF_IN = 0, OFF_P = 7340032, OFF_GLU = 7864320, OFF_OUT = 8912896, OFF_GU = 9961472, OFF_DN = 15728640, LAYER_W = 18612224;
constexpr size_t MiB = 1u << 20;
constexpr size_t WS_SS1 = 65536, WS_SS2 = 131072;
constexpr size_t WS_WB = 1 * MiB, WS_Z = 143 * MiB, WS_ACT = 367 * MiB, WS_Y = 399 * MiB, WS_LSE = 415 * MiB, WS_TAB = 417 * MiB, TAB_STRIDE = 9 * MiB,
                 WS_S = 435 * MiB, WS_XP = 443 * MiB, WS_END = 447 * MiB;
constexpr size_t TB_KT = 0, TB_AT = 768 * 1024, TB_E = 1 * MiB, TB_P = 5 * MiB;
static_assert(WS_WB + 4 * LAYER_W * 2 <= WS_Z && WS_Z + (size_t)MTOK * INC * 2 <= WS_ACT, "ws map");
constexpr int LDS_BYTES = 147456;

struct Args { const float* in[21]; float* out; unsigned char* ws; int ph_lo, ph_hi; };

__device__ __forceinline__ unsigned f2bf(float f) { unsigned u = __float_as_uint(f); return (u + 0x7fffu + ((u >> 16) & 1u)) >> 16; }
__device__ __forceinline__ unsigned pk2(float lo, float hi) { return pg8::cvt_pk_bf16(lo, hi); }
__device__ __forceinline__ float bflo(unsigned w) { return __uint_as_float(w << 16); }
__device__ __forceinline__ float bfhi(unsigned w) { return __uint_as_float(w & 0xffff0000u); }
__device__ __forceinline__ float wave_sum(float v) {
#pragma unroll
    for (int o = 1; o < 64; o <<= 1) v += __shfl_xor(v, o);
    return v;
}

__device__ __forceinline__ void transpose_item(const float* W, int K, int N, bf16* WT, int il_off, float* scr, int item, int lane, const float* gk = nullptr) {
    const int nblk = N / 64, kb = item / nblk, nb = item % nblk, k0 = 64 * kb, n0 = 64 * nb;
    const float* src = W + (size_t)k0 * N + n0 + lane;
#pragma unroll 16
    for (int i = 0; i < 64; ++i) scr[i * 65 + lane] = src[(size_t)i * N];
    const int drow = (il_off < 0) ? n0 : (n0 / 128) * 256 + il_off + (n0 % 128);
    const int c = lane & 7, nn = lane >> 3;
    f32x4 g0 = (f32x4){1.f, 1.f, 1.f, 1.f}, g1 = g0;
    if (gk) { g0 = *(const f32x4*)(gk + k0 + 8 * c); g1 = *(const f32x4*)(gk + k0 + 8 * c + 4); }
#pragma unroll
    for (int j = 0; j < 8; ++j) { const int n = nn + 8 * j; const float* p = scr + (8 * c) * 65 + n;
        u32x4 o; o.x = pk2(p[0 * 65] * g0.x, p[1 * 65] * g0.y); o.y = pk2(p[2 * 65] * g0.z, p[3 * 65] * g0.w); o.z = pk2(p[4 * 65] * g1.x, p[5 * 65] * g1.y); o.w = pk2(p[6 * 65] * g1.z, p[7 * 65] * g1.w);
        *(u32x4*)(WT + (size_t)(drow + n) * K + k0 + 8 * c) = o; }
}
__device__ __forceinline__ void phase_weights(const Args& a, int zero, bf16* WB, float* ldsf, int gw, int ngw, int wave, int lane) {
    float* scr = ldsf + wave * 4352;
    constexpr int PER_LAYER = 4544;
    for (int it = gw; it < DEPTH * PER_LAYER; it += ngw) {
        const int l = it / PER_LAYER; int r = it % PER_LAYER; bf16* wl = WB + (size_t)l * LAYER_W;
        if (r < 1792) { transpose_item(a.in[2 + zero] + (size_t)l * DM * INC, DM, INC, wl + OFF_IN, -1, scr, r, lane, a.in[1 + zero] + l * DM); continue; } r -= 1792;
        if (r < 128) { transpose_item(a.in[5 + zero] + (size_t)l * AW * DM, AW, DM, wl + OFF_P, -1, scr, r, lane); continue; } r -= 128;
        if (r < 128) { transpose_item(a.in[14 + zero] + (size_t)l * AW * DM, AW, DM, wl + OFF_GLU, 0, scr, r, lane); continue; } r -= 128;
        if (r < 128) { transpose_item(a.in[15 + zero] + (size_t)l * AW * DM, AW, DM, wl + OFF_GLU, 128, scr, r, lane); continue; } r -= 128;
        if (r < 256) { transpose_item(a.in[16 + zero] + (size_t)l * DM * DM, DM, DM, wl + OFF_OUT, -1, scr, r, lane); continue; } r -= 256;
        if (r < 704) { transpose_item(a.in[18 + zero] + (size_t)l * DM * DFF, DM, DFF, wl + OFF_GU, 0, scr, r, lane, a.in[17 + zero] + l * DM); continue; } r -= 704;
        if (r < 704) { transpose_item(a.in[19 + zero] + (size_t)l * DM * DFF, DM, DFF, wl + OFF_GU, 128, scr, r, lane, a.in[17 + zero] + l * DM); continue; } r -= 704;
        transpose_item(a.in[20 + zero] + (size_t)l * DFF * DM, DFF, DM, wl + OFF_DN, -1, scr, r, lane);
    }
}

__device__ __forceinline__ void phase_xprep(const float* x, bf16* out, float* SS, int gw, int ngw, int lane) {
    for (int m = gw; m < MTOK; m += ngw) {
        const f32x4* xr = (const f32x4*)(x + (size_t)m * DM) + lane;
        f32x4 v[4]; float s = 0.f;
#pragma unroll
        for (int j = 0; j < 4; ++j) { v[j] = xr[64 * j]; s += (v[j].x * v[j].x + v[j].y * v[j].y) + (v[j].z * v[j].z + v[j].w * v[j].w); }
        s = wave_sum(s);
        u32x2* o8 = (u32x2*)(out + (size_t)m * DM) + lane;
#pragma unroll
        for (int j = 0; j < 4; ++j) { u32x2 w; w.x = pk2(v[j].x, v[j].y); w.y = pk2(v[j].z, v[j].w); o8[64 * j] = w; }
        if (lane < 16) SS[(size_t)m * 16 + lane] = (lane == 0) ? s : 0.f;
    }
}

__device__ __forceinline__ void ssm_pre_item(const Args& a, int zero, int l, int g, unsigned char* tab, float* L, int tid) {
    float* pw = L; float* bb = L + 4224; float* cc = L + 6272;
    const float* lam_re = a.in[6 + zero] + (size_t)(l * 32 + g) * 64; const float* lam_im = a.in[7 + zero] + (size_t)(l * 32 + g) * 64;
    const float* b_re = a.in[9 + zero] + (size_t)(l * 32 + g) * 1024; const float* b_im = a.in[10 + zero] + (size_t)(l * 32 + g) * 1024;
    const float* c_re = a.in[11 + zero] + (size_t)(l * 32 + g) * 1024; const float* c_im = a.in[12 + zero] + (size_t)(l * 32 + g) * 1024;
    const float ldt = a.in[8 + zero][l * 32 + g];
    const double INV_2PI = 0.15915494309189533577, TWO_PI = 6.283185307179586476925;
    float brv[2], biv[2], crv[2], civ[2], lrv[5], liv[5];
#pragma unroll
    for (int q = 0; q < 2; ++q) { const int i = tid + NTHR * q; brv[q] = b_re[i]; biv[q] = b_im[i]; crv[q] = c_re[i]; civ[q] = c_im[i]; }
#pragma unroll
    for (int q = 0; q < 5; ++q) { const int i = tid + NTHR * q, p = i & 63; lrv[q] = lam_re[p]; liv[q] = lam_im[p]; }
    const float dt = expf(ldt);
#pragma unroll
    for (int q = 0; q < 2; ++q) { const int i = tid + NTHR * q, p = i >> 4; const float lr = lam_re[p], li = lam_im[p];
        const double angle = (double)li * (double)dt; const double rr = angle - TWO_PI * rint(angle * INV_2PI);
        float sn, cs; sincosf((float)rr, &sn, &cs); const float mag = expf(lr * dt);
        const float nr = mag * cs - 1.0f, ni = mag * sn, den = lr * lr + li * li;
        const float cr = (nr * lr + ni * li) / den, ci = (ni * lr - nr * li) / den;
        bb[i * 2] = cr * brv[q] - ci * biv[q]; bb[i * 2 + 1] = cr * biv[q] + ci * brv[q];
        cc[i * 2] = crv[q]; cc[i * 2 + 1] = civ[q]; }
#pragma unroll
    for (int q = 0; q < 5; ++q) { const int i = tid + NTHR * q; if (i < 33 * 64) { const int j = i >> 6;
        const double angle = (double)liv[q] * (double)dt * (double)j; const double rr = angle - TWO_PI * rint(angle * INV_2PI);
        float sn, cs; sincosf((float)rr, &sn, &cs); const float mag = expf(lrv[q] * dt * (float)j);
        pw[i * 2] = mag * cs; pw[i * 2 + 1] = mag * sn; } }
    __syncthreads();
    bf16* KT = (bf16*)(tab + TB_KT) + (size_t)g * 32 * 256; bf16* E = (bf16*)(tab + TB_E) + (size_t)g * 128 * 512; bf16* P = (bf16*)(tab + TB_P) + (size_t)g * 512 * 128;
    float* AT = (float*)(tab + TB_AT) + g * 128;
    { const int j = tid >> 4, c = tid & 15; float acc16[16];
#pragma unroll
      for (int q = 0; q < 16; ++q) acc16[q] = 0.f;
      for (int p = 0; p < 64; ++p) { const float Cr = cc[(c * 64 + p) * 2], Ci = cc[(c * 64 + p) * 2 + 1], wr_ = pw[(j * 64 + p) * 2], wi_ = pw[(j * 64 + p) * 2 + 1];
          const float tr = Cr * wr_ - Ci * wi_, ti = Cr * wi_ + Ci * wr_; const f32x4* b4 = (const f32x4*)(bb + p * 32);
#pragma unroll
          for (int q = 0; q < 8; ++q) { const f32x4 bv = b4[q]; acc16[2 * q] += tr * bv.x - ti * bv.y; acc16[2 * q + 1] += tr * bv.z - ti * bv.w; } }
      u32x4 o0, o1; o0.x = pk2(acc16[0], acc16[1]); o0.y = pk2(acc16[2], acc16[3]); o0.z = pk2(acc16[4], acc16[5]); o0.w = pk2(acc16[6], acc16[7]);
      o1.x = pk2(acc16[8], acc16[9]); o1.y = pk2(acc16[10], acc16[11]); o1.z = pk2(acc16[12], acc16[13]); o1.w = pk2(acc16[14], acc16[15]);
      *(u32x4*)(KT + (size_t)tid * 16) = o0; *(u32x4*)(KT + (size_t)tid * 16 + 8) = o1; }
    for (int i8 = tid; i8 < 128 * 64; i8 += NTHR) { const int row = i8 >> 6, k8 = i8 & 63, p = row & 63, s_ = k8 >> 1, c0 = (k8 & 1) * 8, j = 31 - s_;
        const float wr_ = pw[(j * 64 + p) * 2], wi_ = pw[(j * 64 + p) * 2 + 1]; const f32x4* b4 = (const f32x4*)(bb + (p * 16 + c0) * 2); float v[8];
#pragma unroll
        for (int q = 0; q < 4; ++q) { const f32x4 bv = b4[q];
            v[2 * q] = (row < 64) ? (wr_ * bv.x - wi_ * bv.y) : (wr_ * bv.y + wi_ * bv.x); v[2 * q + 1] = (row < 64) ? (wr_ * bv.z - wi_ * bv.w) : (wr_ * bv.w + wi_ * bv.z); }
        u32x4 o; o.x = pk2(v[0], v[1]); o.y = pk2(v[2], v[3]); o.z = pk2(v[4], v[5]); o.w = pk2(v[6], v[7]);
        *(u32x4*)(E + (size_t)i8 * 8) = o; }
    for (int i8 = tid; i8 < 512 * 16; i8 += NTHR) { const int row = i8 >> 4, q0 = (i8 & 15) * 8, p0 = q0 & 63, t = row >> 4, c = row & 15, j = t + 1;
        const f32x4* c4 = (const f32x4*)(cc + (c * 64 + p0) * 2); const f32x4* w4 = (const f32x4*)(pw + (j * 64 + p0) * 2); float v[8];
#pragma unroll
        for (int q = 0; q < 4; ++q) { const f32x4 cv = c4[q], wv = w4[q];
            v[2 * q] = (q0 < 64) ? (cv.x * wv.x - cv.y * wv.y) : -(cv.x * wv.y + cv.y * wv.x); v[2 * q + 1] = (q0 < 64) ? (cv.z * wv.z - cv.w * wv.w) : -(cv.z * wv.w + cv.w * wv.z); }
        u32x4 o; o.x = pk2(v[0], v[1]); o.y = pk2(v[2], v[3]); o.z = pk2(v[4], v[5]); o.w = pk2(v[6], v[7]);
        *(u32x4*)(P + (size_t)i8 * 8) = o; }
    if (tid < 64) { AT[tid] = pw[(32 * 64 + tid) * 2]; AT[64 + tid] = pw[(32 * 64 + tid) * 2 + 1]; }
    __syncthreads();
}

constexpr int QP = 72, VP = 272;
constexpr int LQ_OFF = 0, LK_OFF = 128 * QP * 2, LV_OFF = LK_OFF + 256 * QP * 2;
constexpr size_t QPLANE = (size_t)2 * 3 * 8 * 8192 * 64;
struct AttnItem { int gi, h, b, n; size_t qrow0; };
__device__ __forceinline__ AttnItem attn_decode(int item) {
    AttnItem A; int it = item; const int rn = it & 63; it >>= 6; A.h = it & 7; it >>= 3; A.gi = it % 3; A.b = it / 3;
    const int dsh = 2 * A.gi, nbsh = 6 - dsh; const int r = rn >> nbsh; A.n = rn & ((1 << nbsh) - 1);
    A.qrow0 = ((size_t)(A.b * 3 + A.gi) * 8 + A.h) * 8192 + (size_t)r * (8192 >> dsh) + 128 * A.n;
    return A;
}
__device__ __forceinline__ void attn_load(const AttnItem& A, const bf16* QH, int tid, u32x4 (&qv)[2], u32x4 (&kv)[4], u32x4 (&vv)[4]) {
    const bf16* qp = QH + A.qrow0 * 64 + tid * 8;
#pragma unroll
    for (int rd = 0; rd < 2; ++rd) qv[rd] = *(const u32x4*)(qp + rd * 4096);
#pragma unroll
    for (int rd = 0; rd < 4; ++rd) {
        if (A.n > 0 || rd >= 2) { const bf16* p = qp + QPLANE + (rd - 2) * 4096; kv[rd] = *(const u32x4*)p; vv[rd] = *(const u32x4*)(p + QPLANE); }
        else { kv[rd] = (u32x4){0u, 0u, 0u, 0u}; vv[rd] = (u32x4){0u, 0u, 0u, 0u}; } }
}
__device__ __forceinline__ void attn_stage(const float* gq, const float* gk, unsigned char* lds, int tid, const u32x4 (&qv)[2], const u32x4 (&kv)[4], const u32x4 (&vv)[4]) {
    asm volatile("" : "+v"(tid));
    bf16* Qs = (bf16*)(lds + LQ_OFF); bf16* Ks = (bf16*)(lds + LK_OFF); bf16* Vt = (bf16*)(lds + LV_OFF);
    const int chunk = tid & 7, rowi = tid >> 3;
    float gqv[8], gkv[8];
#pragma unroll
    for (int i = 0; i < 8; ++i) { gqv[i] = gq[chunk * 8 + i] * 0.125f; gkv[i] = gk[chunk * 8 + i]; }
#pragma unroll
    for (int rd = 0; rd < 2; ++rd) { float f[8]; f[0] = bflo(qv[rd].x); f[1] = bfhi(qv[rd].x); f[2] = bflo(qv[rd].y); f[3] = bfhi(qv[rd].y); f[4] = bflo(qv[rd].z); f[5] = bfhi(qv[rd].z); f[6] = bflo(qv[rd].w); f[7] = bfhi(qv[rd].w);
        float ss = 0.f;
#pragma unroll
        for (int i = 0; i < 8; ++i) ss += f[i] * f[i];
        ss += __shfl_xor(ss, 1); ss += __shfl_xor(ss, 2); ss += __shfl_xor(ss, 4);
        const float rs = rsqrtf(ss * (1.f / 64.f) + EPS);
        u32x4 w; w.x = pk2(f[0] * rs * gqv[0], f[1] * rs * gqv[1]); w.y = pk2(f[2] * rs * gqv[2], f[3] * rs * gqv[3]); w.z = pk2(f[4] * rs * gqv[4], f[5] * rs * gqv[5]); w.w = pk2(f[6] * rs * gqv[6], f[7] * rs * gqv[7]);
        *(u32x4*)(Qs + (rowi + 64 * rd) * QP + chunk * 8) = w; }
#pragma unroll
    for (int rd = 0; rd < 4; ++rd) { float f[8]; f[0] = bflo(kv[rd].x); f[1] = bfhi(kv[rd].x); f[2] = bflo(kv[rd].y); f[3] = bfhi(kv[rd].y); f[4] = bflo(kv[rd].z); f[5] = bfhi(kv[rd].z); f[6] = bflo(kv[rd].w); f[7] = bfhi(kv[rd].w);
        float ss = 0.f;
#pragma unroll
        for (int i = 0; i < 8; ++i) ss += f[i] * f[i];
        ss += __shfl_xor(ss, 1); ss += __shfl_xor(ss, 2); ss += __shfl_xor(ss, 4);
        const float rs = rsqrtf(ss * (1.f / 64.f) + EPS);
        u32x4 w; w.x = pk2(f[0] * rs * gkv[0], f[1] * rs * gkv[1]); w.y = pk2(f[2] * rs * gkv[2], f[3] * rs * gkv[3]); w.z = pk2(f[4] * rs * gkv[4], f[5] * rs * gkv[5]); w.w = pk2(f[6] * rs * gkv[6], f[7] * rs * gkv[7]);
        const int ki = rowi + 64 * rd;
        *(u32x4*)(Ks + ki * QP + chunk * 8) = w;
        bf16* vp = Vt + (chunk * 8) * VP + (ki ^ (chunk << 2));
        vp[0 * VP] = (bf16)(vv[rd].x & 0xffffu); vp[1 * VP] = (bf16)(vv[rd].x >> 16); vp[2 * VP] = (bf16)(vv[rd].y & 0xffffu); vp[3 * VP] = (bf16)(vv[rd].y >> 16);
        vp[4 * VP] = (bf16)(vv[rd].z & 0xffffu); vp[5 * VP] = (bf16)(vv[rd].z >> 16); vp[6 * VP] = (bf16)(vv[rd].w & 0xffffu); vp[7 * VP] = (bf16)(vv[rd].w >> 16); }
}
__device__ __forceinline__ void attn_compute(const AttnItem& A, bf16* QH, float* LSE, unsigned char* lds, int tid) {
    asm volatile("" : "+v"(tid));
    const bf16* Qs = (const bf16*)(lds + LQ_OFF); const bf16* Ks = (const bf16*)(lds + LK_OFF); const bf16* Vt = (const bf16*)(lds + LV_OFF);
    const int n = A.n;
    const int w = tid >> 6, lane = tid & 63, fr = lane & 15, fq = lane >> 4, kt0 = w & ~1;
    bf16x8 qf[2];
#pragma unroll
    for (int kk = 0; kk < 2; ++kk) qf[kk] = *(const bf16x8*)(Qs + (16 * w + fr) * QP + 32 * kk + 8 * fq);
    f32x4 s[10];
#pragma unroll
    for (int t = 0; t < 10; ++t) { s[t] = (f32x4){0.f, 0.f, 0.f, 0.f};
#pragma unroll
        for (int kk = 0; kk < 2; ++kk) { const bf16x8 kf = *(const bf16x8*)(Ks + (16 * (kt0 + t) + fr) * QP + 32 * kk + 8 * fq); s[t] = __builtin_amdgcn_mfma_f32_16x16x32_bf16(kf, qf[kk], s[t], 0, 0, 0); }
    }
    const int qi = 16 * w + fr; float mx = -INFINITY;
    const int dbase = 16 * (kt0 - w) + 4 * fq - fr, kbase = 16 * kt0 + 4 * fq - ((n > 0) ? 0 : 128);
#pragma unroll
    for (int t = 0; t < 10; ++t)
#pragma unroll
        for (int j = 0; j < 4; ++j) { const int dlt = dbase + 16 * t + j; const int bad = (dlt | (128 - dlt) | (kbase + 16 * t + j)) >> 31;
            s[t][j] += __int_as_float(bad & (int)0xff800000); mx = fmaxf(mx, s[t][j]); }
    mx = fmaxf(mx, __shfl_xor(mx, 16)); mx = fmaxf(mx, __shfl_xor(mx, 32));
    float sum = 0.f;
#pragma unroll
    for (int t = 0; t < 10; ++t)
#pragma unroll
        for (int j = 0; j < 4; ++j) { const float p = __builtin_amdgcn_exp2f((s[t][j] - mx) * 1.44269504089f); s[t][j] = p; sum += p; }
    sum += __shfl_xor(sum, 16); sum += __shfl_xor(sum, 32);
    f32x4 o[4];
#pragma unroll
    for (int dt = 0; dt < 4; ++dt) o[dt] = (f32x4){0.f, 0.f, 0.f, 0.f};
#pragma unroll
    for (int jj = 0; jj < 5; ++jj) {
        u32x4 pw; pw.x = pk2(s[2 * jj][0], s[2 * jj][1]); pw.y = pk2(s[2 * jj][2], s[2 * jj][3]); pw.z = pk2(s[2 * jj + 1][0], s[2 * jj + 1][1]); pw.w = pk2(s[2 * jj + 1][2], s[2 * jj + 1][3]);
        const bf16x8 pf = __builtin_bit_cast(bf16x8, pw);
#pragma unroll
        for (int dt = 0; dt < 4; ++dt) { const int dd = 16 * dt + fr, sw = ((dd >> 3) & 7) << 2, kb = 32 * (kt0 / 2 + jj) + 4 * fq;
            const bf16* vr = Vt + dd * VP;
            const u32x2 lo = *(const u32x2*)(vr + (kb ^ sw)), hi = *(const u32x2*)(vr + ((kb + 16) ^ sw)); u32x4 vw; vw.x = lo.x; vw.y = lo.y; vw.z = hi.x; vw.w = hi.y;
            o[dt] = __builtin_amdgcn_mfma_f32_16x16x32_bf16(__builtin_bit_cast(bf16x8, vw), pf, o[dt], 0, 0, 0); } }
    const float inv = 1.0f / sum;
    const size_t prow = A.qrow0 + qi;
    bf16* op = QH + prow * 64 + 4 * fq;
#pragma unroll
    for (int dt = 0; dt < 4; ++dt) { u32x2 w2; w2.x = pk2(o[dt][0] * inv, o[dt][1] * inv); w2.y = pk2(o[dt][2] * inv, o[dt][3] * inv); *(u32x2*)(op + 16 * dt) = w2; }
    if (fq == 0) LSE[prow] = mx + logf(sum);
}

constexpr int ULP = 520;
__device__ __forceinline__ void ssm_stage_u(const bf16* UH, int g, int mt, unsigned char* lds, int tid) {
    const bf16* src = UH + ((size_t)g * 16384 + (size_t)mt * 2048) * 16;
    u32x4 v[8];
#pragma unroll
    for (int k = 0; k < 8; ++k) v[k] = *(const u32x4*)(src + (size_t)(tid + NTHR * k) * 8);
#pragma unroll
    for (int k = 0; k < 8; ++k) { const int i = tid + NTHR * k; *(u32x4*)(lds + (i >> 6) * (ULP * 2) + (i & 63) * 16) = v[k]; }
}
__device__ __forceinline__ void ssm_s1_item(int item, const bf16* UH, unsigned char* ws, const unsigned char* tab, unsigned char* lds, int tid) {
    const int g = item >> 3, mt = item & 7, w = tid >> 6, lane = tid & 63, fr = lane & 15, fq = lane >> 4;
    const bf16* E = (const bf16*)(tab + TB_E) + (size_t)g * 128 * 512; float* S = (float*)(ws + WS_S);
    const bf16* ep = E + (size_t)(16 * w + fr) * 512 + 8 * fq;
    bf16x8 ef[16];
#pragma unroll
    for (int ks = 0; ks < 16; ++ks) ef[ks] = *(const bf16x8*)(ep + 32 * ks);
    ssm_stage_u(UH, g, mt, lds, tid);
    __syncthreads();
    const bf16* UL = (const bf16*)lds;
    f32x4 acc[4];
#pragma unroll
    for (int mi = 0; mi < 4; ++mi) acc[mi] = (f32x4){0.f, 0.f, 0.f, 0.f};
#pragma unroll
    for (int ks = 0; ks < 16; ++ks)
#pragma unroll
        for (int mi = 0; mi < 4; ++mi) { const bf16x8 uf = *(const bf16x8*)(UL + (16 * mi + fr) * ULP + (2 * ks + (fq >> 1)) * 16 + 8 * (fq & 1)); acc[mi] = __builtin_amdgcn_mfma_f32_16x16x32_bf16(ef[ks], uf, acc[mi], 0, 0, 0); }
#pragma unroll
    for (int mi = 0; mi < 4; ++mi) *(f32x4*)(S + ((size_t)(64 * mt + 16 * mi + fr) * 32 + g) * 128 + 16 * w + 4 * fq) = acc[mi];
    __syncthreads();
}

__device__ __forceinline__ void ssm_carry_item(int item, unsigned char* ws, const unsigned char* tab, float* L, int tid) {
    const int b = item >> 5, g = item & 31;
    const float* S = (const float*)(ws + WS_S); bf16* XP = (bf16*)(ws + WS_XP); const float* AT = (const float*)(tab + TB_AT) + g * 128;
#pragma unroll 4
    for (int i = 0; i < 16; ++i) { const int idx = i * NTHR + tid, k = idx >> 5, q4 = idx & 31;
        *(f32x4*)(L + k * 128 + 4 * q4) = *(const f32x4*)(S + ((size_t)(b * CHB + k) * 32 + g) * 128 + 4 * q4); }
    __syncthreads();
    if (tid < 64) {
        const int p = tid; const float ar = AT[p], ai = AT[64 + p]; float xr = 0.f, xi = 0.f;
        bf16* xo = XP + ((size_t)(b * CHB) * 32 + g) * 128 + p;
#pragma unroll 8
        for (int k = 0; k < CHB; ++k) {
            xo[(size_t)k * 32 * 128] = (bf16)f2bf(xr); xo[(size_t)k * 32 * 128 + 64] = (bf16)f2bf(xi);
            const float sr = L[k * 128 + p], si = L[k * 128 + 64 + p];
            const float nr = ar * xr - ai * xi + sr, ni = ar * xi + ai * xr + si; xr = nr; xi = ni;
        }
    }
    __syncthreads();
}

__device__ __forceinline__ void phase_merge(const bf16* QH, bf16* Aout, const float* LSE, int vt, int nvt) {
    for (int i = vt; i < MTOK * 64; i += nvt) { const int row = i >> 6, h = (i >> 3) & 7, ch = i & 7, b = row >> 13, t = row & 8191;
        const size_t r0 = ((size_t)(b * 3 + 0) * 8 + h) * 8192 + t;
        const size_t r1 = ((size_t)(b * 3 + 1) * 8 + h) * 8192 + ((t & 3) << 11) + (t >> 2);
        const size_t r2 = ((size_t)(b * 3 + 2) * 8 + h) * 8192 + ((t & 15) << 9) + (t >> 4);
        const float l0 = LSE[r0], l1 = LSE[r1], l2 = LSE[r2];
        const float mx = fmaxf(l0, fmaxf(l1, l2)); float w0 = expf(l0 - mx), w1 = expf(l1 - mx), w2 = expf(l2 - mx); const float inv = 1.0f / (w0 + w1 + w2); w0 *= inv; w1 *= inv; w2 *= inv;
        const u32x4 a0 = *(const u32x4*)(QH + r0 * 64 + ch * 8), a1 = *(const u32x4*)(QH + r1 * 64 + ch * 8), a2 = *(const u32x4*)(QH + r2 * 64 + ch * 8);
        u32x4 o;
        o.x = pk2(w0 * bflo(a0.x) + w1 * bflo(a1.x) + w2 * bflo(a2.x), w0 * bfhi(a0.x) + w1 * bfhi(a1.x) + w2 * bfhi(a2.x));
        o.y = pk2(w0 * bflo(a0.y) + w1 * bflo(a1.y) + w2 * bflo(a2.y), w0 * bfhi(a0.y) + w1 * bfhi(a1.y) + w2 * bfhi(a2.y));
        o.z = pk2(w0 * bflo(a0.z) + w1 * bflo(a1.z) + w2 * bflo(a2.z), w0 * bfhi(a0.z) + w1 * bfhi(a1.z) + w2 * bfhi(a2.z));
        o.w = pk2(w0 * bflo(a0.w) + w1 * bflo(a1.w) + w2 * bflo(a2.w), w0 * bfhi(a0.w) + w1 * bfhi(a1.w) + w2 * bfhi(a2.w));
        *(u32x4*)(Aout + (size_t)row * AW + h * 64 + ch * 8) = o; }
}

__device__ __forceinline__ float gelu_tanh(float y) { const float z = 1.5957691216f * (y + 0.044715f * y * y * y); return y * __builtin_amdgcn_rcpf(1.0f + __builtin_amdgcn_exp2f(-1.44269504089f * z)); }
constexpr int XLP = 136;
constexpr int S3_XL = 64 * ULP * 2, S3_KL = S3_XL + 64 * XLP * 2;
__device__ __forceinline__ void ssm_s3_item(int item, const float* dskip, const bf16* UH, bf16* Y, unsigned char* ws, const unsigned char* tab, unsigned char* lds, int tid) {
    const int g = item >> 3, mt = item & 7, w = tid >> 6, lane = tid & 63, fr = lane & 15, fq = lane >> 4;
    const bf16* KT = (const bf16*)(tab + TB_KT) + (size_t)g * 32 * 256; const bf16* P = (const bf16*)(tab + TB_P) + (size_t)g * 512 * 128; const bf16* XP = (const bf16*)(ws + WS_XP);
    { u32x4 xv[2], kv2[2];
#pragma unroll
      for (int k = 0; k < 2; ++k) { const int i = tid + NTHR * k; xv[k] = *(const u32x4*)(XP + ((size_t)(64 * mt + (i >> 4)) * 32 + g) * 128 + (i & 15) * 8); kv2[k] = *(const u32x4*)(KT + (size_t)i * 8); }
      ssm_stage_u(UH, g, mt, lds, tid);
#pragma unroll
      for (int k = 0; k < 2; ++k) { const int i = tid + NTHR * k; *(u32x4*)(lds + S3_XL + (i >> 4) * (XLP * 2) + (i & 15) * 16) = xv[k]; *(u32x4*)(lds + S3_KL + i * 16) = kv2[k]; } }
    const float* dsk = dskip + g * 16 + 4 * fq;
    const float d0 = dsk[0], d1 = dsk[1], d2 = dsk[2], d3 = dsk[3];
    __syncthreads();
    const bf16* UL = (const bf16*)lds; const bf16* XL = (const bf16*)(lds + S3_XL); const bf16* KL = (const bf16*)(lds + S3_KL);
    const int shalf = fq >> 1, c20 = 8 * (fq & 1);
#pragma unroll 1
    for (int ti = 0; ti < 4; ++ti) {
        const int t = (ti == 0) ? w : (ti == 1) ? 15 - w : (ti == 2) ? 16 + w : 31 - w;
        bf16x8 pf[4];
#pragma unroll
        for (int k2 = 0; k2 < 4; ++k2) pf[k2] = *(const bf16x8*)(P + (size_t)(t * 16 + fr) * 128 + 32 * k2 + 8 * fq);
        f32x4 acc[4];
#pragma unroll
        for (int mi = 0; mi < 4; ++mi) acc[mi] = (f32x4){0.f, 0.f, 0.f, 0.f};
        const int nks = (t >> 1) + 1;
#pragma unroll 2
        for (int ks = 0; ks < nks; ++ks) {
            const int s = 2 * ks + shalf, lag = t - s;
            bf16x8 wf = (bf16x8){0, 0, 0, 0, 0, 0, 0, 0};
            if (lag >= 0) wf = *(const bf16x8*)(KL + lag * 256 + fr * 16 + c20);
#pragma unroll
            for (int mi = 0; mi < 4; ++mi) { const bf16x8 uf = *(const bf16x8*)(UL + (16 * mi + fr) * ULP + s * 16 + c20);
                acc[mi] = __builtin_amdgcn_mfma_f32_16x16x32_bf16(wf, uf, acc[mi], 0, 0, 0); }
        }
#pragma unroll
        for (int k2 = 0; k2 < 4; ++k2)
#pragma unroll
            for (int mi = 0; mi < 4; ++mi) { const bf16x8 xf = *(const bf16x8*)(XL + (16 * mi + fr) * XLP + 32 * k2 + 8 * fq);
                acc[mi] = __builtin_amdgcn_mfma_f32_16x16x32_bf16(pf[k2], xf, acc[mi], 0, 0, 0); }
#pragma unroll
        for (int mi = 0; mi < 4; ++mi) { const size_t tok = (size_t)(64 * mt + 16 * mi + fr) * TC + t;
            const u32x2 uu = *(const u32x2*)(UL + (16 * mi + fr) * ULP + t * 16 + 4 * fq);
            const float y0 = acc[mi][0] + d0 * bflo(uu.x), y1 = acc[mi][1] + d1 * bfhi(uu.x), y2 = acc[mi][2] + d2 * bflo(uu.y), y3 = acc[mi][3] + d3 * bfhi(uu.y);
            u32x2 o; o.x = pk2(gelu_tanh(y0), gelu_tanh(y1)); o.y = pk2(gelu_tanh(y2), gelu_tanh(y3));
            *(u32x2*)(Y + tok * AW + 16 * g + 4 * fq) = o; }
    }
    __syncthreads();
}

#define XB_TMO      128
#define XB_XCNT(j)  (256  + 64 * (j))
#define XB_XSUB(j)  (1280 + 64 * (j))
#define XB_XGEN(j)  (2304 + 64 * (j))
#define XB_TOP      3328
#define XB_TOPGEN   3392
#define XCD_BAR_WORDS 3456
#define XB_SPIN_CAP (1u << 20)
__device__ __forceinline__ unsigned xb_ld(unsigned* p)              { return __hip_atomic_load(p, __ATOMIC_RELAXED, __HIP_MEMORY_SCOPE_AGENT); }
__device__ __forceinline__ unsigned xb_add(unsigned* p, unsigned v) { return __hip_atomic_fetch_add(p, v, __ATOMIC_RELAXED, __HIP_MEMORY_SCOPE_AGENT); }
__device__ __forceinline__ unsigned xb_xcc_id() { return (unsigned)__builtin_amdgcn_s_getreg((3 << 11) | 20) & 0xFu; }
#define XB_SPIN(cond, bar) do { unsigned _sp = 0; while (cond) { __builtin_amdgcn_s_sleep(1); \
    if ((++_sp & 255u) == 0u) { if (xb_ld(&(bar)[XB_TMO])) break; if (_sp > XB_SPIN_CAP) { atomicAdd(&(bar)[XB_TMO], 1u); break; } } } } while (0)
struct XcdBarrier { unsigned* bar; unsigned x; volatile LAS unsigned* st; };
__device__ __forceinline__ XcdBarrier xcd_barrier_post(unsigned* bar, volatile LAS unsigned* st) {
    XcdBarrier b; b.bar = bar; b.x = xb_xcc_id(); b.st = st;
    if (threadIdx.x == 0) (void)xb_add(&bar[XB_XCNT(b.x)], 1u);
    return b;
}
__device__ __forceinline__ void xcd_barrier_complete(unsigned* bar, unsigned x, unsigned& nloc, unsigned& nx) {
    const unsigned G = gridDim.x * gridDim.y * gridDim.z;
    unsigned sum, cnt, mine, sp = 0u;
    for (;;) {
        sum = 0u; cnt = 0u; mine = 0u;
#pragma unroll
        for (unsigned j = 0; j < 16; ++j) { const unsigned c = xb_ld(&bar[XB_XCNT(j)]); sum += c; cnt += (c > 0u) ? 1u : 0u; mine = (j == x) ? c : mine; }
        if (sum == G) break;
        __builtin_amdgcn_s_sleep(1);
        if ((++sp & 255u) == 0u) { if (xb_ld(&bar[XB_TMO])) break; if (sp > XB_SPIN_CAP) { atomicAdd(&bar[XB_TMO], 1u); break; } }
    }
    nloc = mine > 0u ? mine : 1u; nx = cnt > 0u ? cnt : 1u;
}
__device__ __forceinline__ void xcd_barrier(const XcdBarrier& b) {
    asm volatile("s_waitcnt vmcnt(0)" ::: "memory");
    __syncthreads();
    if (threadIdx.x == 0) {
        unsigned* bar = b.bar;
        __builtin_amdgcn_s_waitcnt(0);
        unsigned nloc = b.st[0], nx = b.st[1];
        if (nloc == 0u) { xcd_barrier_complete(bar, b.x, nloc, nx); b.st[0] = nloc; b.st[1] = nx; }
        const unsigned old = xb_add(&bar[XB_XSUB(b.x)], 1u);
        const unsigned gen = old / nloc;
        if (old + 1u == (gen + 1u) * nloc) {
            __builtin_amdgcn_fence(__ATOMIC_RELEASE, "agent");
            asm volatile("s_waitcnt vmcnt(0)" ::: "memory");
            const unsigned og = xb_add(&bar[XB_TOP], 1u);
            const unsigned tg = og / nx;
            if (og + 1u == (tg + 1u) * nx) xb_add(&bar[XB_TOPGEN], 1u);
            else XB_SPIN(xb_ld(&bar[XB_TOPGEN]) == tg, bar);
            __builtin_amdgcn_fence(__ATOMIC_ACQUIRE, "agent");
            xb_add(&bar[XB_XGEN(b.x)], 1u);
            asm volatile("s_waitcnt vmcnt(0)" ::: "memory");
        } else {
            XB_SPIN(xb_ld(&bar[XB_XGEN(b.x)]) == gen, bar);
            __builtin_amdgcn_fence(__ATOMIC_ACQUIRE, "agent");
            asm volatile("s_waitcnt vmcnt(0)" ::: "memory");
        }
    }
    __syncthreads();
}

constexpr int KPL = 8, N_PHASES = 1 + KPL * DEPTH;
__global__ void __launch_bounds__(NTHR, 2) mega_fwd(Args a) {
    extern __shared__ __attribute__((aligned(16))) unsigned char lds[];
    cg::grid_group grid = cg::this_grid();
    LAS unsigned char* ldsl = (LAS unsigned char*)lds;
    volatile LAS unsigned* bst = (volatile LAS unsigned*)(ldsl + LDS_BYTES - 16);
    if (threadIdx.x < 2) bst[threadIdx.x] = 0u;
    __syncthreads();
    XcdBarrier xbar; xbar.bar = (unsigned*)a.ws; xbar.x = 0; xbar.st = bst;
    if (a.ph_hi - a.ph_lo > 1) xbar = xcd_barrier_post((unsigned*)a.ws, bst);
    int prep = 0;
    for (int ph = a.ph_lo; ph < a.ph_hi; ++ph) {
        int zero; asm volatile("s_mov_b32 %0, 0" : "=s"(zero));
        int tid = threadIdx.x; asm volatile("" : "+v"(tid));
        const int lane = tid & 63, wave = __builtin_amdgcn_readfirstlane(tid >> 6);
        const int G = (int)gridDim.x + zero, bx = (int)blockIdx.x + zero;
        const int gw = bx * NWAVES + wave, ngw = G * NWAVES;
        unsigned char* ws = a.ws + zero; float* outp = a.out + zero;
        bf16* WB = (bf16*)(ws + WS_WB); bf16* QH = (bf16*)(ws + WS_Z); bf16* UG = (bf16*)(ws + WS_Z + 144 * MiB); bf16* UH = (bf16*)(ws + WS_Z + 208 * MiB); bf16* AK = QH + QPLANE; bf16* ACT = (bf16*)(ws + WS_ACT); bf16* Y = (bf16*)(ws + WS_Y); float* LSE = (float*)(ws + WS_LSE);
        bf16* MIX = QH;
        float* SS1 = (float*)(ws + WS_S); float* SS2 = (float*)(ws + WS_S + MiB);
        if (ph == 0) {
            for (int rep = 0; rep < NREP(15); ++rep) phase_weights(a, zero, WB, (float*)lds, gw, ngw, wave, lane);
            __syncthreads();
            for (int rep = 0; rep < NREP(12); ++rep) {
            for (int g = bx; g < 32; g += G) ssm_pre_item(a, zero, 0, g, ws + WS_TAB, (float*)lds, tid);
            phase_xprep(a.in[zero], ACT, SS2, gw, ngw, lane); }
        } else {
            const int l = (ph - 1) / KPL, k = (ph - 1) % KPL;
            const bf16* wl = WB + (size_t)l * LAYER_W;
            const float* xin = (l == 0) ? a.in[zero] : outp;
            unsigned char* tab = ws + WS_TAB + (size_t)(l & 1) * TAB_STRIDE;
            if (k == 0) {
                pg8::Gemm gm{ACT, wl + OFF_IN, MTOK, INC, DM, DM}; pg8::StaticOrder S; S.init(MTOK, INC, G, bx);
                PG8_LAS float* rst = (PG8_LAS float*)(ldsl + 131088); int pbase = 0;
                { pg8::Unit u0; if (S.next(0, u0)) { pbase = (u0.pm & ~7) * 256; for (int i = tid; i < 2048; i += NTHR) rst[i] = pg8::row_rstd(SS2, (size_t)(pbase + i)); } }
                __syncthreads();
                pg8::EpiZ E{QH, UG, UH, SS2, rst, pbase};
                pg8::gemm_phase<pg8::EpiZ, pg8::StaticOrder, true, true>(ldsl, tid, gm, S, E);
            } else if (k == 1) {
                const float* gq = a.in[3 + zero] + l * 64; const float* gk = a.in[4 + zero] + l * 64;
                u32x4 qv[2], kv[4], vv[4], qv2[2], kv2[4], vv2[4];
#pragma unroll
                for (int i = 0; i < 4; ++i) { qv[i & 1] = (u32x4){0u, 0u, 0u, 0u}; kv[i] = (u32x4){0u, 0u, 0u, 0u}; vv[i] = (u32x4){0u, 0u, 0u, 0u}; qv2[i & 1] = (u32x4){0u, 0u, 0u, 0u}; kv2[i] = (u32x4){0u, 0u, 0u, 0u}; vv2[i] = (u32x4){0u, 0u, 0u, 0u}; }
                if (bx < 3072) { const AttnItem A0 = attn_decode(bx); attn_load(A0, QH, tid, qv, kv, vv); }
                if (bx + G < 3072) { const AttnItem A1 = attn_decode(bx + G); attn_load(A1, QH, tid, qv2, kv2, vv2); }
                for (int it = bx; it < 3072; it += 2 * G) {
                    { const AttnItem A = attn_decode(it);
                      attn_stage(gq, gk, lds, tid, qv, kv, vv);
                      __builtin_amdgcn_sched_barrier(0);
                      __syncthreads();
                      if (it + 2 * G < 3072) { const AttnItem An = attn_decode(it + 2 * G); attn_load(An, QH, tid, qv, kv, vv); }
                      __builtin_amdgcn_sched_barrier(0);
                      attn_compute(A, QH, LSE, lds, tid);
                      __builtin_amdgcn_sched_barrier(0);
                      __syncthreads(); }
                    if (it + G < 3072) { const AttnItem A = attn_decode(it + G);
                      attn_stage(gq, gk, lds, tid, qv2, kv2, vv2);
                      __builtin_amdgcn_sched_barrier(0);
                      __syncthreads();
                      if (it + 3 * G < 3072) { const AttnItem An = attn_decode(it + 3 * G); attn_load(An, QH, tid, qv2, kv2, vv2); }
                      __builtin_amdgcn_sched_barrier(0);
                      attn_compute(A, QH, LSE, lds, tid);
                      __builtin_amdgcn_sched_barrier(0);
                      __syncthreads(); }
                }
                for (int it = bx; it < 256; it += G) for (int rep = 0; rep < NREP(2); ++rep) ssm_s1_item(it, UH, ws, tab, lds, tid);
            } else if (k == 2) {
                if (G >= 256) {
                    if (bx < 64) { for (int rep = 0; rep < NREP(3); ++rep) ssm_carry_item(bx, ws, tab, (float*)lds, tid); }
                    else if (bx < 96) { if (l + 1 < DEPTH) for (int rep = 0; rep < NREP(11); ++rep) ssm_pre_item(a, zero, l + 1, bx - 64, ws + WS_TAB + (size_t)((l + 1) & 1) * TAB_STRIDE, (float*)lds, tid); }
                    else { for (int rep = 0; rep < NREP(10); ++rep) phase_merge(QH, AK, LSE, (bx - 96) * NTHR + tid, (G - 96) * NTHR); }
                } else {
                    for (int it = bx; it < 64; it += G) ssm_carry_item(it, ws, tab, (float*)lds, tid);
                    if (l + 1 < DEPTH) for (int g = bx; g < 32; g += G) ssm_pre_item(a, zero, l + 1, g, ws + WS_TAB + (size_t)((l + 1) & 1) * TAB_STRIDE, (float*)lds, tid);
                    phase_merge(QH, AK, LSE, bx * NTHR + tid, G * NTHR);
                }
            } else if (k == 3) {
                const float* dskip = a.in[13 + zero] + l * 512;
                for (int rep = 0; rep < NREP(4); ++rep) for (int it = bx; it < 256; it += G) ssm_s3_item(it, dskip, UH, Y, ws, tab, lds, tid);
            } else if (k == 4) {
                { pg8::Gemm gm{AK, wl + OFF_P, MTOK, DM, AW, AW}; pg8::StaticOrder S; S.init(MTOK, DM, G, bx);
                  pg8::EpiGate1 E{MIX, DM, UG, UGP};
                  pg8::gemm_phase<pg8::EpiGate1, pg8::StaticOrder, true, true>(ldsl, tid, gm, S, E); }
                { pg8::Gemm gm{Y, wl + OFF_GLU, MTOK, 2 * DM, AW, AW}; pg8::PairOrder S; S.base.init(MTOK, DM, G, bx);
                  pg8::EpiGlu E{MIX, DM, UG + 1024, UGP};
                  pg8::gemm_phase<pg8::EpiGlu, pg8::PairOrder, true, true>(ldsl, tid, gm, S, E); }
            } else if (k == 5) {
                pg8::Gemm gm{MIX, wl + OFF_OUT, MTOK, DM, DM, DM}; pg8::StaticOrder S; S.init(MTOK, DM, G, bx);
                pg8::EpiResid E{xin, outp, DM, ACT, SS1};
                pg8::gemm_phase<pg8::EpiResid, pg8::StaticOrder, true, true>(ldsl, tid, gm, S, E);
            } else if (k == 6) {
                pg8::Gemm gm{ACT, wl + OFF_GU, MTOK, 2 * DFF, DM, DM}; pg8::StaticOrder S; S.init(MTOK, 2 * DFF, G, bx);
                PG8_LAS float* rst = (PG8_LAS float*)(ldsl + 131088); int pbase = 0;
                { pg8::Unit u0; if (S.next(0, u0)) { pbase = (u0.pm & ~7) * 256; for (int i = tid; i < 2048; i += NTHR) rst[i] = pg8::row_rstd(SS1, (size_t)(pbase + i)); } }
                __syncthreads();
                pg8::EpiSwiglu E{QH, DFF, SS1, rst, pbase};
                pg8::gemm_phase<pg8::EpiSwiglu, pg8::StaticOrder, true, true>(ldsl, tid, gm, S, E);
            } else {
                pg8::Gemm gm{QH, wl + OFF_DN, MTOK, DM, DFF, DFF}; pg8::StaticOrder S; S.init(MTOK, DM, G, bx);
                pg8::EpiResid E{outp, outp, DM, ACT, SS2};
                pg8::gemm_phase<pg8::EpiResid, pg8::StaticOrder, true, true>(ldsl, tid, gm, S, E);
            }
        }
        if (REP_PH != 0 && ph > 0 && ((REP_PH >> ((ph - 1) % KPL)) & 1) && prep == 0) { prep = 1; --ph; xcd_barrier(xbar); continue; }
        prep = 0;
        if (ph + 1 < a.ph_hi) { if (ph == a.ph_lo) grid.sync(); else { for (int sx = 0; sx < SYNC_X; ++sx) xcd_barrier(xbar); } }
    }
}

extern "C" void kernel_launch(void* const* d_in, const int* in_sizes, int n_in, void* d_out, int out_size, void* d_ws, size_t ws_size, hipStream_t stream) {
    static int grid = 0;
    if (grid == 0) {
        if (n_in != 21 || in_sizes[0] != MTOK * DM || out_size != MTOK * DM || ws_size < WS_END) { fprintf(stderr, "kernel_launch: unexpected shapes / workspace (n_in %d, ws %zu)\n", n_in, ws_size); grid = -1; return; }
        int dev = 0, cus = 0, per_cu = 0;
        (void)hipGetDevice(&dev); (void)hipDeviceGetAttribute(&cus, hipDeviceAttributeMultiprocessorCount, dev);
        (void)hipFuncSetAttribute((const void*)mega_fwd, hipFuncAttributeMaxDynamicSharedMemorySize, LDS_BYTES);
        (void)hipOccupancyMaxActiveBlocksPerMultiprocessor(&per_cu, (const void*)mega_fwd, NTHR, LDS_BYTES);
        if (per_cu < 1) per_cu = 1;
        (void)hipGetLastError();
        grid = cus * per_cu;
    }
    if (grid < 0) return;
    (void)hipMemsetAsync(d_ws, 0, 16384, stream);
    Args a{};
    for (int i = 0; i < 21; ++i) a.in[i] = (const float*)d_in[i];
    a.out = (float*)d_out; a.ws = (unsigned char*)d_ws;
#if MK_SINGLE
    a.ph_lo = 0; a.ph_hi = N_PHASES;
    void* args[] = {&a};
    hipError_t e = hipLaunchCooperativeKernel((const void*)mega_fwd, dim3(grid), dim3(NTHR), args, LDS_BYTES, stream);
    if (e != hipSuccess) fprintf(stderr, "cooperative launch failed: %s (grid %d)\n", hipGetErrorString(e), grid);
#else
    for (int ph = 0; ph < N_PHASES; ++ph) { a.ph_lo = ph; a.ph_hi = ph + 1; hipLaunchKernelGGL(mega_fwd, dim3(grid), dim3(NTHR), LDS_BYTES, stream, a); }
#endif
}
```

```cpp
#include <hip/hip_runtime.h>
#include <hip/hip_cooperative_groups.h>
#include <cstdio>
#include <cstdint>
namespace cg = cooperative_groups;

#ifndef REP_MASK
#define REP_MASK 0
#endif
#ifndef REP_PH
#define REP_PH 0
#endif
#ifndef REP_ATT
#define REP_ATT 0
#endif
#ifndef SYNC_X
#define SYNC_X 1
#endif
#define NREP(k) (((REP_MASK >> (k)) & 1) ? 2 : 1)
#ifndef MK_SINGLE
#define MK_SINGLE 1
#endif

namespace pg8 {
#define PG8_LAS __attribute__((address_space(3)))
typedef unsigned short bf16_t;
typedef short bf16x8 __attribute__((ext_vector_type(8)));
typedef float f32x4 __attribute__((ext_vector_type(4)));
typedef unsigned u32x4 __attribute__((ext_vector_type(4)));
constexpr int BM = 256, BK = 64, HALF = 128, HTB = HALF * BK * 2, STAGE_BYTES = 8 * HTB, NXCD = 8, WGM = 8;

__host__ __device__ __forceinline__ int lds_byte(int r, int c) { const int st = (r >> 4) * 2 + (c >> 5), rr = r & 15, cc = c & 31, ob = rr * 64 + cc * 2; return st * 1024 + (ob ^ (((ob >> 9) & 1) << 5)); }
__host__ __device__ __forceinline__ void stage_rc(int b, int& R, int& C) { const int st = b / 1024, sb = b % 1024, swz = sb ^ (((sb >> 9) & 1) << 5); R = (st >> 1) * 16 + swz / 64; C = (st & 1) * 32 + (swz % 64) / 2; }
__host__ __device__ __forceinline__ int perm32(int rho) { const int n = rho >> 4, i = rho & 15; return 8 * (i >> 2) + 4 * n + (i & 3); }

struct Unit { int pm, pn; };
struct Gemm { const bf16_t* A; const bf16_t* Bt; int M, N, K, lda; };

struct StaticOrder {
    int nM, nN, nwg, G, c;
    __host__ __device__ void init(int M, int N, int G_, int c_) { nM = M / BM; nN = N / BM; nwg = nM * nN; G = G_; c = c_; }
    __host__ __device__ bool next(int i, Unit& u) const {
        const long L = (long)i * G + c; if (L >= nwg) return false;
        int wgid = (int)L; { const int q = nwg / NXCD, r = nwg % NXCD, xcd = wgid % NXCD, off = wgid / NXCD; wgid = (xcd < r ? xcd * (q + 1) : r * (q + 1) + (xcd - r) * q) + off; }
        const int nig = WGM * nN, gid = wgid / nig, fm = gid * WGM, gsz = (nM - fm) < WGM ? (nM - fm) : WGM;
        u.pm = fm + ((wgid % nig) % gsz); u.pn = (wgid % nig) / gsz; return true;
    }
    __device__ __forceinline__ void a_ready(const Unit&) const {}
    __device__ __forceinline__ void done(const Unit&) const {}
};
struct PairOrder {
    StaticOrder base;
    __host__ __device__ bool next(int i, Unit& u) const { Unit b; if (!base.next(i >> 1, b)) return false; u.pm = b.pm; u.pn = 2 * b.pn + (i & 1); return true; }
    __device__ __forceinline__ void a_ready(const Unit&) const {}
    __device__ __forceinline__ void done(const Unit&) const {}
};

typedef float f32x2c_ __attribute__((ext_vector_type(2))); typedef __bf16 bf16x2c_ __attribute__((ext_vector_type(2)));
__device__ __forceinline__ unsigned cvt_pk_bf16(float lo, float hi) { const f32x2c_ v = {lo, hi}; const bf16x2c_ b = __builtin_convertvector(v, bf16x2c_); return __builtin_bit_cast(unsigned, b); }
__device__ __forceinline__ float bf_lo(unsigned w) { return __uint_as_float(w << 16); }
__device__ __forceinline__ float bf_hi(unsigned w) { return __uint_as_float(w & 0xffff0000u); }
__device__ __forceinline__ float sigmoidf_(float x) { return __builtin_amdgcn_rcpf(1.0f + __builtin_amdgcn_exp2f(-1.44269504089f * x)); }

__device__ __forceinline__ float row_rstd(const float* SSP, size_t row) {
    const f32x4* p = (const f32x4*)(SSP + row * 16); const f32x4 a = p[0], b = p[1], c = p[2], d = p[3];
    const float ss = ((a[0] + a[1]) + (a[2] + a[3])) + ((b[0] + b[1]) + (b[2] + b[3])) + ((c[0] + c[1]) + (c[2] + c[3])) + ((d[0] + d[1]) + (d[2] + d[3]));
    return rsqrtf(ss * (1.0f / 1024.0f) + 1e-6f);
}
struct EpiZ {
    static constexpr bool PERM = true, AFTER_DRAIN = false;
    bf16_t* QH; bf16_t* UG; bf16_t* UH; const float* SS; const PG8_LAS float* rst; int pbase;
    __device__ __forceinline__ void operator()(const f32x4 (&acc)[2][2][4][2], const Unit& u, int wr, int wc, int fr, int fq) const {
        const int row0 = u.pm * BM + wr * 64 + fr;
        float rs[2][4];
#pragma unroll
        for (int ai = 0; ai < 2; ++ai)
#pragma unroll
            for (int m = 0; m < 4; ++m) { const int rr = row0 + ai * HALF + m * 16, rl = rr - pbase; rs[ai][m] = ((unsigned)rl < 2048u) ? rst[rl] : row_rstd(SS, (size_t)rr); }
        if (u.pn < 18) {
            const int which = u.pn / 6, colt = (u.pn % 6) * 256;
#pragma unroll
            for (int bj = 0; bj < 2; ++bj) { const int col = colt + bj * HALF + wc * 32 + 8 * fq, gi = col >> 9, h = (col >> 6) & 7, e = col & 63, dsh = 2 * gi;
#pragma unroll
                for (int ai = 0; ai < 2; ++ai)
#pragma unroll
                    for (int m = 0; m < 4; ++m) { const int row = row0 + ai * HALF + m * 16, b = row >> 13, t = row & 8191, idx = ((t & ((1 << dsh) - 1)) << (13 - dsh)) + (t >> dsh);
                        const f32x4 v0 = acc[ai][bj][m][0] * rs[ai][m], v1 = acc[ai][bj][m][1] * rs[ai][m];
                        u32x4 w; w.x = cvt_pk_bf16(v0[0], v0[1]); w.y = cvt_pk_bf16(v0[2], v0[3]); w.z = cvt_pk_bf16(v1[0], v1[1]); w.w = cvt_pk_bf16(v1[2], v1[3]);
                        *(u32x4*)(QH + ((((size_t)(which * 2 + b) * 3 + gi) * 8 + h) * 8192 + idx) * 64 + e) = w; } }
        } else if (u.pn < 20) {
#pragma unroll
            for (int bj = 0; bj < 2; ++bj) { const int col = (u.pn - 18) * BM + bj * HALF + wc * 32 + 8 * fq, g = col >> 4, c0 = col & 15;
#pragma unroll
                for (int ai = 0; ai < 2; ++ai)
#pragma unroll
                    for (int m = 0; m < 4; ++m) { const int row = row0 + ai * HALF + m * 16;
                        const f32x4 v0 = acc[ai][bj][m][0] * rs[ai][m], v1 = acc[ai][bj][m][1] * rs[ai][m];
                        u32x4 w; w.x = cvt_pk_bf16(v0[0], v0[1]); w.y = cvt_pk_bf16(v0[2], v0[3]); w.z = cvt_pk_bf16(v1[0], v1[1]); w.w = cvt_pk_bf16(v1[2], v1[3]);
                        *(u32x4*)(UH + ((size_t)g * 16384 + row) * 16 + c0) = w; } }
        } else {
            const int col0 = (u.pn - 20) * BM + wc * 32 + 8 * fq;
#pragma unroll
            for (int ai = 0; ai < 2; ++ai)
#pragma unroll
                for (int m = 0; m < 4; ++m) { bf16_t* rowp = UG + (size_t)(row0 + ai * HALF + m * 16) * 2048 + col0;
#pragma unroll
                    for (int bj = 0; bj < 2; ++bj) { f32x4 v0 = acc[ai][bj][m][0] * rs[ai][m], v1 = acc[ai][bj][m][1] * rs[ai][m];
#pragma unroll
                        for (int j = 0; j < 4; ++j) { v0[j] = sigmoidf_(v0[j]); v1[j] = sigmoidf_(v1[j]); }
                        u32x4 w; w.x = cvt_pk_bf16(v0[0], v0[1]); w.y = cvt_pk_bf16(v0[2], v0[3]); w.z = cvt_pk_bf16(v1[0], v1[1]); w.w = cvt_pk_bf16(v1[2], v1[3]);
                        *(u32x4*)(rowp + bj * HALF) = w; } }
        }
    }
};
struct EpiGate1 {
    static constexpr bool PERM = true, AFTER_DRAIN = false;
    bf16_t* O; int ldc; const bf16_t* G; int ldg;
    __device__ __forceinline__ void operator()(const f32x4 (&acc)[2][2][4][2], const Unit& u, int wr, int wc, int fr, int fq) const {
        const int row0 = u.pm * BM + wr * 64 + fr, col0 = u.pn * BM + wc * 32 + 8 * fq;
#pragma unroll
        for (int ai = 0; ai < 2; ++ai)
#pragma unroll
            for (int m = 0; m < 4; ++m) { const size_t r = (size_t)(row0 + ai * HALF + m * 16);
#pragma unroll
                for (int bj = 0; bj < 2; ++bj) { const f32x4 v0 = acc[ai][bj][m][0], v1 = acc[ai][bj][m][1];
                    const u32x4 g = *(const u32x4*)(G + r * ldg + col0 + bj * HALF);
                    u32x4 w; w.x = cvt_pk_bf16(v0[0] * bf_lo(g.x), v0[1] * bf_hi(g.x)); w.y = cvt_pk_bf16(v0[2] * bf_lo(g.y), v0[3] * bf_hi(g.y));
                    w.z = cvt_pk_bf16(v1[0] * bf_lo(g.z), v1[1] * bf_hi(g.z)); w.w = cvt_pk_bf16(v1[2] * bf_lo(g.w), v1[3] * bf_hi(g.w));
                    *(u32x4*)(O + r * ldc + col0 + bj * HALF) = w; }
                asm volatile("" ::: "memory"); }
    }
};
struct EpiGlu {
    static constexpr bool PERM = true, AFTER_DRAIN = false;
    bf16_t* O; int ldc; const bf16_t* G; int ldg;
    __device__ __forceinline__ void operator()(const f32x4 (&acc)[2][2][4][2], const Unit& u, int wr, int wc, int fr, int fq) const {
        const int row0 = u.pm * BM + wr * 64 + fr, col0 = u.pn * HALF + wc * 32 + 8 * fq;
#pragma unroll
        for (int ai = 0; ai < 2; ++ai)
#pragma unroll
            for (int m = 0; m < 4; ++m) { const size_t r = (size_t)(row0 + ai * HALF + m * 16);
                const u32x4 g = *(const u32x4*)(G + r * ldg + col0); const u32x4 t = *(const u32x4*)(O + r * ldc + col0);
                const f32x4 a0 = acc[ai][0][m][0], a1 = acc[ai][0][m][1], b0 = acc[ai][1][m][0], b1 = acc[ai][1][m][1];
                u32x4 w;
                w.x = cvt_pk_bf16(bf_lo(t.x) + bf_lo(g.x) * a0[0] * sigmoidf_(b0[0]), bf_hi(t.x) + bf_hi(g.x) * a0[1] * sigmoidf_(b0[1]));
                w.y = cvt_pk_bf16(bf_lo(t.y) + bf_lo(g.y) * a0[2] * sigmoidf_(b0[2]), bf_hi(t.y) + bf_hi(g.y) * a0[3] * sigmoidf_(b0[3]));
                w.z = cvt_pk_bf16(bf_lo(t.z) + bf_lo(g.z) * a1[0] * sigmoidf_(b1[0]), bf_hi(t.z) + bf_hi(g.z) * a1[1] * sigmoidf_(b1[1]));
                w.w = cvt_pk_bf16(bf_lo(t.w) + bf_lo(g.w) * a1[2] * sigmoidf_(b1[2]), bf_hi(t.w) + bf_hi(g.w) * a1[3] * sigmoidf_(b1[3]));
                *(u32x4*)(O + r * ldc + col0) = w; asm volatile("" ::: "memory"); }
    }
};
struct EpiSwiglu {
    static constexpr bool PERM = true, AFTER_DRAIN = false;
    bf16_t* O; int ldc; const float* SS; const PG8_LAS float* rst; int pbase;
    __device__ __forceinline__ void operator()(const f32x4 (&acc)[2][2][4][2], const Unit& u, int wr, int wc, int fr, int fq) const {
        const int row0 = u.pm * BM + wr * 64 + fr, col0 = u.pn * HALF + wc * 32 + 8 * fq;
#pragma unroll
        for (int ai = 0; ai < 2; ++ai)
#pragma unroll
            for (int m = 0; m < 4; ++m) { const size_t r = (size_t)(row0 + ai * HALF + m * 16);
                const int rl = (int)r - pbase; const float rs = ((unsigned)rl < 2048u) ? rst[rl] : row_rstd(SS, r);
                const f32x4 a0 = acc[ai][0][m][0] * rs, a1 = acc[ai][0][m][1] * rs, b0 = acc[ai][1][m][0] * rs, b1 = acc[ai][1][m][1] * rs;
                u32x4 w;
                w.x = cvt_pk_bf16(a0[0] * sigmoidf_(a0[0]) * b0[0], a0[1] * sigmoidf_(a0[1]) * b0[1]);
                w.y = cvt_pk_bf16(a0[2] * sigmoidf_(a0[2]) * b0[2], a0[3] * sigmoidf_(a0[3]) * b0[3]);
                w.z = cvt_pk_bf16(a1[0] * sigmoidf_(a1[0]) * b1[0], a1[1] * sigmoidf_(a1[1]) * b1[1]);
                w.w = cvt_pk_bf16(a1[2] * sigmoidf_(a1[2]) * b1[2], a1[3] * sigmoidf_(a1[3]) * b1[3]);
                *(u32x4*)(O + r * ldc + col0) = w; }
    }
};
struct EpiResid {
    static constexpr bool PERM = false, AFTER_DRAIN = false;
    const float* R; float* C; int ldc; bf16_t* XB; float* SS;
    __device__ __forceinline__ void operator()(const f32x4 (&acc)[2][2][4][2], const Unit& u, int wr, int wc, int fr, int fq) const {
        const int row0 = u.pm * BM + wr * 64 + fr, col0 = u.pn * BM + wc * 32 + 4 * fq;
#pragma unroll
        for (int ai = 0; ai < 2; ++ai)
#pragma unroll
            for (int m = 0; m < 4; ++m) { const int row = row0 + ai * HALF + m * 16; const size_t off = (size_t)row * ldc + col0; float ss = 0.f;
#pragma unroll
                for (int bj = 0; bj < 2; ++bj)
#pragma unroll
                    for (int n = 0; n < 2; ++n) { const f32x4 rv = *(const f32x4*)(R + off + bj * HALF + n * 16); const f32x4 o = acc[ai][bj][m][n] + rv; *(f32x4*)(C + off + bj * HALF + n * 16) = o;
                        ss += (o[0] * o[0] + o[1] * o[1]) + (o[2] * o[2] + o[3] * o[3]);
                        unsigned w0 = cvt_pk_bf16(o[0], o[1]), w1 = cvt_pk_bf16(o[2], o[3]); typedef unsigned u32x2_ __attribute__((ext_vector_type(2))); *(u32x2_*)(XB + off + bj * HALF + n * 16) = (u32x2_){w0, w1}; }
                ss += __shfl_xor(ss, 16); ss += __shfl_xor(ss, 32);
                if (fq == 0) SS[(size_t)row * 16 + u.pn * 4 + wc] = ss;
                asm volatile("" ::: "memory"); }
    }
};

template <class Epi, class Sched, bool ALIGN_EPI = false, bool SP2 = false>
__device__ __forceinline__ void gemm_phase(PG8_LAS unsigned char* lds, const int tid, const Gemm g, const Sched& S, const Epi& E) {
    const int wid = __builtin_amdgcn_readfirstlane(tid >> 6), lane = tid & 63, wr = wid >> 2, wc = wid & 3, fr = lane & 15, fq = lane >> 4;
    const int K = g.K, nt = K / BK, lda = g.lda;
    unsigned voffA[2], voffB[2];
#pragma unroll
    for (int i = 0; i < 2; ++i) { int R, C; stage_rc(tid * 16 + i * 8192, R, C); const int Rb = Epi::PERM ? ((R & ~31) + perm32(R & 31)) : R;
        voffA[i] = (unsigned)(R * lda + C) * 2u; voffB[i] = (unsigned)(Rb * K + C) * 2u; }
    const size_t kstep = (size_t)(BK * 2);
    const size_t hA = (size_t)HALF * lda * 2, hB = (size_t)HALF * K * 2;
    const size_t tA = 2 * hA, tB = 2 * hB;
    const unsigned ldsw = (unsigned)wid * 1024u;
    const int aoff = lds_byte(wr * 64 + fr, fq * 8), boff = lds_byte(wc * 32 + fr, fq * 8);
#define PG8_SA(b, h) (((b) * 2 + (h)) * HTB)
#define PG8_SB(b, h) ((4 + (b) * 2 + (h)) * HTB)
#define PG8_STAGE(bufoff, gbase, voff) do { _Pragma("unroll") for (int _i = 0; _i < 2; ++_i) \
        __builtin_amdgcn_global_load_lds((const unsigned*)((const char*)(gbase) + (voff)[_i]), (PG8_LAS unsigned*)(lds + (bufoff) + ldsw + _i * 8192), 16, 0, 0); } while (0)
#define PG8_LDA(dst, b, h) do { _Pragma("unroll") for (int m = 0; m < 4; ++m) _Pragma("unroll") for (int k = 0; k < 2; ++k) dst[m][k] = *(const PG8_LAS bf16x8*)(lds + PG8_SA(b, h) + aoff + m * 2048 + k * 1024); } while (0)
#define PG8_LDB(dst, b, h) do { _Pragma("unroll") for (int n = 0; n < 2; ++n) _Pragma("unroll") for (int k = 0; k < 2; ++k) dst[n][k] = *(const PG8_LAS bf16x8*)(lds + PG8_SB(b, h) + boff + n * 2048 + k * 1024); } while (0)
#define PG8_MMA(ai, bj, At, Bt) do { __builtin_amdgcn_s_setprio(1); _Pragma("unroll") for (int m = 0; m < 4; ++m) _Pragma("unroll") for (int n = 0; n < 2; ++n) _Pragma("unroll") for (int k = 0; k < 2; ++k) \
        acc[ai][bj][m][n] = __builtin_amdgcn_mfma_f32_16x16x32_bf16(Bt[n][k], At[m][k], acc[ai][bj][m][n], 0, 0, 0); __builtin_amdgcn_s_setprio(0); } while (0)
#define PG8_WAIT_V(n) asm volatile("s_waitcnt vmcnt(" #n ")" ::: "memory")
#define PG8_WAIT_L(n) asm volatile("s_waitcnt lgkmcnt(" #n ")" ::: "memory")
#define PG8_BAR __builtin_amdgcn_s_barrier()
#define PG8_SCHED __builtin_amdgcn_sched_barrier(0)
    Unit cur, nxt; int ui = 0;
    if (!S.next(0, cur)) return;
    f32x4 acc[2][2][4][2];
#pragma unroll
    for (int a = 0; a < 2; ++a)
#pragma unroll
        for (int b = 0; b < 2; ++b)
#pragma unroll
            for (int m = 0; m < 4; ++m)
#pragma unroll
                for (int n = 0; n < 2; ++n) acc[a][b][m][n] = (f32x4){0.f, 0.f, 0.f, 0.f};
    bf16x8 At[4][2], B0[2][2], B1[2][2];
    const char* cA = (const char*)g.A + (size_t)cur.pm * tA; const char* cB = (const char*)g.Bt + (size_t)cur.pn * tB;
    S.a_ready(cur);
    if constexpr (SP2) {
        PG8_STAGE(PG8_SB(0, 0), cB, voffB); PG8_STAGE(PG8_SB(0, 1), cB + hB, voffB); PG8_STAGE(PG8_SA(0, 0), cA, voffA); PG8_STAGE(PG8_SA(0, 1), cA + hA, voffA);
        if (wr == 1) PG8_BAR;
        PG8_WAIT_V(2); PG8_BAR;
        PG8_STAGE(PG8_SB(1, 0), cB + kstep, voffB); PG8_STAGE(PG8_SA(1, 0), cA + kstep, voffA); PG8_STAGE(PG8_SB(1, 1), cB + hB + kstep, voffB);
        PG8_WAIT_V(6); PG8_BAR;
    } else {
        PG8_STAGE(PG8_SB(0, 0), cB, voffB); PG8_STAGE(PG8_SA(0, 0), cA, voffA); PG8_STAGE(PG8_SB(0, 1), cB + hB, voffB); PG8_STAGE(PG8_SA(0, 1), cA + hA, voffA);
        if (wr == 1) PG8_BAR;
        PG8_WAIT_V(4); PG8_BAR;
        PG8_STAGE(PG8_SB(1, 0), cB + kstep, voffB); PG8_STAGE(PG8_SA(1, 0), cA + kstep, voffA); PG8_STAGE(PG8_SB(1, 1), cB + hB + kstep, voffB);
        PG8_WAIT_V(6); PG8_BAR;
    }
    for (;;) {
        const bool has_next = S.next(ui + 1, nxt);
        const char* nA = has_next ? (const char*)g.A + (size_t)nxt.pm * tA : cA; const char* nB = has_next ? (const char*)g.Bt + (size_t)nxt.pn * tB : cB;
        for (int t = 0; t < nt; t += 2) {
            const bool last = (t == nt - 2);
            const char* a1 = cA + (size_t)(t + 1) * kstep;
            const char* a2 = last ? nA : cA + (size_t)(t + 2) * kstep; const char* b2 = last ? nB : cB + (size_t)(t + 2) * kstep;
            const char* a3 = a2 + kstep; const char* b3 = b2 + kstep;
            if (last && has_next) S.a_ready(nxt);
            if constexpr (SP2) {
            PG8_LDB(B0, 0, 0); PG8_LDB(B1, 0, 1); PG8_SCHED; PG8_LDA(At, 0, 0); PG8_STAGE(PG8_SA(1, 1), a1 + hA, voffA);
            PG8_WAIT_V(8); PG8_WAIT_L(0); PG8_BAR; PG8_MMA(0, 0, At, B0); PG8_MMA(0, 1, At, B1); PG8_BAR; PG8_SCHED;
            PG8_LDA(At, 0, 1); PG8_STAGE(PG8_SB(0, 0), b2, voffB); PG8_STAGE(PG8_SB(0, 1), b2 + hB, voffB); PG8_STAGE(PG8_SA(0, 0), a2, voffA);
            PG8_WAIT_V(8); PG8_WAIT_L(0); PG8_BAR; PG8_MMA(1, 0, At, B0); PG8_MMA(1, 1, At, B1); PG8_BAR; PG8_SCHED;
            PG8_LDB(B0, 1, 0); PG8_LDB(B1, 1, 1); PG8_SCHED; PG8_LDA(At, 1, 0); PG8_STAGE(PG8_SA(0, 1), a2 + hA, voffA);
            PG8_WAIT_V(8); PG8_WAIT_L(0); PG8_BAR; PG8_MMA(0, 0, At, B0); PG8_MMA(0, 1, At, B1); PG8_BAR; PG8_SCHED;
            PG8_LDA(At, 1, 1); PG8_STAGE(PG8_SB(1, 0), b3, voffB); PG8_STAGE(PG8_SB(1, 1), b3 + hB, voffB); PG8_STAGE(PG8_SA(1, 0), a3, voffA);
            PG8_WAIT_V(8); PG8_WAIT_L(0); PG8_BAR; PG8_MMA(1, 0, At, B0); PG8_MMA(1, 1, At, B1); PG8_BAR; PG8_SCHED;
            } else {
            PG8_LDB(B0, 0, 0); PG8_SCHED; PG8_LDA(At, 0, 0); PG8_STAGE(PG8_SA(1, 1), a1 + hA, voffA);
            PG8_WAIT_L(8); PG8_BAR; PG8_WAIT_L(0); PG8_MMA(0, 0, At, B0); PG8_BAR; PG8_SCHED;
            PG8_LDB(B1, 0, 1); PG8_STAGE(PG8_SB(0, 0), b2, voffB);
            PG8_BAR; PG8_WAIT_L(0); PG8_MMA(0, 1, At, B1); PG8_BAR;
            PG8_LDA(At, 0, 1); PG8_STAGE(PG8_SA(0, 0), a2, voffA);
            PG8_BAR; PG8_WAIT_L(0); PG8_MMA(1, 0, At, B0); PG8_BAR; PG8_SCHED;
            PG8_STAGE(PG8_SB(0, 1), b2 + hB, voffB);
            PG8_WAIT_V(6); PG8_BAR; PG8_MMA(1, 1, At, B1); PG8_BAR;
            PG8_LDB(B0, 1, 0); PG8_SCHED; PG8_LDA(At, 1, 0); PG8_STAGE(PG8_SA(0, 1), a2 + hA, voffA);
            PG8_WAIT_L(8); PG8_BAR; PG8_WAIT_L(0); PG8_MMA(0, 0, At, B0); PG8_BAR; PG8_SCHED;
            PG8_LDB(B1, 1, 1); PG8_STAGE(PG8_SB(1, 0), b3, voffB);
            PG8_BAR; PG8_WAIT_L(0); PG8_MMA(0, 1, At, B1); PG8_BAR;
            PG8_LDA(At, 1, 1); PG8_STAGE(PG8_SA(1, 0), a3, voffA);
            PG8_BAR; PG8_WAIT_L(0); PG8_MMA(1, 0, At, B0); PG8_BAR; PG8_SCHED;
            PG8_STAGE(PG8_SB(1, 1), b3 + hB, voffB);
            PG8_WAIT_V(6); PG8_BAR; PG8_MMA(1, 1, At, B1); PG8_BAR;
            }
        }
        if constexpr (ALIGN_EPI) { if (wr == 0) PG8_BAR; }
        if constexpr (!Epi::AFTER_DRAIN) { E(acc, cur, wr, wc, fr, fq); S.done(cur); }
        if (!has_next) break;
#pragma unroll
        for (int a = 0; a < 2; ++a)
#pragma unroll
            for (int b = 0; b < 2; ++b)
#pragma unroll
                for (int m = 0; m < 4; ++m)
#pragma unroll
                    for (int n = 0; n < 2; ++n) acc[a][b][m][n] = (f32x4){0.f, 0.f, 0.f, 0.f};
        cur = nxt; cA = nA; cB = nB; ++ui;
        if constexpr (ALIGN_EPI) { if (wr == 1) PG8_BAR; }
    }
    PG8_WAIT_V(0);
    if constexpr (!ALIGN_EPI) { if (wr == 0) PG8_BAR; }
    PG8_BAR;
#undef PG8_SA
#undef PG8_SB
#undef PG8_STAGE
#undef PG8_LDA
#undef PG8_LDB
#undef PG8_MMA
#undef PG8_WAIT_V
#undef PG8_WAIT_L
#undef PG8_BAR
#undef PG8_SCHED
}
}

typedef unsigned short bf16;
typedef short bf16x8 __attribute__((ext_vector_type(8)));
typedef float f32x4 __attribute__((ext_vector_type(4)));
typedef unsigned u32x4 __attribute__((ext_vector_type(4)));
typedef unsigned u32x2 __attribute__((ext_vector_type(2)));
#define LAS __attribute__((address_space(3)))

constexpr int NWAVES = 8, NTHR = 512;
constexpr int DM = 1024, SEQ = 8192, MTOK = 16384, DEPTH = 4;
constexpr int INC = 7168, DFF = 2816, AW = 512;
constexpr int COL_Q = 0, COL_K = 1536, COL_V = 3072, COL_U = 4608, COL_GA = 5120, COL_GS = 6144;
constexpr int UGP = 2048;
constexpr int TC = 32, NCH = MTOK / TC  , CHB = SEQ / TC  ;
constexpr float EPS = 1e-6f;

constexpr size_t OFF_IN = 0, OFF_P = 7340032, OFF_GLU = 7864320, OFF_OUT = 8912896, OFF_GU = 9961472, OFF_DN = 15728640, LAYER_W = 18612224;
constexpr size_t MiB = 1u << 20;
constexpr size_t WS_SS1 = 65536, WS_SS2 = 131072;
constexpr size_t WS_WB = 1 * MiB, WS_Z = 143 * MiB, WS_ACT = 367 * MiB, WS_Y = 399 * MiB, WS_LSE = 415 * MiB, WS_TAB = 417 * MiB, TAB_STRIDE = 9 * MiB,
                 WS_S = 435 * MiB, WS_XP = 443 * MiB, WS_END = 447 * MiB;
constexpr size_t TB_KT = 0, TB_AT = 768 * 1024, TB_E = 1 * MiB, TB_P = 5 * MiB;
static_assert(WS_WB + 4 * LAYER_W * 2 <= WS_Z && WS_Z + (size_t)MTOK * INC * 2 <= WS_ACT, "ws map");
constexpr int LDS_BYTES = 147456;

struct Args { const float* in[21]; float* out; unsigned char* ws; int ph_lo, ph_hi; };

__device__ __forceinline__ unsigned f2bf(float f) { unsigned u = __float_as_uint(f); return (u + 0x7fffu + ((u >> 16) & 1u)) >> 16; }
__device__ __forceinline__ unsigned pk2(float lo, float hi) { return pg8::cvt_pk_bf16(lo, hi); }
__device__ __forceinline__ float bflo(unsigned w) { return __uint_as_float(w << 16); }
__device__ __forceinline__ float bfhi(unsigned w) { return __uint_as_float(w & 0xffff0000u); }
__device__ __forceinline__ float wave_sum(float v) {
#pragma unroll
    for (int o = 1; o < 64; o <<= 1) v += __shfl_xor(v, o);
    return v;
}

__device__ __forceinline__ void transpose_item(const float* W, int K, int N, bf16* WT, int il_off, float* scr, int item, int lane, const float* gk = nullptr) {
    const int nblk = N / 64, kb = item / nblk, nb = item % nblk, k0 = 64 * kb, n0 = 64 * nb;
    const float* src = W + (size_t)k0 * N + n0 + lane;
#pragma unroll 16
    for (int i = 0; i < 64; ++i) scr[i * 65 + lane] = src[(size_t)i * N];
    const int drow = (il_off < 0) ? n0 : (n0 / 128) * 256 + il_off + (n0 % 128);
    const int c = lane & 7, nn = lane >> 3;
    f32x4 g0 = (f32x4){1.f, 1.f, 1.f, 1.f}, g1 = g0;
    if (gk) { g0 = *(const f32x4*)(gk + k0 + 8 * c); g1 = *(const f32x4*)(gk + k0 + 8 * c + 4); }
#pragma unroll
    for (int j = 0; j < 8; ++j) { const int n = nn + 8 * j; const float* p = scr + (8 * c) * 65 + n;
        u32x4 o; o.x = pk2(p[0 * 65] * g0.x, p[1 * 65] * g0.y); o.y = pk2(p[2 * 65] * g0.z, p[3 * 65] * g0.w); o.z = pk2(p[4 * 65] * g1.x, p[5 * 65] * g1.y); o.w = pk2(p[6 * 65] * g1.z, p[7 * 65] * g1.w);
        *(u32x4*)(WT + (size_t)(drow + n) * K + k0 + 8 * c) = o; }
}
__device__ __forceinline__ void phase_weights(const Args& a, int zero, bf16* WB, float* ldsf, int gw, int ngw, int wave, int lane) {
    float* scr = ldsf + wave * 4352;
    constexpr int PER_LAYER = 4544;
    for (int it = gw; it < DEPTH * PER_LAYER; it += ngw) {
        const int l = it / PER_LAYER; int r = it % PER_LAYER; bf16* wl = WB + (size_t)l * LAYER_W;
        if (r < 1792) { transpose_item(a.in[2 + zero] + (size_t)l * DM * INC, DM, INC, wl + OFF_IN, -1, scr, r, lane, a.in[1 + zero] + l * DM); continue; } r -= 1792;
        if (r < 128) { transpose_item(a.in[5 + zero] + (size_t)l * AW * DM, AW, DM, wl + OFF_P, -1, scr, r, lane); continue; } r -= 128;
        if (r < 128) { transpose_item(a.in[14 + zero] + (size_t)l * AW * DM, AW, DM, wl + OFF_GLU, 0, scr, r, lane); continue; } r -= 128;
        if (r < 128) { transpose_item(a.in[15 + zero] + (size_t)l * AW * DM, AW, DM, wl + OFF_GLU, 128, scr, r, lane); continue; } r -= 128;
        if (r < 256) { transpose_item(a.in[16 + zero] + (size_t)l * DM * DM, DM, DM, wl + OFF_OUT, -1, scr, r, lane); continue; } r -= 256;
        if (r < 704) { transpose_item(a.in[18 + zero] + (size_t)l * DM * DFF, DM, DFF, wl + OFF_GU, 0, scr, r, lane, a.in[17 + zero] + l * DM); continue; } r -= 704;
        if (r < 704) { transpose_item(a.in[19 + zero] + (size_t)l * DM * DFF, DM, DFF, wl + OFF_GU, 128, scr, r, lane, a.in[17 + zero] + l * DM); continue; } r -= 704;
        transpose_item(a.in[20 + zero] + (size_t)l * DFF * DM, DFF, DM, wl + OFF_DN, -1, scr, r, lane);
    }
}

__device__ __forceinline__ void phase_xprep(const float* x, bf16* out, float* SS, int gw, int ngw, int lane) {
    for (int m = gw; m < MTOK; m += ngw) {
        const f32x4* xr = (const f32x4*)(x + (size_t)m * DM) + lane;
        f32x4 v[4]; float s = 0.f;
#pragma unroll
        for (int j = 0; j < 4; ++j) { v[j] = xr[64 * j]; s += (v[j].x * v[j].x + v[j].y * v[j].y) + (v[j].z * v[j].z + v[j].w * v[j].w); }
        s = wave_sum(s);
        u32x2* o8 = (u32x2*)(out + (size_t)m * DM) + lane;
#pragma unroll
        for (int j = 0; j < 4; ++j) { u32x2 w; w.x = pk2(v[j].x, v[j].y); w.y = pk2(v[j].z, v[j].w); o8[64 * j] = w; }
        if (lane < 16) SS[(size_t)m * 16 + lane] = (lane == 0) ? s : 0.f;
    }
}

__device__ __forceinline__ void ssm_pre_item(const Args& a, int zero, int l, int g, unsigned char* tab, float* L, int tid) {
    float* pw = L; float* bb = L + 4224; float* cc = L + 6272;
    const float* lam_re = a.in[6 + zero] + (size_t)(l * 32 + g) * 64; const float* lam_im = a.in[7 + zero] + (size_t)(l * 32 + g) * 64;
    const float* b_re = a.in[9 + zero] + (size_t)(l * 32 + g) * 1024; const float* b_im = a.in[10 + zero] + (size_t)(l * 32 + g) * 1024;
    const float* c_re = a.in[11 + zero] + (size_t)(l * 32 + g) * 1024; const float* c_im = a.in[12 + zero] + (size_t)(l * 32 + g) * 1024;
    const float ldt = a.in[8 + zero][l * 32 + g];
    const double INV_2PI = 0.15915494309189533577, TWO_PI = 6.283185307179586476925;
    float brv[2], biv[2], crv[2], civ[2], lrv[5], liv[5];
#pragma unroll
    for (int q = 0; q < 2; ++q) { const int i = tid + NTHR * q; brv[q] = b_re[i]; biv[q] = b_im[i]; crv[q] = c_re[i]; civ[q] = c_im[i]; }
#pragma unroll
    for (int q = 0; q < 5; ++q) { const int i = tid + NTHR * q, p = i & 63; lrv[q] = lam_re[p]; liv[q] = lam_im[p]; }
    const float dt = expf(ldt);
#pragma unroll
    for (int q = 0; q < 2; ++q) { const int i = tid + NTHR * q, p = i >> 4; const float lr = lam_re[p], li = lam_im[p];
        const double angle = (double)li * (double)dt; const double rr = angle - TWO_PI * rint(angle * INV_2PI);
        float sn, cs; sincosf((float)rr, &sn, &cs); const float mag = expf(lr * dt);
        const float nr = mag * cs - 1.0f, ni = mag * sn, den = lr * lr + li * li;
        const float cr = (nr * lr + ni * li) / den, ci = (ni * lr - nr * li) / den;
        bb[i * 2] = cr * brv[q] - ci * biv[q]; bb[i * 2 + 1] = cr * biv[q] + ci * brv[q];
        cc[i * 2] = crv[q]; cc[i * 2 + 1] = civ[q]; }
#pragma unroll
    for (int q = 0; q < 5; ++q) { const int i = tid + NTHR * q; if (i < 33 * 64) { const int j = i >> 6;
        const double angle = (double)liv[q] * (double)dt * (double)j; const double rr = angle - TWO_PI * rint(angle * INV_2PI);
        float sn, cs; sincosf((float)rr, &sn, &cs); const float mag = expf(lrv[q] * dt * (float)j);
        pw[i * 2] = mag * cs; pw[i * 2 + 1] = mag * sn; } }
    __syncthreads();
    bf16* KT = (bf16*)(tab + TB_KT) + (size_t)g * 32 * 256; bf16* E = (bf16*)(tab + TB_E) + (size_t)g * 128 * 512; bf16* P = (bf16*)(tab + TB_P) + (size_t)g * 512 * 128;
    float* AT = (float*)(tab + TB_AT) + g * 128;
    { const int j = tid >> 4, c = tid & 15; float acc16[16];
#pragma unroll
      for (int q = 0; q < 16; ++q) acc16[q] = 0.f;
      for (int p = 0; p < 64; ++p) { const float Cr = cc[(c * 64 + p) * 2], Ci = cc[(c * 64 + p) * 2 + 1], wr_ = pw[(j * 64 + p) * 2], wi_ = pw[(j * 64 + p) * 2 + 1];
          const float tr = Cr * wr_ - Ci * wi_, ti = Cr * wi_ + Ci * wr_; const f32x4* b4 = (const f32x4*)(bb + p * 32);
#pragma unroll
          for (int q = 0; q < 8; ++q) { const f32x4 bv = b4[q]; acc16[2 * q] += tr * bv.x - ti * bv.y; acc16[2 * q + 1] += tr * bv.z - ti * bv.w; } }
      u32x4 o0, o1; o0.x = pk2(acc16[0], acc16[1]); o0.y = pk2(acc16[2], acc16[3]); o0.z = pk2(acc16[4], acc16[5]); o0.w = pk2(acc16[6], acc16[7]);
      o1.x = pk2(acc16[8], acc16[9]); o1.y = pk2(acc16[10], acc16[11]); o1.z = pk2(acc16[12], acc16[13]); o1.w = pk2(acc16[14], acc16[15]);
      *(u32x4*)(KT + (size_t)tid * 16) = o0; *(u32x4*)(KT + (size_t)tid * 16 + 8) = o1; }
    for (int i8 = tid; i8 < 128 * 64; i8 += NTHR) { const int row = i8 >> 6, k8 = i8 & 63, p = row & 63, s_ = k8 >> 1, c0 = (k8 & 1) * 8, j = 31 - s_;
        const float wr_ = pw[(j * 64 + p) * 2], wi_ = pw[(j * 64 + p) * 2 + 1]; const f32x4* b4 = (const f32x4*)(bb + (p * 16 + c0) * 2); float v[8];
#pragma unroll
        for (int q = 0; q < 4; ++q) { const f32x4 bv = b4[q];
            v[2 * q] = (row < 64) ? (wr_ * bv.x - wi_ * bv.y) : (wr_ * bv.y + wi_ * bv.x); v[2 * q + 1] = (row < 64) ? (wr_ * bv.z - wi_ * bv.w) : (wr_ * bv.w + wi_ * bv.z); }
        u32x4 o; o.x = pk2(v[0], v[1]); o.y = pk2(v[2], v[3]); o.z = pk2(v[4], v[5]); o.w = pk2(v[6], v[7]);
        *(u32x4*)(E + (size_t)i8 * 8) = o; }
    for (int i8 = tid; i8 < 512 * 16; i8 += NTHR) { const int row = i8 >> 4, q0 = (i8 & 15) * 8, p0 = q0 & 63, t = row >> 4, c = row & 15, j = t + 1;
        const f32x4* c4 = (const f32x4*)(cc + (c * 64 + p0) * 2); const f32x4* w4 = (const f32x4*)(pw + (j * 64 + p0) * 2); float v[8];
#pragma unroll
        for (int q = 0; q < 4; ++q) { const f32x4 cv = c4[q], wv = w4[q];
            v[2 * q] = (q0 < 64) ? (cv.x * wv.x - cv.y * wv.y) : -(cv.x * wv.y + cv.y * wv.x); v[2 * q + 1] = (q0 < 64) ? (cv.z * wv.z - cv.w * wv.w) : -(cv.z * wv.w + cv.w * wv.z); }
        u32x4 o; o.x = pk2(v[0], v[1]); o.y = pk2(v[2], v[3]); o.z = pk2(v[4], v[5]); o.w = pk2(v[6], v[7]);
        *(u32x4*)(P + (size_t)i8 * 8) = o; }
    if (tid < 64) { AT[tid] = pw[(32 * 64 + tid) * 2]; AT[64 + tid] = pw[(32 * 64 + tid) * 2 + 1]; }
    __syncthreads();
}

constexpr int QP = 72, VP = 400;
constexpr int LK_OFF = 0, LV_OFF = 384 * QP * 2;
constexpr size_t QPLANE = (size_t)2 * 3 * 8 * 8192 * 64;
struct AttnItem { int n0; size_t qrow0; };
__device__ __forceinline__ AttnItem attn_decode(int sit) {
    AttnItem A; int it = sit; const int rn2 = it & 31; it >>= 5; const int h = it & 7; it >>= 3; const int gi = it % 3, b = it / 3;
    const int dsh = 2 * gi, psh = 5 - dsh;
    const int r = rn2 >> psh; A.n0 = 2 * (rn2 & ((1 << psh) - 1));
    A.qrow0 = ((size_t)(b * 3 + gi) * 8 + h) * 8192 + (size_t)r * (8192 >> dsh) + 128 * A.n0;
    return A;
}
__device__ __forceinline__ void attn_load(const AttnItem& A, const bf16* QH, int tid, u32x4 (&kv)[6], u32x4 (&vv)[6]) {
    const bf16* kp = QH + QPLANE + (A.qrow0 - 128) * 64 + tid * 8;
#pragma unroll
    for (int rd = 0; rd < 6; ++rd) {
        if (A.n0 > 0 || rd >= 2) { kv[rd] = *(const u32x4*)(kp + rd * 4096); vv[rd] = *(const u32x4*)(kp + QPLANE + rd * 4096); }
        else { kv[rd] = (u32x4){0u, 0u, 0u, 0u}; vv[rd] = (u32x4){0u, 0u, 0u, 0u}; } }
}
__device__ __forceinline__ void attn_stage(const float* gk, unsigned char* lds, int tid, const u32x4 (&kv)[6], const u32x4 (&vv)[6]) {
    asm volatile("" : "+v"(tid));
    bf16* Ks = (bf16*)(lds + LK_OFF); bf16* Vt = (bf16*)(lds + LV_OFF);
    const int chunk = tid & 7, rowi = tid >> 3;
    float gkv[8];
#pragma unroll
    for (int i = 0; i < 8; ++i) gkv[i] = gk[chunk * 8 + i];
#pragma unroll
    for (int rd = 0; rd < 6; ++rd) { float f[8]; f[0] = bflo(kv[rd].x); f[1] = bfhi(kv[rd].x); f[2] = bflo(kv[rd].y); f[3] = bfhi(kv[rd].y); f[4] = bflo(kv[rd].z); f[5] = bfhi(kv[rd].z); f[6] = bflo(kv[rd].w); f[7] = bfhi(kv[rd].w);
        float ss = 0.f;
#pragma unroll
        for (int i = 0; i < 8; ++i) ss += f[i] * f[i];
        ss += __shfl_xor(ss, 1); ss += __shfl_xor(ss, 2); ss += __shfl_xor(ss, 4);
        const float rs = rsqrtf(ss * (1.f / 64.f) + EPS);
        u32x4 w; w.x = pk2(f[0] * rs * gkv[0], f[1] * rs * gkv[1]); w.y = pk2(f[2] * rs * gkv[2], f[3] * rs * gkv[3]); w.z = pk2(f[4] * rs * gkv[4], f[5] * rs * gkv[5]); w.w = pk2(f[6] * rs * gkv[6], f[7] * rs * gkv[7]);
        const int ki = rowi + 64 * rd;
        *(u32x4*)(Ks + ki * QP + chunk * 8) = w;
        bf16* vp = Vt + (chunk * 8) * VP + (ki ^ (chunk << 2));
        vp[0 * VP] = (bf16)(vv[rd].x & 0xffffu); vp[1 * VP] = (bf16)(vv[rd].x >> 16); vp[2 * VP] = (bf16)(vv[rd].y & 0xffffu); vp[3 * VP] = (bf16)(vv[rd].y >> 16);
        vp[4 * VP] = (bf16)(vv[rd].z & 0xffffu); vp[5 * VP] = (bf16)(vv[rd].z >> 16); vp[6 * VP] = (bf16)(vv[rd].w & 0xffffu); vp[7 * VP] = (bf16)(vv[rd].w >> 16); }
}
__device__ __forceinline__ void attn_qload(const AttnItem& A, const bf16* QH, int tid, u32x4 (&qr)[4]) {
    const int w = tid >> 6, lane = tid & 63, fr = lane & 15, fq = lane >> 4;
#pragma unroll
    for (int m2 = 0; m2 < 2; ++m2) { const bf16* p = QH + (A.qrow0 + 32 * w + 16 * m2 + fr) * 64 + 8 * fq; qr[2 * m2] = *(const u32x4*)p; qr[2 * m2 + 1] = *(const u32x4*)(p + 32); }
}
__device__ __forceinline__ void attn_tile(const AttnItem& A, int m2, const u32x4 q0, const u32x4 q1, const float* gq, bf16* QH, float* LSE, unsigned char* lds, int tid) {
    asm volatile("" : "+v"(tid));
    const bf16* Ks = (const bf16*)(lds + LK_OFF); const bf16* Vt = (const bf16*)(lds + LV_OFF);
    const int w = tid >> 6, lane = tid & 63, fr = lane & 15, fq = lane >> 4;
    const int qi = 32 * w + 16 * m2 + fr;
    const int ktn = (32 * w + 16 * m2) >> 4;
    const int kt0 = (ktn & ~1) < 14 ? (ktn & ~1) : 14;
    const size_t prow = A.qrow0 + qi;
    bf16x8 qf[2];
    { float f[16]; f[0] = bflo(q0.x); f[1] = bfhi(q0.x); f[2] = bflo(q0.y); f[3] = bfhi(q0.y); f[4] = bflo(q0.z); f[5] = bfhi(q0.z); f[6] = bflo(q0.w); f[7] = bfhi(q0.w);
      f[8] = bflo(q1.x); f[9] = bfhi(q1.x); f[10] = bflo(q1.y); f[11] = bfhi(q1.y); f[12] = bflo(q1.z); f[13] = bfhi(q1.z); f[14] = bflo(q1.w); f[15] = bfhi(q1.w);
      float ss = 0.f;
#pragma unroll
      for (int i = 0; i < 16; ++i) ss += f[i] * f[i];
      ss += __shfl_xor(ss, 16); ss += __shfl_xor(ss, 32);
      const float rs = rsqrtf(ss * (1.f / 64.f) + EPS) * 0.125f;
      const f32x4 g0 = *(const f32x4*)(gq + 8 * fq), g1 = *(const f32x4*)(gq + 8 * fq + 4), g2 = *(const f32x4*)(gq + 32 + 8 * fq), g3 = *(const f32x4*)(gq + 32 + 8 * fq + 4);
      u32x4 a, c;
      a.x = pk2(f[0] * rs * g0.x, f[1] * rs * g0.y); a.y = pk2(f[2] * rs * g0.z, f[3] * rs * g0.w); a.z = pk2(f[4] * rs * g1.x, f[5] * rs * g1.y); a.w = pk2(f[6] * rs * g1.z, f[7] * rs * g1.w);
      c.x = pk2(f[8] * rs * g2.x, f[9] * rs * g2.y); c.y = pk2(f[10] * rs * g2.z, f[11] * rs * g2.w); c.z = pk2(f[12] * rs * g3.x, f[13] * rs * g3.y); c.w = pk2(f[14] * rs * g3.z, f[15] * rs * g3.w);
      qf[0] = __builtin_bit_cast(bf16x8, a); qf[1] = __builtin_bit_cast(bf16x8, c); }
    f32x4 s[10];
#pragma unroll
    for (int t = 0; t < 10; ++t) s[t] = (f32x4){0.f, 0.f, 0.f, 0.f};
    {
        bf16x8 kf[3][4];
        const bf16* kb0 = Ks + (16 * kt0 + fr) * QP + 8 * fq;
#define ATT_LDK(pr, sl) do { _Pragma("unroll") for (int tt = 0; tt < 2; ++tt) _Pragma("unroll") for (int kk = 0; kk < 2; ++kk) kf[sl][tt * 2 + kk] = *(const bf16x8*)(kb0 + (16 * (2 * (pr) + tt)) * QP + 32 * kk); } while (0)
        ATT_LDK(0, 0); ATT_LDK(1, 1);
#pragma unroll
        for (int pr = 0; pr < 5; ++pr) {
            if (pr + 2 < 5) ATT_LDK(pr + 2, (pr + 2) % 3);
            __builtin_amdgcn_sched_barrier(0);
#pragma unroll
            for (int tt = 0; tt < 2; ++tt)
#pragma unroll
                for (int kk = 0; kk < 2; ++kk) s[2 * pr + tt] = __builtin_amdgcn_mfma_f32_16x16x32_bf16(kf[pr % 3][tt * 2 + kk], qf[kk], s[2 * pr + tt], 0, 0, 0);
            __builtin_amdgcn_sched_barrier(0);
        }
#undef ATT_LDK
    }
    float mx = -INFINITY;
    const int dbase = 16 * kt0 + 4 * fq - qi, kbase = 16 * kt0 + 4 * fq - ((A.n0 > 0) ? 0 : 128);
#pragma unroll
    for (int t = 0; t < 10; ++t)
#pragma unroll
        for (int j = 0; j < 4; ++j) { const int dlt = dbase + 16 * t + j; const int bad = (dlt | (128 - dlt) | (kbase + 16 * t + j)) >> 31;
            s[t][j] += __int_as_float(bad & (int)0xff800000); mx = fmaxf(mx, s[t][j]); }
    mx = fmaxf(mx, __shfl_xor(mx, 16)); mx = fmaxf(mx, __shfl_xor(mx, 32));
    float sum = 0.f;
#pragma unroll
    for (int t = 0; t < 10; ++t)
#pragma unroll
        for (int j = 0; j < 4; ++j) { const float p = __builtin_amdgcn_exp2f((s[t][j] - mx) * 1.44269504089f); s[t][j] = p; sum += p; }
    sum += __shfl_xor(sum, 16); sum += __shfl_xor(sum, 32);
    f32x4 o[4];
#pragma unroll
    for (int dt = 0; dt < 4; ++dt) o[dt] = (f32x4){0.f, 0.f, 0.f, 0.f};
    {
        u32x4 vf[3][4];
#define ATT_LDV(jj_, sl) do { _Pragma("unroll") for (int dt = 0; dt < 4; ++dt) { const int dd = 16 * dt + fr, sw = ((dd >> 3) & 7) << 2, kb = 32 * (kt0 / 2 + (jj_)) + 4 * fq; const bf16* vr = Vt + dd * VP; \
            const u32x2 lo = *(const u32x2*)(vr + (kb ^ sw)), hi = *(const u32x2*)(vr + ((kb + 16) ^ sw)); vf[sl][dt] = (u32x4){lo.x, lo.y, hi.x, hi.y}; } } while (0)
        ATT_LDV(0, 0); ATT_LDV(1, 1);
#pragma unroll
        for (int jj = 0; jj < 5; ++jj) {
            if (jj + 2 < 5) ATT_LDV(jj + 2, (jj + 2) % 3);
            u32x4 pw; pw.x = pk2(s[2 * jj][0], s[2 * jj][1]); pw.y = pk2(s[2 * jj][2], s[2 * jj][3]); pw.z = pk2(s[2 * jj + 1][0], s[2 * jj + 1][1]); pw.w = pk2(s[2 * jj + 1][2], s[2 * jj + 1][3]);
            const bf16x8 pf = __builtin_bit_cast(bf16x8, pw);
            __builtin_amdgcn_sched_barrier(0);
#pragma unroll
            for (int dt = 0; dt < 4; ++dt) o[dt] = __builtin_amdgcn_mfma_f32_16x16x32_bf16(__builtin_bit_cast(bf16x8, vf[jj % 3][dt]), pf, o[dt], 0, 0, 0);
            __builtin_amdgcn_sched_barrier(0);
        }
#undef ATT_LDV
    }
    const float inv = 1.0f / sum;
    bf16* op = QH + prow * 64 + 4 * fq;
#pragma unroll
    for (int dt = 0; dt < 4; ++dt) { u32x2 w2; w2.x = pk2(o[dt][0] * inv, o[dt][1] * inv); w2.y = pk2(o[dt][2] * inv, o[dt][3] * inv); *(u32x2*)(op + 16 * dt) = w2; }
    if (fq == 0) LSE[prow] = mx + logf(sum);
}

constexpr int ULP = 520;
__device__ __forceinline__ void ssm_stage_u(const bf16* UH, int g, int mt, unsigned char* lds, int tid) {
    const bf16* src = UH + ((size_t)g * 16384 + (size_t)mt * 2048) * 16;
    u32x4 v[8];
#pragma unroll
    for (int k = 0; k < 8; ++k) v[k] = *(const u32x4*)(src + (size_t)(tid + NTHR * k) * 8);
#pragma unroll
    for (int k = 0; k < 8; ++k) { const int i = tid + NTHR * k; *(u32x4*)(lds + (i >> 6) * (ULP * 2) + (i & 63) * 16) = v[k]; }
}
__device__ __forceinline__ void ssm_s1_item(int item, const bf16* UH, unsigned char* ws, const unsigned char* tab, unsigned char* lds, int tid) {
    const int g = item >> 3, mt = item & 7, w = tid >> 6, lane = tid & 63, fr = lane & 15, fq = lane >> 4;
    const bf16* E = (const bf16*)(tab + TB_E) + (size_t)g * 128 * 512; float* S = (float*)(ws + WS_S);
    const bf16* ep = E + (size_t)(16 * w + fr) * 512 + 8 * fq;
    bf16x8 ef[16];
#pragma unroll
    for (int ks = 0; ks < 16; ++ks) ef[ks] = *(const bf16x8*)(ep + 32 * ks);
    ssm_stage_u(UH, g, mt, lds, tid);
    __syncthreads();
    const bf16* UL = (const bf16*)lds;
    f32x4 acc[4];
#pragma unroll
    for (int mi = 0; mi < 4; ++mi) acc[mi] = (f32x4){0.f, 0.f, 0.f, 0.f};
#pragma unroll
    for (int ks = 0; ks < 16; ++ks)
#pragma unroll
        for (int mi = 0; mi < 4; ++mi) { const bf16x8 uf = *(const bf16x8*)(UL + (16 * mi + fr) * ULP + (2 * ks + (fq >> 1)) * 16 + 8 * (fq & 1)); acc[mi] = __builtin_amdgcn_mfma_f32_16x16x32_bf16(ef[ks], uf, acc[mi], 0, 0, 0); }
#pragma unroll
    for (int mi = 0; mi < 4; ++mi) *(f32x4*)(S + ((size_t)(64 * mt + 16 * mi + fr) * 32 + g) * 128 + 16 * w + 4 * fq) = acc[mi];
    __syncthreads();
}

__device__ __forceinline__ void ssm_carry_item(int item, unsigned char* ws, const unsigned char* tab, float* L, int tid) {
    const int b = item >> 5, g = item & 31;
    const float* S = (const float*)(ws + WS_S); bf16* XP = (bf16*)(ws + WS_XP); const float* AT = (const float*)(tab + TB_AT) + g * 128;
#pragma unroll 4
    for (int i = 0; i < 16; ++i) { const int idx = i * NTHR + tid, k = idx >> 5, q4 = idx & 31;
        *(f32x4*)(L + k * 128 + 4 * q4) = *(const f32x4*)(S + ((size_t)(b * CHB + k) * 32 + g) * 128 + 4 * q4); }
    __syncthreads();
    if (tid < 64) {
        const int p = tid; const float ar = AT[p], ai = AT[64 + p]; float xr = 0.f, xi = 0.f;
        bf16* xo = XP + ((size_t)(b * CHB) * 32 + g) * 128 + p;
#pragma unroll 8
        for (int k = 0; k < CHB; ++k) {
            xo[(size_t)k * 32 * 128] = (bf16)f2bf(xr); xo[(size_t)k * 32 * 128 + 64] = (bf16)f2bf(xi);
            const float sr = L[k * 128 + p], si = L[k * 128 + 64 + p];
            const float nr = ar * xr - ai * xi + sr, ni = ar * xi + ai * xr + si; xr = nr; xi = ni;
        }
    }
    __syncthreads();
}

__device__ __forceinline__ void phase_merge(const bf16* QH, bf16* Aout, const float* LSE, int vt, int nvt) {
    for (int i = vt; i < MTOK * 64; i += nvt) { const int row = i >> 6, h = (i >> 3) & 7, ch = i & 7, b = row >> 13, t = row & 8191;
        const size_t r0 = ((size_t)(b * 3 + 0) * 8 + h) * 8192 + t;
        const size_t r1 = ((size_t)(b * 3 + 1) * 8 + h) * 8192 + ((t & 3) << 11) + (t >> 2);
        const size_t r2 = ((size_t)(b * 3 + 2) * 8 + h) * 8192 + ((t & 15) << 9) + (t >> 4);
        const float l0 = LSE[r0], l1 = LSE[r1], l2 = LSE[r2];
        const float mx = fmaxf(l0, fmaxf(l1, l2)); float w0 = expf(l0 - mx), w1 = expf(l1 - mx), w2 = expf(l2 - mx); const float inv = 1.0f / (w0 + w1 + w2); w0 *= inv; w1 *= inv; w2 *= inv;
        const u32x4 a0 = *(const u32x4*)(QH + r0 * 64 + ch * 8), a1 = *(const u32x4*)(QH + r1 * 64 + ch * 8), a2 = *(const u32x4*)(QH + r2 * 64 + ch * 8);
        u32x4 o;
        o.x = pk2(w0 * bflo(a0.x) + w1 * bflo(a1.x) + w2 * bflo(a2.x), w0 * bfhi(a0.x) + w1 * bfhi(a1.x) + w2 * bfhi(a2.x));
        o.y = pk2(w0 * bflo(a0.y) + w1 * bflo(a1.y) + w2 * bflo(a2.y), w0 * bfhi(a0.y) + w1 * bfhi(a1.y) + w2 * bfhi(a2.y));
        o.z = pk2(w0 * bflo(a0.z) + w1 * bflo(a1.z) + w2 * bflo(a2.z), w0 * bfhi(a0.z) + w1 * bfhi(a1.z) + w2 * bfhi(a2.z));
        o.w = pk2(w0 * bflo(a0.w) + w1 * bflo(a1.w) + w2 * bflo(a2.w), w0 * bfhi(a0.w) + w1 * bfhi(a1.w) + w2 * bfhi(a2.w));
        *(u32x4*)(Aout + (size_t)row * AW + h * 64 + ch * 8) = o; }
}

__device__ __forceinline__ float gelu_tanh(float y) { const float z = 1.5957691216f * (y + 0.044715f * y * y * y); return y * __builtin_amdgcn_rcpf(1.0f + __builtin_amdgcn_exp2f(-1.44269504089f * z)); }
constexpr int XLP = 136;
constexpr int S3_XL = 64 * ULP * 2, S3_KL = S3_XL + 64 * XLP * 2;
__device__ __forceinline__ void ssm_s3_item(int item, const float* dskip, const bf16* UH, bf16* Y, unsigned char* ws, const unsigned char* tab, unsigned char* lds, int tid) {
    const int g = item >> 3, mt = item & 7, w = tid >> 6, lane = tid & 63, fr = lane & 15, fq = lane >> 4;
    const bf16* KT = (const bf16*)(tab + TB_KT) + (size_t)g * 32 * 256; const bf16* P = (const bf16*)(tab + TB_P) + (size_t)g * 512 * 128; const bf16* XP = (const bf16*)(ws + WS_XP);
    { u32x4 xv[2], kv2[2];
#pragma unroll
      for (int k = 0; k < 2; ++k) { const int i = tid + NTHR * k; xv[k] = *(const u32x4*)(XP + ((size_t)(64 * mt + (i >> 4)) * 32 + g) * 128 + (i & 15) * 8); kv2[k] = *(const u32x4*)(KT + (size_t)i * 8); }
      ssm_stage_u(UH, g, mt, lds, tid);
#pragma unroll
      for (int k = 0; k < 2; ++k) { const int i = tid + NTHR * k; *(u32x4*)(lds + S3_XL + (i >> 4) * (XLP * 2) + (i & 15) * 16) = xv[k]; *(u32x4*)(lds + S3_KL + i * 16) = kv2[k]; } }
    const float* dsk = dskip + g * 16 + 4 * fq;
    const float d0 = dsk[0], d1 = dsk[1], d2 = dsk[2], d3 = dsk[3];
    __syncthreads();
    const bf16* UL = (const bf16*)lds; const bf16* XL = (const bf16*)(lds + S3_XL); const bf16* KL = (const bf16*)(lds + S3_KL);
    const int shalf = fq >> 1, c20 = 8 * (fq & 1);
#pragma unroll 1
    for (int ti = 0; ti < 4; ++ti) {
        const int t = (ti == 0) ? w : (ti == 1) ? 15 - w : (ti == 2) ? 16 + w : 31 - w;
        bf16x8 pf[4];
#pragma unroll
        for (int k2 = 0; k2 < 4; ++k2) pf[k2] = *(const bf16x8*)(P + (size_t)(t * 16 + fr) * 128 + 32 * k2 + 8 * fq);
        f32x4 acc[4];
#pragma unroll
        for (int mi = 0; mi < 4; ++mi) acc[mi] = (f32x4){0.f, 0.f, 0.f, 0.f};
        const int nks = (t >> 1) + 1;
#pragma unroll 2
        for (int ks = 0; ks < nks; ++ks) {
            const int s = 2 * ks + shalf, lag = t - s;
            bf16x8 wf = (bf16x8){0, 0, 0, 0, 0, 0, 0, 0};
            if (lag >= 0) wf = *(const bf16x8*)(KL + lag * 256 + fr * 16 + c20);
#pragma unroll
            for (int mi = 0; mi < 4; ++mi) { const bf16x8 uf = *(const bf16x8*)(UL + (16 * mi + fr) * ULP + s * 16 + c20);
                acc[mi] = __builtin_amdgcn_mfma_f32_16x16x32_bf16(wf, uf, acc[mi], 0, 0, 0); }
        }
#pragma unroll
        for (int k2 = 0; k2 < 4; ++k2)
#pragma unroll
            for (int mi = 0; mi < 4; ++mi) { const bf16x8 xf = *(const bf16x8*)(XL + (16 * mi + fr) * XLP + 32 * k2 + 8 * fq);
                acc[mi] = __builtin_amdgcn_mfma_f32_16x16x32_bf16(pf[k2], xf, acc[mi], 0, 0, 0); }
#pragma unroll
        for (int mi = 0; mi < 4; ++mi) { const size_t tok = (size_t)(64 * mt + 16 * mi + fr) * TC + t;
            const u32x2 uu = *(const u32x2*)(UL + (16 * mi + fr) * ULP + t * 16 + 4 * fq);
            const float y0 = acc[mi][0] + d0 * bflo(uu.x), y1 = acc[mi][1] + d1 * bfhi(uu.x), y2 = acc[mi][2] + d2 * bflo(uu.y), y3 = acc[mi][3] + d3 * bfhi(uu.y);
            u32x2 o; o.x = pk2(gelu_tanh(y0), gelu_tanh(y1)); o.y = pk2(gelu_tanh(y2), gelu_tanh(y3));
            *(u32x2*)(Y + tok * AW + 16 * g + 4 * fq) = o; }
    }
    __syncthreads();
}

#define XB_TMO      128
#define XB_XCNT(j)  (256  + 64 * (j))
#define XB_XSUB(j)  (1280 + 64 * (j))
#define XB_XGEN(j)  (2304 + 64 * (j))
#define XB_TOP      3328
#define XB_TOPGEN   3392
#define XCD_BAR_WORDS 3456
#define XB_SPIN_CAP (1u << 20)
__device__ __forceinline__ unsigned xb_ld(unsigned* p)              { return __hip_atomic_load(p, __ATOMIC_RELAXED, __HIP_MEMORY_SCOPE_AGENT); }
__device__ __forceinline__ unsigned xb_add(unsigned* p, unsigned v) { return __hip_atomic_fetch_add(p, v, __ATOMIC_RELAXED, __HIP_MEMORY_SCOPE_AGENT); }
__device__ __forceinline__ unsigned xb_xcc_id() { return (unsigned)__builtin_amdgcn_s_getreg((3 << 11) | 20) & 0xFu; }
#define XB_SPIN(cond, bar) do { unsigned _sp = 0; while (cond) { __builtin_amdgcn_s_sleep(1); \
    if ((++_sp & 255u) == 0u) { if (xb_ld(&(bar)[XB_TMO])) break; if (_sp > XB_SPIN_CAP) { atomicAdd(&(bar)[XB_TMO], 1u); break; } } } } while (0)
struct XcdBarrier { unsigned* bar; unsigned x; volatile LAS unsigned* st; };
__device__ __forceinline__ XcdBarrier xcd_barrier_post(unsigned* bar, volatile LAS unsigned* st) {
    XcdBarrier b; b.bar = bar; b.x = xb_xcc_id(); b.st = st;
    if (threadIdx.x == 0) (void)xb_add(&bar[XB_XCNT(b.x)], 1u);
    return b;
}
__device__ __forceinline__ void xcd_barrier_complete(unsigned* bar, unsigned x, unsigned& nloc, unsigned& nx) {
    const unsigned G = gridDim.x * gridDim.y * gridDim.z;
    unsigned sum, cnt, mine, sp = 0u;
    for (;;) {
        sum = 0u; cnt = 0u; mine = 0u;
#pragma unroll
        for (unsigned j = 0; j < 16; ++j) { const unsigned c = xb_ld(&bar[XB_XCNT(j)]); sum += c; cnt += (c > 0u) ? 1u : 0u; mine = (j == x) ? c : mine; }
        if (sum == G) break;
        __builtin_amdgcn_s_sleep(1);
        if ((++sp & 255u) == 0u) { if (xb_ld(&bar[XB_TMO])) break; if (sp > XB_SPIN_CAP) { atomicAdd(&bar[XB_TMO], 1u); break; } }
    }
    nloc = mine > 0u ? mine : 1u; nx = cnt > 0u ? cnt : 1u;
}
__device__ __forceinline__ void xcd_barrier(const XcdBarrier& b) {
    asm volatile("s_waitcnt vmcnt(0)" ::: "memory");
    __syncthreads();
    if (threadIdx.x == 0) {
        unsigned* bar = b.bar;
        __builtin_amdgcn_s_waitcnt(0);
        unsigned nloc = b.st[0], nx = b.st[1];
        if (nloc == 0u) { xcd_barrier_complete(bar, b.x, nloc, nx); b.st[0] = nloc; b.st[1] = nx; }
        const unsigned old = xb_add(&bar[XB_XSUB(b.x)], 1u);
        const unsigned gen = old / nloc;
        if (old + 1u == (gen + 1u) * nloc) {
            __builtin_amdgcn_fence(__ATOMIC_RELEASE, "agent");
            asm volatile("s_waitcnt vmcnt(0)" ::: "memory");
            const unsigned og = xb_add(&bar[XB_TOP], 1u);
            const unsigned tg = og / nx;
            if (og + 1u == (tg + 1u) * nx) xb_add(&bar[XB_TOPGEN], 1u);
            else XB_SPIN(xb_ld(&bar[XB_TOPGEN]) == tg, bar);
            __builtin_amdgcn_fence(__ATOMIC_ACQUIRE, "agent");
            xb_add(&bar[XB_XGEN(b.x)], 1u);
            asm volatile("s_waitcnt vmcnt(0)" ::: "memory");
        } else {
            XB_SPIN(xb_ld(&bar[XB_XGEN(b.x)]) == gen, bar);
            __builtin_amdgcn_fence(__ATOMIC_ACQUIRE, "agent");
            asm volatile("s_waitcnt vmcnt(0)" ::: "memory");
        }
    }
    __syncthreads();
}

constexpr int KPL = 8, N_PHASES = 1 + KPL * DEPTH;
__global__ void __launch_bounds__(NTHR, 2) mega_fwd(Args a) {
    extern __shared__ __attribute__((aligned(16))) unsigned char lds[];
    cg::grid_group grid = cg::this_grid();
    LAS unsigned char* ldsl = (LAS unsigned char*)lds;
    volatile LAS unsigned* bst = (volatile LAS unsigned*)(ldsl + LDS_BYTES - 16);
    if (threadIdx.x < 2) bst[threadIdx.x] = 0u;
    __syncthreads();
    XcdBarrier xbar; xbar.bar = (unsigned*)a.ws; xbar.x = 0; xbar.st = bst;
    if (a.ph_hi - a.ph_lo > 1) xbar = xcd_barrier_post((unsigned*)a.ws, bst);
    int prep = 0;
    for (int ph = a.ph_lo; ph < a.ph_hi; ++ph) {
        int zero; asm volatile("s_mov_b32 %0, 0" : "=s"(zero));
        int tid = threadIdx.x; asm volatile("" : "+v"(tid));
        const int lane = tid & 63, wave = __builtin_amdgcn_readfirstlane(tid >> 6);
        const int G = (int)gridDim.x + zero, bx = (int)blockIdx.x + zero;
        const int gw = bx * NWAVES + wave, ngw = G * NWAVES;
        unsigned char* ws = a.ws + zero; float* outp = a.out + zero;
        bf16* WB = (bf16*)(ws + WS_WB); bf16* QH = (bf16*)(ws + WS_Z); bf16* UG = (bf16*)(ws + WS_Z + 144 * MiB); bf16* UH = (bf16*)(ws + WS_Z + 208 * MiB); bf16* AK = QH + QPLANE; bf16* ACT = (bf16*)(ws + WS_ACT); bf16* Y = (bf16*)(ws + WS_Y); float* LSE = (float*)(ws + WS_LSE);
        bf16* MIX = QH;
        float* SS1 = (float*)(ws + WS_S); float* SS2 = (float*)(ws + WS_S + MiB);
        if (ph == 0) {
            for (int rep = 0; rep < NREP(15); ++rep) phase_weights(a, zero, WB, (float*)lds, gw, ngw, wave, lane);
            __syncthreads();
            for (int rep = 0; rep < NREP(12); ++rep) {
            for (int g = bx; g < 32; g += G) ssm_pre_item(a, zero, 0, g, ws + WS_TAB, (float*)lds, tid);
            phase_xprep(a.in[zero], ACT, SS2, gw, ngw, lane); }
        } else {
            const int l = (ph - 1) / KPL, k = (ph - 1) % KPL;
            const bf16* wl = WB + (size_t)l * LAYER_W;
            const float* xin = (l == 0) ? a.in[zero] : outp;
            unsigned char* tab = ws + WS_TAB + (size_t)(l & 1) * TAB_STRIDE;
            if (k == 0) {
                pg8::Gemm gm{ACT, wl + OFF_IN, MTOK, INC, DM, DM}; pg8::StaticOrder S; S.init(MTOK, INC, G, bx);
                PG8_LAS float* rst = (PG8_LAS float*)(ldsl + 131088); int pbase = 0;
                { pg8::Unit u0; if (S.next(0, u0)) { pbase = (u0.pm & ~7) * 256; for (int i = tid; i < 2048; i += NTHR) rst[i] = pg8::row_rstd(SS2, (size_t)(pbase + i)); } }
                __syncthreads();
                pg8::EpiZ E{QH, UG, UH, SS2, rst, pbase};
                pg8::gemm_phase<pg8::EpiZ, pg8::StaticOrder, true, true>(ldsl, tid, gm, S, E);
            } else if (k == 1) {
                const float* gq = a.in[3 + zero] + l * 64; const float* gk = a.in[4 + zero] + l * 64;
                u32x4 kv[6], vv[6], qr[4], qn[4];
#pragma unroll
                for (int i = 0; i < 6; ++i) { kv[i] = (u32x4){0u, 0u, 0u, 0u}; vv[i] = (u32x4){0u, 0u, 0u, 0u}; qr[i & 3] = (u32x4){0u, 0u, 0u, 0u}; qn[i & 3] = (u32x4){0u, 0u, 0u, 0u}; }
                if (bx < 1536) { const AttnItem A0 = attn_decode(bx); attn_load(A0, QH, tid, kv, vv); attn_qload(A0, QH, tid, qn); }
                for (int it = bx; it < 1536; it += G) {
                    const AttnItem A = attn_decode(it);
                    attn_stage(gk, lds, tid, kv, vv);
#pragma unroll
                    for (int i = 0; i < 4; ++i) qr[i] = qn[i];
                    __builtin_amdgcn_sched_barrier(0);
                    __syncthreads();
                    if (it + G < 1536) { const AttnItem An = attn_decode(it + G); attn_load(An, QH, tid, kv, vv); attn_qload(An, QH, tid, qn); }
                    __builtin_amdgcn_sched_barrier(0);
                    attn_tile(A, 0, qr[0], qr[1], gq, QH, LSE, lds, tid);
                    attn_tile(A, 1, qr[2], qr[3], gq, QH, LSE, lds, tid);
                    __builtin_amdgcn_sched_barrier(0);
                    __syncthreads();
                }
                for (int it = bx; it < 256; it += G) for (int rep = 0; rep < NREP(2); ++rep) ssm_s1_item(it, UH, ws, tab, lds, tid);
            } else if (k == 2) {
                if (G >= 256) {
                    if (bx < 64) { for (int rep = 0; rep < NREP(3); ++rep) ssm_carry_item(bx, ws, tab, (float*)lds, tid); }
                    else if (bx < 96) { if (l + 1 < DEPTH) for (int rep = 0; rep < NREP(11); ++rep) ssm_pre_item(a, zero, l + 1, bx - 64, ws + WS_TAB + (size_t)((l + 1) & 1) * TAB_STRIDE, (float*)lds, tid); }
                    else { for (int rep = 0; rep < NREP(10); ++rep) phase_merge(QH, AK, LSE, (bx - 96) * NTHR + tid, (G - 96) * NTHR); }
                } else {
                    for (int it = bx; it < 64; it += G) ssm_carry_item(it, ws, tab, (float*)lds, tid);
                    if (l + 1 < DEPTH) for (int g = bx; g < 32; g += G) ssm_pre_item(a, zero, l + 1, g, ws + WS_TAB + (size_t)((l + 1) & 1) * TAB_STRIDE, (float*)lds, tid);
                    phase_merge(QH, AK, LSE, bx * NTHR + tid, G * NTHR);
                }
            } else if (k == 3) {
                const float* dskip = a.in[13 + zero] + l * 512;
                for (int rep = 0; rep < NREP(4); ++rep) for (int it = bx; it < 256; it += G) ssm_s3_item(it, dskip, UH, Y, ws, tab, lds, tid);
            } else if (k == 4) {
                { pg8::Gemm gm{AK, wl + OFF_P, MTOK, DM, AW, AW}; pg8::StaticOrder S; S.init(MTOK, DM, G, bx);
                  pg8::EpiGate1 E{MIX, DM, UG, UGP};
                  pg8::gemm_phase<pg8::EpiGate1, pg8::StaticOrder, true, true>(ldsl, tid, gm, S, E); }
                { pg8::Gemm gm{Y, wl + OFF_GLU, MTOK, 2 * DM, AW, AW}; pg8::PairOrder S; S.base.init(MTOK, DM, G, bx);
                  pg8::EpiGlu E{MIX, DM, UG + 1024, UGP};
                  pg8::gemm_phase<pg8::EpiGlu, pg8::PairOrder, true, true>(ldsl, tid, gm, S, E); }
            } else if (k == 5) {
                pg8::Gemm gm{MIX, wl + OFF_OUT, MTOK, DM, DM, DM}; pg8::StaticOrder S; S.init(MTOK, DM, G, bx);
                pg8::EpiResid E{xin, outp, DM, ACT, SS1};
                pg8::gemm_phase<pg8::EpiResid, pg8::StaticOrder, true, true>(ldsl, tid, gm, S, E);
            } else if (k == 6) {
                pg8::Gemm gm{ACT, wl + OFF_GU, MTOK, 2 * DFF, DM, DM}; pg8::StaticOrder S; S.init(MTOK, 2 * DFF, G, bx);
                PG8_LAS float* rst = (PG8_LAS float*)(ldsl + 131088); int pbase = 0;
                { pg8::Unit u0; if (S.next(0, u0)) { pbase = (u0.pm & ~7) * 256; for (int i = tid; i < 2048; i += NTHR) rst[i] = pg8::row_rstd(SS1, (size_t)(pbase + i)); } }
                __syncthreads();
                pg8::EpiSwiglu E{QH, DFF, SS1, rst, pbase};
                pg8::gemm_phase<pg8::EpiSwiglu, pg8::StaticOrder, true, true>(ldsl, tid, gm, S, E);
            } else {
                pg8::Gemm gm{QH, wl + OFF_DN, MTOK, DM, DFF, DFF}; pg8::StaticOrder S; S.init(MTOK, DM, G, bx);
                pg8::EpiResid E{outp, outp, DM, ACT, SS2};
                pg8::gemm_phase<pg8::EpiResid, pg8::StaticOrder, true, true>(ldsl, tid, gm, S, E);
            }
        }
        if (REP_PH != 0 && ph > 0 && ((REP_PH >> ((ph - 1) % KPL)) & 1) && prep == 0) { prep = 1; --ph; xcd_barrier(xbar); continue; }
        prep = 0;
        if (ph + 1 < a.ph_hi) { if (ph == a.ph_lo) grid.sync(); else { for (int sx = 0; sx < SYNC_X; ++sx) xcd_barrier(xbar); } }
    }
}

extern "C" void kernel_launch(void* const* d_in, const int* in_sizes, int n_in, void* d_out, int out_size, void* d_ws, size_t ws_size, hipStream_t stream) {
    static int grid = 0;
    if (grid == 0) {
        if (n_in != 21 || in_sizes[0] != MTOK * DM || out_size != MTOK * DM || ws_size < WS_END) { fprintf(stderr, "kernel_launch: unexpected shapes / workspace (n_in %d, ws %zu)\n", n_in, ws_size); grid = -1; return; }
        int dev = 0, cus = 0, per_cu = 0;
        (void)hipGetDevice(&dev); (void)hipDeviceGetAttribute(&cus, hipDeviceAttributeMultiprocessorCount, dev);
        (void)hipFuncSetAttribute((const void*)mega_fwd, hipFuncAttributeMaxDynamicSharedMemorySize, LDS_BYTES);
        (void)hipOccupancyMaxActiveBlocksPerMultiprocessor(&per_cu, (const void*)mega_fwd, NTHR, LDS_BYTES);
        if (per_cu < 1) per_cu = 1;
        (void)hipGetLastError();
        grid = cus * per_cu;
    }
    if (grid < 0) return;
    (void)hipMemsetAsync(d_ws, 0, 16384, stream);
    Args a{};
    for (int i = 0; i < 21; ++i) a.in[i] = (const float*)d_in[i];
    a.out = (float*)d_out; a.ws = (unsigned char*)d_ws;
#if MK_SINGLE
    a.ph_lo = 0; a.ph_hi = N_PHASES;
    void* args[] = {&a};
    hipError_t e = hipLaunchCooperativeKernel((const void*)mega_fwd, dim3(grid), dim3(NTHR), args, LDS_BYTES, stream);
    if (e != hipSuccess) fprintf(stderr, "cooperative launch failed: %s (grid %d)\n", hipGetErrorString(e), grid);
#else
    for (int ph = 0; ph < N_PHASES; ++ph) { a.ph_lo = ph; a.ph_hi = ph + 1; hipLaunchKernelGGL(mega_fwd, dim3(grid), dim3(NTHR), LDS_BYTES, stream, a); }
#endif
}
```

```cpp
#include <hip/hip_runtime.h>
#include <hip/hip_cooperative_groups.h>
#include <cstdio>
#include <cstdint>
namespace cg = cooperative_groups;

#ifndef REP_MASK
#define REP_MASK 0
#endif
#ifndef REP_PH
#define REP_PH 0
#endif
#ifndef REP_ATT
#define REP_ATT 0
#endif
#ifndef WGM_K0
#define WGM_K0 4
#endif
#ifndef WGM_K6
#define WGM_K6 8
#endif
#ifndef WGM_S
#define WGM_S 8
#endif
#ifndef W_FILL
#define W_FILL 1
#endif
#ifndef K0_DELAY_US
#define K0_DELAY_US 0
#endif
#ifndef K6_DELAY_US
#define K6_DELAY_US 15
#endif
#ifndef STAGGER_US
#define STAGGER_US 0
#endif
#ifndef DUP_K
#define DUP_K (-1)
#endif
#ifndef SYNC_X
#define SYNC_X 1
#endif
#define NREP(k) (((REP_MASK >> (k)) & 1) ? 2 : 1)
#ifndef MK_SINGLE
#define MK_SINGLE 1
#endif

namespace pg8 {
#define PG8_LAS __attribute__((address_space(3)))
typedef unsigned short bf16_t;
typedef short bf16x8 __attribute__((ext_vector_type(8)));
typedef float f32x4 __attribute__((ext_vector_type(4)));
typedef unsigned u32x4 __attribute__((ext_vector_type(4)));
constexpr int BM = 256, BK = 64, HALF = 128, HTB = HALF * BK * 2, STAGE_BYTES = 8 * HTB, NXCD = 8, WGM = 8;

__host__ __device__ __forceinline__ int lds_byte(int r, int c) { const int st = (r >> 4) * 2 + (c >> 5), rr = r & 15, cc = c & 31, ob = rr * 64 + cc * 2; return st * 1024 + (ob ^ (((ob >> 9) & 1) << 5)); }
__host__ __device__ __forceinline__ void stage_rc(int b, int& R, int& C) { const int st = b / 1024, sb = b % 1024, swz = sb ^ (((sb >> 9) & 1) << 5); R = (st >> 1) * 16 + swz / 64; C = (st & 1) * 32 + (swz % 64) / 2; }
__host__ __device__ __forceinline__ int perm32(int rho) { const int n = rho >> 4, i = rho & 15; return 8 * (i >> 2) + 4 * n + (i & 3); }

struct Unit { int pm, pn; };
struct Gemm { const bf16_t* A; const bf16_t* Bt; int M, N, K, lda; };

struct StaticOrder {
    int nM, nN, nwg, G, c, wgm;
    __host__ __device__ void init(int M, int N, int G_, int c_, int wgm_ = WGM) { nM = M / BM; nN = N / BM; nwg = nM * nN; G = G_; c = c_; wgm = wgm_; }
    __host__ __device__ bool next(int i, Unit& u) const {
        const long L = (long)i * G + c; if (L >= nwg) return false;
        int wgid = (int)L; { const int q = nwg / NXCD, r = nwg % NXCD, xcd = wgid % NXCD, off = wgid / NXCD; wgid = (xcd < r ? xcd * (q + 1) : r * (q + 1) + (xcd - r) * q) + off; }
        const int nig = wgm * nN, gid = wgid / nig, fm = gid * wgm, gsz = (nM - fm) < wgm ? (nM - fm) : wgm;
        u.pm = fm + ((wgid % nig) % gsz); u.pn = (wgid % nig) / gsz; return true;
    }
    __device__ __forceinline__ void a_ready(const Unit&) const {}
    __device__ __forceinline__ void done(const Unit&) const {}
};
struct PairOrder {
    StaticOrder base;
    __host__ __device__ bool next(int i, Unit& u) const { Unit b; if (!base.next(i >> 1, b)) return false; u.pm = b.pm; u.pn = 2 * b.pn + (i & 1); return true; }
    __device__ __forceinline__ void a_ready(const Unit&) const {}
    __device__ __forceinline__ void done(const Unit&) const {}
};

typedef float f32x2c_ __attribute__((ext_vector_type(2))); typedef __bf16 bf16x2c_ __attribute__((ext_vector_type(2)));
__device__ __forceinline__ unsigned cvt_pk_bf16(float lo, float hi) { const f32x2c_ v = {lo, hi}; const bf16x2c_ b = __builtin_convertvector(v, bf16x2c_); return __builtin_bit_cast(unsigned, b); }
__device__ __forceinline__ float bf_lo(unsigned w) { return __uint_as_float(w << 16); }
__device__ __forceinline__ float bf_hi(unsigned w) { return __uint_as_float(w & 0xffff0000u); }
__device__ __forceinline__ float ub(unsigned w, int i) { return (float)((w >> (8 * i)) & 255u) * (1.0f / 255.0f); }
__device__ __forceinline__ unsigned pk_u8x4(float a, float b, float c, float d) { return (unsigned)(a * 255.f + 0.5f) | ((unsigned)(b * 255.f + 0.5f) << 8) | ((unsigned)(c * 255.f + 0.5f) << 16) | ((unsigned)(d * 255.f + 0.5f) << 24); }
__device__ __forceinline__ float sigmoidf_(float x) { return __builtin_amdgcn_rcpf(1.0f + __builtin_amdgcn_exp2f(-1.44269504089f * x)); }

__device__ __forceinline__ float row_rstd(const float* SSP, size_t row) {
    const f32x4* p = (const f32x4*)(SSP + row * 16); const f32x4 a = p[0], b = p[1], c = p[2], d = p[3];
    const float ss = ((a[0] + a[1]) + (a[2] + a[3])) + ((b[0] + b[1]) + (b[2] + b[3])) + ((c[0] + c[1]) + (c[2] + c[3])) + ((d[0] + d[1]) + (d[2] + d[3]));
    return rsqrtf(ss * (1.0f / 1024.0f) + 1e-6f);
}
struct EpiZ {
    static constexpr bool PERM = true, AFTER_DRAIN = false;
    bf16_t* QH; bf16_t* UG; bf16_t* UH; const float* SS; const PG8_LAS float* rst; int pbase;
    __device__ __forceinline__ void operator()(const f32x4 (&acc)[2][2][4][2], const Unit& u, int wr, int wc, int fr, int fq) const {
        const int row0 = u.pm * BM + wr * 64 + fr;
        float rs[2][4];
#pragma unroll
        for (int ai = 0; ai < 2; ++ai)
#pragma unroll
            for (int m = 0; m < 4; ++m) { const int rr = row0 + ai * HALF + m * 16, rl = rr - pbase; rs[ai][m] = ((unsigned)rl < 2048u) ? rst[rl] : row_rstd(SS, (size_t)rr); }
        if (u.pn < 18) {
            const int which = u.pn / 6, colt = (u.pn % 6) * 256;
#pragma unroll
            for (int bj = 0; bj < 2; ++bj) { const int col = colt + bj * HALF + wc * 32 + 8 * fq, gi = col >> 9, h = (col >> 6) & 7, e = col & 63, dsh = 2 * gi;
#pragma unroll
                for (int ai = 0; ai < 2; ++ai)
#pragma unroll
                    for (int m = 0; m < 4; ++m) { const int row = row0 + ai * HALF + m * 16, b = row >> 13, t = row & 8191, idx = ((t & ((1 << dsh) - 1)) << (13 - dsh)) + (t >> dsh);
                        const f32x4 v0 = acc[ai][bj][m][0] * rs[ai][m], v1 = acc[ai][bj][m][1] * rs[ai][m];
                        u32x4 w; w.x = cvt_pk_bf16(v0[0], v0[1]); w.y = cvt_pk_bf16(v0[2], v0[3]); w.z = cvt_pk_bf16(v1[0], v1[1]); w.w = cvt_pk_bf16(v1[2], v1[3]);
                        *(u32x4*)(QH + ((((size_t)(which * 2 + b) * 3 + gi) * 8 + h) * 8192 + idx) * 64 + e) = w; } }
        } else if (u.pn < 20) {
#pragma unroll
            for (int bj = 0; bj < 2; ++bj) { const int col = (u.pn - 18) * BM + bj * HALF + wc * 32 + 8 * fq, g = col >> 4, c0 = col & 15;
#pragma unroll
                for (int ai = 0; ai < 2; ++ai)
#pragma unroll
                    for (int m = 0; m < 4; ++m) { const int row = row0 + ai * HALF + m * 16;
                        const f32x4 v0 = acc[ai][bj][m][0] * rs[ai][m], v1 = acc[ai][bj][m][1] * rs[ai][m];
                        u32x4 w; w.x = cvt_pk_bf16(v0[0], v0[1]); w.y = cvt_pk_bf16(v0[2], v0[3]); w.z = cvt_pk_bf16(v1[0], v1[1]); w.w = cvt_pk_bf16(v1[2], v1[3]);
                        *(u32x4*)(UH + ((size_t)g * 16384 + row) * 16 + c0) = w; } }
        } else {
            typedef unsigned u32x2g __attribute__((ext_vector_type(2)));
            unsigned char* UG8 = (unsigned char*)UG; const int col0 = (u.pn - 20) * BM + wc * 32 + 8 * fq;
#pragma unroll
            for (int ai = 0; ai < 2; ++ai)
#pragma unroll
                for (int m = 0; m < 4; ++m) { unsigned char* rowp = UG8 + (size_t)(row0 + ai * HALF + m * 16) * 2048 + col0;
#pragma unroll
                    for (int bj = 0; bj < 2; ++bj) { f32x4 v0 = acc[ai][bj][m][0] * rs[ai][m], v1 = acc[ai][bj][m][1] * rs[ai][m];
#pragma unroll
                        for (int j = 0; j < 4; ++j) { v0[j] = sigmoidf_(v0[j]); v1[j] = sigmoidf_(v1[j]); }
                        *(u32x2g*)(rowp + bj * HALF) = (u32x2g){pk_u8x4(v0[0], v0[1], v0[2], v0[3]), pk_u8x4(v1[0], v1[1], v1[2], v1[3])}; } }
        }
    }
};
struct EpiGate1 {
    static constexpr bool PERM = true, AFTER_DRAIN = false;
    bf16_t* O; int ldc; const unsigned char* G; int ldg;
    __device__ __forceinline__ void operator()(const f32x4 (&acc)[2][2][4][2], const Unit& u, int wr, int wc, int fr, int fq) const {
        const int row0 = u.pm * BM + wr * 64 + fr, col0 = u.pn * BM + wc * 32 + 8 * fq;
#pragma unroll
        for (int ai = 0; ai < 2; ++ai) {
            typedef unsigned u32x2g __attribute__((ext_vector_type(2))); u32x2g g[4][2];
#pragma unroll
            for (int m = 0; m < 4; ++m)
#pragma unroll
                for (int bj = 0; bj < 2; ++bj) g[m][bj] = *(const u32x2g*)(G + (size_t)(row0 + ai * HALF + m * 16) * ldg + col0 + bj * HALF);
#pragma unroll
            for (int m = 0; m < 4; ++m) { const size_t r = (size_t)(row0 + ai * HALF + m * 16);
#pragma unroll
                for (int bj = 0; bj < 2; ++bj) { const f32x4 v0 = acc[ai][bj][m][0], v1 = acc[ai][bj][m][1]; const u32x2g gg = g[m][bj];
                    u32x4 w; w.x = cvt_pk_bf16(v0[0] * ub(gg.x, 0), v0[1] * ub(gg.x, 1)); w.y = cvt_pk_bf16(v0[2] * ub(gg.x, 2), v0[3] * ub(gg.x, 3));
                    w.z = cvt_pk_bf16(v1[0] * ub(gg.y, 0), v1[1] * ub(gg.y, 1)); w.w = cvt_pk_bf16(v1[2] * ub(gg.y, 2), v1[3] * ub(gg.y, 3));
                    *(u32x4*)(O + r * ldc + col0 + bj * HALF) = w; } }
            asm volatile("" ::: "memory"); }
    }
};
struct EpiGlu {
    static constexpr bool PERM = true, AFTER_DRAIN = false;
    bf16_t* O; int ldc; const unsigned char* G; int ldg;
    __device__ __forceinline__ void operator()(const f32x4 (&acc)[2][2][4][2], const Unit& u, int wr, int wc, int fr, int fq) const {
        const int row0 = u.pm * BM + wr * 64 + fr, col0 = u.pn * HALF + wc * 32 + 8 * fq;
#pragma unroll
        for (int ai = 0; ai < 2; ++ai) {
            typedef unsigned u32x2g __attribute__((ext_vector_type(2))); u32x2g gv[4]; u32x4 tv[4];
#pragma unroll
            for (int m = 0; m < 4; ++m) { const size_t r = (size_t)(row0 + ai * HALF + m * 16); gv[m] = *(const u32x2g*)(G + r * ldg + col0); tv[m] = *(const u32x4*)(O + r * ldc + col0); }
#pragma unroll
            for (int m = 0; m < 4; ++m) { const size_t r = (size_t)(row0 + ai * HALF + m * 16); const u32x2g g = gv[m]; const u32x4 t = tv[m];
                const f32x4 a0 = acc[ai][0][m][0], a1 = acc[ai][0][m][1], b0 = acc[ai][1][m][0], b1 = acc[ai][1][m][1];
                u32x4 w;
                w.x = cvt_pk_bf16(bf_lo(t.x) + ub(g.x, 0) * a0[0] * sigmoidf_(b0[0]), bf_hi(t.x) + ub(g.x, 1) * a0[1] * sigmoidf_(b0[1]));
                w.y = cvt_pk_bf16(bf_lo(t.y) + ub(g.x, 2) * a0[2] * sigmoidf_(b0[2]), bf_hi(t.y) + ub(g.x, 3) * a0[3] * sigmoidf_(b0[3]));
                w.z = cvt_pk_bf16(bf_lo(t.z) + ub(g.y, 0) * a1[0] * sigmoidf_(b1[0]), bf_hi(t.z) + ub(g.y, 1) * a1[1] * sigmoidf_(b1[1]));
                w.w = cvt_pk_bf16(bf_lo(t.w) + ub(g.y, 2) * a1[2] * sigmoidf_(b1[2]), bf_hi(t.w) + ub(g.y, 3) * a1[3] * sigmoidf_(b1[3]));
                *(u32x4*)(O + r * ldc + col0) = w; }
            asm volatile("" ::: "memory"); }
    }
};
struct K4Order {
    StaticOrder base;
    __host__ __device__ bool next(int i, Unit& u) const { Unit b; if (!base.next(i / 3, b)) return false; const int j = i % 3;
        if (j == 0) { u.pm = b.pm; u.pn = b.pn; } else { u.pm = 64 + b.pm; u.pn = 4 + 2 * b.pn + (j - 1); } return true; }
    __device__ __forceinline__ void a_ready(const Unit&) const {}
    __device__ __forceinline__ void done(const Unit&) const {}
};
struct EpiK4 {
    static constexpr bool PERM = true, AFTER_DRAIN = false;
    EpiGate1 e1; EpiGlu e2;
    __device__ __forceinline__ void operator()(const f32x4 (&acc)[2][2][4][2], const Unit& u, int wr, int wc, int fr, int fq) const {
        if (u.pn < 4) e1(acc, u, wr, wc, fr, fq);
        else { Unit v; v.pm = u.pm - 64; v.pn = u.pn - 4; e2(acc, v, wr, wc, fr, fq); }
    }
};
struct EpiSwiglu {
    static constexpr bool PERM = true, AFTER_DRAIN = false;
    bf16_t* O; int ldc; const float* SS; const PG8_LAS float* rst; int pbase;
    __device__ __forceinline__ void operator()(const f32x4 (&acc)[2][2][4][2], const Unit& u, int wr, int wc, int fr, int fq) const {
        const int row0 = u.pm * BM + wr * 64 + fr, col0 = u.pn * HALF + wc * 32 + 8 * fq;
#pragma unroll
        for (int ai = 0; ai < 2; ++ai)
#pragma unroll
            for (int m = 0; m < 4; ++m) { const size_t r = (size_t)(row0 + ai * HALF + m * 16);
                const int rl = (int)r - pbase; const float rs = ((unsigned)rl < 2048u) ? rst[rl] : row_rstd(SS, r);
                const f32x4 a0 = acc[ai][0][m][0] * rs, a1 = acc[ai][0][m][1] * rs, b0 = acc[ai][1][m][0] * rs, b1 = acc[ai][1][m][1] * rs;
                u32x4 w;
                w.x = cvt_pk_bf16(a0[0] * sigmoidf_(a0[0]) * b0[0], a0[1] * sigmoidf_(a0[1]) * b0[1]);
                w.y = cvt_pk_bf16(a0[2] * sigmoidf_(a0[2]) * b0[2], a0[3] * sigmoidf_(a0[3]) * b0[3]);
                w.z = cvt_pk_bf16(a1[0] * sigmoidf_(a1[0]) * b1[0], a1[1] * sigmoidf_(a1[1]) * b1[1]);
                w.w = cvt_pk_bf16(a1[2] * sigmoidf_(a1[2]) * b1[2], a1[3] * sigmoidf_(a1[3]) * b1[3]);
                *(u32x4*)(O + r * ldc + col0) = w; }
    }
};
struct EpiResid {
    static constexpr bool PERM = true, AFTER_DRAIN = false;
    bf16_t* XB; float* C; int ldc; float* SS;
    __device__ __forceinline__ void operator()(const f32x4 (&acc)[2][2][4][2], const Unit& u, int wr, int wc, int fr, int fq) const {
        const int row0 = u.pm * BM + wr * 64 + fr, col0 = u.pn * BM + wc * 32 + 8 * fq;
#pragma unroll
        for (int ai = 0; ai < 2; ++ai) {
            u32x4 rv[4][2];
#pragma unroll
            for (int m = 0; m < 4; ++m)
#pragma unroll
                for (int bj = 0; bj < 2; ++bj) rv[m][bj] = *(const u32x4*)(XB + (size_t)(row0 + ai * HALF + m * 16) * ldc + col0 + bj * HALF);
#pragma unroll
            for (int m = 0; m < 4; ++m) { const int row = row0 + ai * HALF + m * 16; const size_t off = (size_t)row * ldc + col0; float ss = 0.f;
#pragma unroll
                for (int bj = 0; bj < 2; ++bj) { const u32x4 r = rv[m][bj];
                    const f32x4 o0 = acc[ai][bj][m][0] + (f32x4){bf_lo(r.x), bf_hi(r.x), bf_lo(r.y), bf_hi(r.y)}, o1 = acc[ai][bj][m][1] + (f32x4){bf_lo(r.z), bf_hi(r.z), bf_lo(r.w), bf_hi(r.w)};
                    ss += ((o0[0] * o0[0] + o0[1] * o0[1]) + (o0[2] * o0[2] + o0[3] * o0[3])) + ((o1[0] * o1[0] + o1[1] * o1[1]) + (o1[2] * o1[2] + o1[3] * o1[3]));
                    u32x4 w; w.x = cvt_pk_bf16(o0[0], o0[1]); w.y = cvt_pk_bf16(o0[2], o0[3]); w.z = cvt_pk_bf16(o1[0], o1[1]); w.w = cvt_pk_bf16(o1[2], o1[3]);
                    *(u32x4*)(XB + off + bj * HALF) = w;
                    if (C) { *(f32x4*)(C + off + bj * HALF) = o0; *(f32x4*)(C + off + bj * HALF + 4) = o1; } }
                ss += __shfl_xor(ss, 16); ss += __shfl_xor(ss, 32);
                if (fq == 0) SS[(size_t)row * 16 + u.pn * 4 + wc] = ss; }
            asm volatile("" ::: "memory"); }
    }
};

template <class Epi, class Sched, bool ALIGN_EPI = false, bool SP2 = false>
__device__ __forceinline__ void gemm_phase(PG8_LAS unsigned char* lds, const int tid, const Gemm g, const Sched& S, const Epi& E) {
    const int wid = __builtin_amdgcn_readfirstlane(tid >> 6), lane = tid & 63, wr = wid >> 2, wc = wid & 3, fr = lane & 15, fq = lane >> 4;
    const int K = g.K, nt = K / BK, lda = g.lda;
    unsigned voffA[2], voffB[2];
#pragma unroll
    for (int i = 0; i < 2; ++i) { int R, C; stage_rc(tid * 16 + i * 8192, R, C); const int Rb = Epi::PERM ? ((R & ~31) + perm32(R & 31)) : R;
        voffA[i] = (unsigned)(R * lda + C) * 2u; voffB[i] = (unsigned)(Rb * K + C) * 2u; }
    const size_t kstep = (size_t)(BK * 2);
    const size_t hA = (size_t)HALF * lda * 2, hB = (size_t)HALF * K * 2;
    const size_t tA = 2 * hA, tB = 2 * hB;
    const unsigned ldsw = (unsigned)wid * 1024u;
    const int aoff = lds_byte(wr * 64 + fr, fq * 8), boff = lds_byte(wc * 32 + fr, fq * 8);
#define PG8_SA(b, h) (((b) * 2 + (h)) * HTB)
#define PG8_SB(b, h) ((4 + (b) * 2 + (h)) * HTB)
#define PG8_STAGE(bufoff, gbase, voff) do { _Pragma("unroll") for (int _i = 0; _i < 2; ++_i) \
        __builtin_amdgcn_global_load_lds((const unsigned*)((const char*)(gbase) + (voff)[_i]), (PG8_LAS unsigned*)(lds + (bufoff) + ldsw + _i * 8192), 16, 0, 0); } while (0)
#define PG8_LDA(dst, b, h) do { _Pragma("unroll") for (int m = 0; m < 4; ++m) _Pragma("unroll") for (int k = 0; k < 2; ++k) dst[m][k] = *(const PG8_LAS bf16x8*)(lds + PG8_SA(b, h) + aoff + m * 2048 + k * 1024); } while (0)
#define PG8_LDB(dst, b, h) do { _Pragma("unroll") for (int n = 0; n < 2; ++n) _Pragma("unroll") for (int k = 0; k < 2; ++k) dst[n][k] = *(const PG8_LAS bf16x8*)(lds + PG8_SB(b, h) + boff + n * 2048 + k * 1024); } while (0)
#define PG8_MMA(ai, bj, At, Bt) do { __builtin_amdgcn_s_setprio(1); _Pragma("unroll") for (int m = 0; m < 4; ++m) _Pragma("unroll") for (int n = 0; n < 2; ++n) _Pragma("unroll") for (int k = 0; k < 2; ++k) \
        acc[ai][bj][m][n] = __builtin_amdgcn_mfma_f32_16x16x32_bf16(Bt[n][k], At[m][k], acc[ai][bj][m][n], 0, 0, 0); __builtin_amdgcn_s_setprio(0); } while (0)
#define PG8_WAIT_V(n) asm volatile("s_waitcnt vmcnt(" #n ")" ::: "memory")
#define PG8_WAIT_L(n) asm volatile("s_waitcnt lgkmcnt(" #n ")" ::: "memory")
#define PG8_BAR __builtin_amdgcn_s_barrier()
#define PG8_SCHED __builtin_amdgcn_sched_barrier(0)
    Unit cur, nxt; int ui = 0;
    if (!S.next(0, cur)) return;
    f32x4 acc[2][2][4][2];
#pragma unroll
    for (int a = 0; a < 2; ++a)
#pragma unroll
        for (int b = 0; b < 2; ++b)
#pragma unroll
            for (int m = 0; m < 4; ++m)
#pragma unroll
                for (int n = 0; n < 2; ++n) acc[a][b][m][n] = (f32x4){0.f, 0.f, 0.f, 0.f};
    bf16x8 At[4][2], B0[2][2], B1[2][2];
    const char* cA = (const char*)g.A + (size_t)cur.pm * tA; const char* cB = (const char*)g.Bt + (size_t)cur.pn * tB;
    S.a_ready(cur);
    if constexpr (SP2) {
        PG8_STAGE(PG8_SB(0, 0), cB, voffB); PG8_STAGE(PG8_SB(0, 1), cB + hB, voffB); PG8_STAGE(PG8_SA(0, 0), cA, voffA); PG8_STAGE(PG8_SA(0, 1), cA + hA, voffA);
        if (wr == 1) PG8_BAR;
        PG8_WAIT_V(2); PG8_BAR;
        PG8_STAGE(PG8_SB(1, 0), cB + kstep, voffB); PG8_STAGE(PG8_SA(1, 0), cA + kstep, voffA); PG8_STAGE(PG8_SB(1, 1), cB + hB + kstep, voffB);
        PG8_WAIT_V(6); PG8_BAR;
    } else {
        PG8_STAGE(PG8_SB(0, 0), cB, voffB); PG8_STAGE(PG8_SA(0, 0), cA, voffA); PG8_STAGE(PG8_SB(0, 1), cB + hB, voffB); PG8_STAGE(PG8_SA(0, 1), cA + hA, voffA);
        if (wr == 1) PG8_BAR;
        PG8_WAIT_V(4); PG8_BAR;
        PG8_STAGE(PG8_SB(1, 0), cB + kstep, voffB); PG8_STAGE(PG8_SA(1, 0), cA + kstep, voffA); PG8_STAGE(PG8_SB(1, 1), cB + hB + kstep, voffB);
        PG8_WAIT_V(6); PG8_BAR;
    }
    for (;;) {
        const bool has_next = S.next(ui + 1, nxt);
        const char* nA = has_next ? (const char*)g.A + (size_t)nxt.pm * tA : cA; const char* nB = has_next ? (const char*)g.Bt + (size_t)nxt.pn * tB : cB;
        for (int t = 0; t < nt; t += 2) {
            const bool last = (t == nt - 2);
            const char* a1 = cA + (size_t)(t + 1) * kstep;
            const char* a2 = last ? nA : cA + (size_t)(t + 2) * kstep; const char* b2 = last ? nB : cB + (size_t)(t + 2) * kstep;
            const char* a3 = a2 + kstep; const char* b3 = b2 + kstep;
            if (last && has_next) S.a_ready(nxt);
            if constexpr (SP2) {
            PG8_LDB(B0, 0, 0); PG8_LDB(B1, 0, 1); PG8_SCHED; PG8_LDA(At, 0, 0); PG8_STAGE(PG8_SA(1, 1), a1 + hA, voffA);
            PG8_WAIT_V(8); PG8_WAIT_L(0); PG8_BAR; PG8_MMA(0, 0, At, B0); PG8_MMA(0, 1, At, B1); PG8_BAR; PG8_SCHED;
            PG8_LDA(At, 0, 1); PG8_STAGE(PG8_SB(0, 0), b2, voffB); PG8_STAGE(PG8_SB(0, 1), b2 + hB, voffB); PG8_STAGE(PG8_SA(0, 0), a2, voffA);
            PG8_WAIT_V(8); PG8_WAIT_L(0); PG8_BAR; PG8_MMA(1, 0, At, B0); PG8_MMA(1, 1, At, B1); PG8_BAR; PG8_SCHED;
            PG8_LDB(B0, 1, 0); PG8_LDB(B1, 1, 1); PG8_SCHED; PG8_LDA(At, 1, 0); PG8_STAGE(PG8_SA(0, 1), a2 + hA, voffA);
            PG8_WAIT_V(8); PG8_WAIT_L(0); PG8_BAR; PG8_MMA(0, 0, At, B0); PG8_MMA(0, 1, At, B1); PG8_BAR; PG8_SCHED;
            PG8_LDA(At, 1, 1); PG8_STAGE(PG8_SB(1, 0), b3, voffB); PG8_STAGE(PG8_SB(1, 1), b3 + hB, voffB); PG8_STAGE(PG8_SA(1, 0), a3, voffA);
            PG8_WAIT_V(8); PG8_WAIT_L(0); PG8_BAR; PG8_MMA(1, 0, At, B0); PG8_MMA(1, 1, At, B1); PG8_BAR; PG8_SCHED;
            } else {
            PG8_LDB(B0, 0, 0); PG8_SCHED; PG8_LDA(At, 0, 0); PG8_STAGE(PG8_SA(1, 1), a1 + hA, voffA);
            PG8_WAIT_L(8); PG8_BAR; PG8_WAIT_L(0); PG8_MMA(0, 0, At, B0); PG8_BAR; PG8_SCHED;
            PG8_LDB(B1, 0, 1); PG8_STAGE(PG8_SB(0, 0), b2, voffB);
            PG8_BAR; PG8_WAIT_L(0); PG8_MMA(0, 1, At, B1); PG8_BAR;
            PG8_LDA(At, 0, 1); PG8_STAGE(PG8_SA(0, 0), a2, voffA);
            PG8_BAR; PG8_WAIT_L(0); PG8_MMA(1, 0, At, B0); PG8_BAR; PG8_SCHED;
            PG8_STAGE(PG8_SB(0, 1), b2 + hB, voffB);
            PG8_WAIT_V(6); PG8_BAR; PG8_MMA(1, 1, At, B1); PG8_BAR;
            PG8_LDB(B0, 1, 0); PG8_SCHED; PG8_LDA(At, 1, 0); PG8_STAGE(PG8_SA(0, 1), a2 + hA, voffA);
            PG8_WAIT_L(8); PG8_BAR; PG8_WAIT_L(0); PG8_MMA(0, 0, At, B0); PG8_BAR; PG8_SCHED;
            PG8_LDB(B1, 1, 1); PG8_STAGE(PG8_SB(1, 0), b3, voffB);
            PG8_BAR; PG8_WAIT_L(0); PG8_MMA(0, 1, At, B1); PG8_BAR;
            PG8_LDA(At, 1, 1); PG8_STAGE(PG8_SA(1, 0), a3, voffA);
            PG8_BAR; PG8_WAIT_L(0); PG8_MMA(1, 0, At, B0); PG8_BAR; PG8_SCHED;
            PG8_STAGE(PG8_SB(1, 1), b3 + hB, voffB);
            PG8_WAIT_V(6); PG8_BAR; PG8_MMA(1, 1, At, B1); PG8_BAR;
            }
        }
        if constexpr (ALIGN_EPI) { if (wr == 0) PG8_BAR; }
        if constexpr (!Epi::AFTER_DRAIN) { E(acc, cur, wr, wc, fr, fq); S.done(cur); }
        if (!has_next) break;
#pragma unroll
        for (int a = 0; a < 2; ++a)
#pragma unroll
            for (int b = 0; b < 2; ++b)
#pragma unroll
                for (int m = 0; m < 4; ++m)
#pragma unroll
                    for (int n = 0; n < 2; ++n) acc[a][b][m][n] = (f32x4){0.f, 0.f, 0.f, 0.f};
        cur = nxt; cA = nA; cB = nB; ++ui;
        if constexpr (ALIGN_EPI) { if (wr == 1) PG8_BAR; }
    }
    PG8_WAIT_V(0);
    if constexpr (!ALIGN_EPI) { if (wr == 0) PG8_BAR; }
    PG8_BAR;
#undef PG8_SA
#undef PG8_SB
#undef PG8_STAGE
#undef PG8_LDA
#undef PG8_LDB
#undef PG8_MMA
#undef PG8_WAIT_V
#undef PG8_WAIT_L
#undef PG8_BAR
#undef PG8_SCHED
}
}

typedef unsigned short bf16;
typedef short bf16x8 __attribute__((ext_vector_type(8)));
typedef float f32x4 __attribute__((ext_vector_type(4)));
typedef unsigned u32x4 __attribute__((ext_vector_type(4)));
typedef unsigned u32x2 __attribute__((ext_vector_type(2)));
#define LAS __attribute__((address_space(3)))

constexpr int NWAVES = 8, NTHR = 512;
constexpr int DM = 1024, SEQ = 8192, MTOK = 16384, DEPTH = 4;
constexpr int INC = 7168, DFF = 2816, AW = 512;
constexpr int COL_Q = 0, COL_K = 1536, COL_V = 3072, COL_U = 4608, COL_GA = 5120, COL_GS = 6144;
constexpr int UGP = 2048;
constexpr int TC = 32, NCH = MTOK / TC  , CHB = SEQ / TC  ;
constexpr float EPS = 1e-6f;

constexpr size_t OFF_IN = 0, OFF_P = 7340032, OFF_GLU = 7864320, OFF_OUT = 8912896, OFF_GU = 9961472, OFF_DN = 15728640, LAYER_W = 18612224;
constexpr size_t MiB = 1u << 20;
constexpr size_t WS_SS1 = 65536, WS_SS2 = 131072;
constexpr size_t WS_WB = 1 * MiB, WS_Z = 143 * MiB, WS_ACT = 367 * MiB, WS_Y = 399 * MiB, WS_LSE = 415 * MiB, WS_TAB = 417 * MiB, TAB_STRIDE = 9 * MiB,
                 WS_S = 435 * MiB, WS_XP = 443 * MiB, WS_END = 447 * MiB;
constexpr size_t TB_KT = 0, TB_AT = 768 * 1024, TB_E = 1 * MiB, TB_P = 5 * MiB;
static_assert(WS_WB + 4 * LAYER_W * 2 <= WS_Z && WS_Z + (size_t)MTOK * INC * 2 <= WS_ACT, "ws map");
constexpr int LDS_BYTES = 147456;

struct Args { const float* in[21]; float* out; unsigned char* ws; int ph_lo, ph_hi; };

__device__ __forceinline__ unsigned f2bf(float f) { unsigned u = __float_as_uint(f); return (u + 0x7fffu + ((u >> 16) & 1u)) >> 16; }
__device__ __forceinline__ unsigned pk2(float lo, float hi) { return pg8::cvt_pk_bf16(lo, hi); }
__device__ __forceinline__ float bflo(unsigned w) { return __uint_as_float(w << 16); }
__device__ __forceinline__ float bfhi(unsigned w) { return __uint_as_float(w & 0xffff0000u); }
__device__ __forceinline__ float wave_sum(float v) {
#pragma unroll
    for (int o = 1; o < 64; o <<= 1) v += __shfl_xor(v, o);
    return v;
}

__device__ __forceinline__ void transpose_item(const float* W, int K, int N, bf16* WT, int il_off, float* scr, int item, int lane, const float* gk = nullptr) {
    const int nblk = N / 64, kb = item / nblk, nb = item % nblk, k0 = 64 * kb, n0 = 64 * nb;
    const float* src = W + (size_t)k0 * N + n0 + lane;
#pragma unroll 16
    for (int i = 0; i < 64; ++i) scr[i * 65 + lane] = src[(size_t)i * N];
    const int drow = (il_off < 0) ? n0 : (n0 / 128) * 256 + il_off + (n0 % 128);
    const int c = lane & 7, nn = lane >> 3;
    f32x4 g0 = (f32x4){1.f, 1.f, 1.f, 1.f}, g1 = g0;
    if (gk) { g0 = *(const f32x4*)(gk + k0 + 8 * c); g1 = *(const f32x4*)(gk + k0 + 8 * c + 4); }
#pragma unroll
    for (int j = 0; j < 8; ++j) { const int n = nn + 8 * j; const float* p = scr + (8 * c) * 65 + n;
        u32x4 o; o.x = pk2(p[0 * 65] * g0.x, p[1 * 65] * g0.y); o.y = pk2(p[2 * 65] * g0.z, p[3 * 65] * g0.w); o.z = pk2(p[4 * 65] * g1.x, p[5 * 65] * g1.y); o.w = pk2(p[6 * 65] * g1.z, p[7 * 65] * g1.w);
        *(u32x4*)(WT + (size_t)(drow + n) * K + k0 + 8 * c) = o; }
}
__device__ __forceinline__ void phase_weights(const Args& a, int zero, bf16* WB, float* ldsf, int gw, int ngw, int wave, int lane, int l0 = 0, int l1 = DEPTH) {
    float* scr = ldsf + wave * 4352;
    constexpr int PER_LAYER = 4544;
    for (int it = l0 * PER_LAYER + gw; it < l1 * PER_LAYER; it += ngw) {
        const int l = it / PER_LAYER; int r = it % PER_LAYER; bf16* wl = WB + (size_t)l * LAYER_W;
        if (r < 1792) { transpose_item(a.in[2 + zero] + (size_t)l * DM * INC, DM, INC, wl + OFF_IN, -1, scr, r, lane, a.in[1 + zero] + l * DM); continue; } r -= 1792;
        if (r < 128) { transpose_item(a.in[5 + zero] + (size_t)l * AW * DM, AW, DM, wl + OFF_P, -1, scr, r, lane); continue; } r -= 128;
        if (r < 128) { transpose_item(a.in[14 + zero] + (size_t)l * AW * DM, AW, DM, wl + OFF_GLU, 0, scr, r, lane); continue; } r -= 128;
        if (r < 128) { transpose_item(a.in[15 + zero] + (size_t)l * AW * DM, AW, DM, wl + OFF_GLU, 128, scr, r, lane); continue; } r -= 128;
        if (r < 256) { transpose_item(a.in[16 + zero] + (size_t)l * DM * DM, DM, DM, wl + OFF_OUT, -1, scr, r, lane); continue; } r -= 256;
        if (r < 704) { transpose_item(a.in[18 + zero] + (size_t)l * DM * DFF, DM, DFF, wl + OFF_GU, 0, scr, r, lane, a.in[17 + zero] + l * DM); continue; } r -= 704;
        if (r < 704) { transpose_item(a.in[19 + zero] + (size_t)l * DM * DFF, DM, DFF, wl + OFF_GU, 128, scr, r, lane, a.in[17 + zero] + l * DM); continue; } r -= 704;
        transpose_item(a.in[20 + zero] + (size_t)l * DFF * DM, DFF, DM, wl + OFF_DN, -1, scr, r, lane);
    }
}

__device__ __forceinline__ void phase_xprep(const float* x, bf16* out, float* SS, int gw, int ngw, int lane) {
    for (int m = gw; m < MTOK; m += ngw) {
        const f32x4* xr = (const f32x4*)(x + (size_t)m * DM) + lane;
        f32x4 v[4]; float s = 0.f;
#pragma unroll
        for (int j = 0; j < 4; ++j) { v[j] = xr[64 * j]; s += (v[j].x * v[j].x + v[j].y * v[j].y) + (v[j].z * v[j].z + v[j].w * v[j].w); }
        s = wave_sum(s);
        u32x2* o8 = (u32x2*)(out + (size_t)m * DM) + lane;
#pragma unroll
        for (int j = 0; j < 4; ++j) { u32x2 w; w.x = pk2(v[j].x, v[j].y); w.y = pk2(v[j].z, v[j].w); o8[64 * j] = w; }
        if (lane < 16) SS[(size_t)m * 16 + lane] = (lane == 0) ? s : 0.f;
    }
}

__device__ __forceinline__ void ssm_pre_item(const Args& a, int zero, int l, int g, unsigned char* tab, float* L, int tid) {
    float* pw = L; float* bb = L + 4224; float* cc = L + 6272; float* cc2 = L + 8320;
    const float* lam_re = a.in[6 + zero] + (size_t)(l * 32 + g) * 64; const float* lam_im = a.in[7 + zero] + (size_t)(l * 32 + g) * 64;
    const float* b_re = a.in[9 + zero] + (size_t)(l * 32 + g) * 1024; const float* b_im = a.in[10 + zero] + (size_t)(l * 32 + g) * 1024;
    const float* c_re = a.in[11 + zero] + (size_t)(l * 32 + g) * 1024; const float* c_im = a.in[12 + zero] + (size_t)(l * 32 + g) * 1024;
    const float ldt = a.in[8 + zero][l * 32 + g];
    const double INV_2PI = 0.15915494309189533577, TWO_PI = 6.283185307179586476925;
    float brv[2], biv[2], crv[2], civ[2], lrv[5], liv[5];
#pragma unroll
    for (int q = 0; q < 2; ++q) { const int i = tid + NTHR * q; brv[q] = b_re[i]; biv[q] = b_im[i]; crv[q] = c_re[i]; civ[q] = c_im[i]; }
#pragma unroll
    for (int q = 0; q < 5; ++q) { const int i = tid + NTHR * q, p = i & 63; lrv[q] = lam_re[p]; liv[q] = lam_im[p]; }
    const float dt = expf(ldt);
#pragma unroll
    for (int q = 0; q < 2; ++q) { const int i = tid + NTHR * q, p = i >> 4; const float lr = lam_re[p], li = lam_im[p];
        const double angle = (double)li * (double)dt; const double rr = angle - TWO_PI * rint(angle * INV_2PI);
        float sn, cs; sincosf((float)rr, &sn, &cs); const float mag = expf(lr * dt);
        const float nr = mag * cs - 1.0f, ni = mag * sn, den = lr * lr + li * li;
        const float cr = (nr * lr + ni * li) / den, ci = (ni * lr - nr * li) / den;
        bb[i * 2] = cr * brv[q] - ci * biv[q]; bb[i * 2 + 1] = cr * biv[q] + ci * brv[q];
        cc[i * 2] = crv[q]; cc[i * 2 + 1] = civ[q]; { const int cI = i >> 6, pI = i & 63; cc2[(pI * 16 + cI) * 2] = crv[q]; cc2[(pI * 16 + cI) * 2 + 1] = civ[q]; } }
#pragma unroll
    for (int q = 0; q < 5; ++q) { const int i = tid + NTHR * q; if (i < 33 * 64) { const int j = i >> 6;
        const double angle = (double)liv[q] * (double)dt * (double)j; const double rr = angle - TWO_PI * rint(angle * INV_2PI);
        float sn, cs; sincosf((float)rr, &sn, &cs); const float mag = expf(lrv[q] * dt * (float)j);
        pw[i * 2] = mag * cs; pw[i * 2 + 1] = mag * sn; } }
    __syncthreads();
    bf16* KT = (bf16*)(tab + TB_KT) + (size_t)g * 32 * 256; bf16* E = (bf16*)(tab + TB_E) + (size_t)g * 128 * 512; bf16* P = (bf16*)(tab + TB_P) + (size_t)g * 512 * 128;
    float* AT = (float*)(tab + TB_AT) + g * 128;
    { const int j = tid >> 4, c = tid & 15; float acc16[16];
#pragma unroll
      for (int q = 0; q < 16; ++q) acc16[q] = 0.f;
      for (int p = 0; p < 64; ++p) { const float Cr = cc2[(p * 16 + c) * 2], Ci = cc2[(p * 16 + c) * 2 + 1], wr_ = pw[(j * 64 + p) * 2], wi_ = pw[(j * 64 + p) * 2 + 1];
          const float tr = Cr * wr_ - Ci * wi_, ti = Cr * wi_ + Ci * wr_; const f32x4* b4 = (const f32x4*)(bb + p * 32);
#pragma unroll
          for (int q = 0; q < 8; ++q) { const f32x4 bv = b4[q]; acc16[2 * q] += tr * bv.x - ti * bv.y; acc16[2 * q + 1] += tr * bv.z - ti * bv.w; } }
      u32x4 o0, o1; o0.x = pk2(acc16[0], acc16[1]); o0.y = pk2(acc16[2], acc16[3]); o0.z = pk2(acc16[4], acc16[5]); o0.w = pk2(acc16[6], acc16[7]);
      o1.x = pk2(acc16[8], acc16[9]); o1.y = pk2(acc16[10], acc16[11]); o1.z = pk2(acc16[12], acc16[13]); o1.w = pk2(acc16[14], acc16[15]);
      *(u32x4*)(KT + (size_t)tid * 16) = o0; *(u32x4*)(KT + (size_t)tid * 16 + 8) = o1; }
    for (int i8 = tid; i8 < 128 * 64; i8 += NTHR) { const int row = i8 >> 6, k8 = i8 & 63, p = row & 63, s_ = k8 >> 1, c0 = (k8 & 1) * 8, j = 31 - s_;
        const float wr_ = pw[(j * 64 + p) * 2], wi_ = pw[(j * 64 + p) * 2 + 1]; const f32x4* b4 = (const f32x4*)(bb + (p * 16 + c0) * 2); float v[8];
#pragma unroll
        for (int q = 0; q < 4; ++q) { const f32x4 bv = b4[q];
            v[2 * q] = (row < 64) ? (wr_ * bv.x - wi_ * bv.y) : (wr_ * bv.y + wi_ * bv.x); v[2 * q + 1] = (row < 64) ? (wr_ * bv.z - wi_ * bv.w) : (wr_ * bv.w + wi_ * bv.z); }
        u32x4 o; o.x = pk2(v[0], v[1]); o.y = pk2(v[2], v[3]); o.z = pk2(v[4], v[5]); o.w = pk2(v[6], v[7]);
        *(u32x4*)(E + (size_t)i8 * 8) = o; }
    for (int i8 = tid; i8 < 512 * 16; i8 += NTHR) { const int row = i8 >> 4, q0 = (i8 & 15) * 8, p0 = q0 & 63, t = row >> 4, c = row & 15, j = t + 1;
        const f32x4* c4 = (const f32x4*)(cc + (c * 64 + p0) * 2); const f32x4* w4 = (const f32x4*)(pw + (j * 64 + p0) * 2); float v[8];
#pragma unroll
        for (int q = 0; q < 4; ++q) { const f32x4 cv = c4[q], wv = w4[q];
            v[2 * q] = (q0 < 64) ? (cv.x * wv.x - cv.y * wv.y) : -(cv.x * wv.y + cv.y * wv.x); v[2 * q + 1] = (q0 < 64) ? (cv.z * wv.z - cv.w * wv.w) : -(cv.z * wv.w + cv.w * wv.z); }
        u32x4 o; o.x = pk2(v[0], v[1]); o.y = pk2(v[2], v[3]); o.z = pk2(v[4], v[5]); o.w = pk2(v[6], v[7]);
        *(u32x4*)(P + (size_t)i8 * 8) = o; }
    if (tid < 64) { AT[tid] = pw[(32 * 64 + tid) * 2]; AT[64 + tid] = pw[(32 * 64 + tid) * 2 + 1]; }
    __syncthreads();
}

constexpr int QP = 72, VP = 400;
constexpr int LK_OFF = 0, LV_OFF = 384 * QP * 2;
constexpr size_t QPLANE = (size_t)2 * 3 * 8 * 8192 * 64;
struct AttnItem { int n0; size_t qrow0; };
__device__ __forceinline__ AttnItem attn_decode(int sit) {
    AttnItem A; int it = sit; const int rn2 = it & 31; it >>= 5; const int h = it & 7; it >>= 3; const int gi = it % 3, b = it / 3;
    const int dsh = 2 * gi, psh = 5 - dsh;
    const int r = rn2 >> psh; A.n0 = 2 * (rn2 & ((1 << psh) - 1));
    A.qrow0 = ((size_t)(b * 3 + gi) * 8 + h) * 8192 + (size_t)r * (8192 >> dsh) + 128 * A.n0;
    return A;
}
__device__ __forceinline__ void attn_load(const AttnItem& A, const bf16* QH, int tid, u32x4 (&kv)[6], u32x4 (&vv)[6]) {
    const bf16* kp = QH + QPLANE + (A.qrow0 - 128) * 64 + tid * 8;
#pragma unroll
    for (int rd = 0; rd < 6; ++rd) {
        if (A.n0 > 0 || rd >= 2) { kv[rd] = *(const u32x4*)(kp + rd * 4096); vv[rd] = *(const u32x4*)(kp + QPLANE + rd * 4096); }
        else { kv[rd] = (u32x4){0u, 0u, 0u, 0u}; vv[rd] = (u32x4){0u, 0u, 0u, 0u}; } }
}
__device__ __forceinline__ void attn_stage(const float* gk, unsigned char* lds, int tid, const u32x4 (&kv)[6], const u32x4 (&vv)[6]) {
    asm volatile("" : "+v"(tid));
    bf16* Ks = (bf16*)(lds + LK_OFF); bf16* Vt = (bf16*)(lds + LV_OFF);
    const int chunk = tid & 7, rowi = tid >> 3;
    float gkv[8];
#pragma unroll
    for (int i = 0; i < 8; ++i) gkv[i] = gk[chunk * 8 + i];
#pragma unroll
    for (int rd = 0; rd < 6; ++rd) { float f[8]; f[0] = bflo(kv[rd].x); f[1] = bfhi(kv[rd].x); f[2] = bflo(kv[rd].y); f[3] = bfhi(kv[rd].y); f[4] = bflo(kv[rd].z); f[5] = bfhi(kv[rd].z); f[6] = bflo(kv[rd].w); f[7] = bfhi(kv[rd].w);
        float ss = 0.f;
#pragma unroll
        for (int i = 0; i < 8; ++i) ss += f[i] * f[i];
        ss += __shfl_xor(ss, 1); ss += __shfl_xor(ss, 2); ss += __shfl_xor(ss, 4);
        const float rs = rsqrtf(ss * (1.f / 64.f) + EPS);
        u32x4 w; w.x = pk2(f[0] * rs * gkv[0], f[1] * rs * gkv[1]); w.y = pk2(f[2] * rs * gkv[2], f[3] * rs * gkv[3]); w.z = pk2(f[4] * rs * gkv[4], f[5] * rs * gkv[5]); w.w = pk2(f[6] * rs * gkv[6], f[7] * rs * gkv[7]);
        const int ki = rowi + 64 * rd;
        *(u32x4*)(Ks + ki * QP + chunk * 8) = w;
        bf16* vp = Vt + (chunk * 8) * VP + (ki ^ (chunk << 2));
        vp[0 * VP] = (bf16)(vv[rd].x & 0xffffu); vp[1 * VP] = (bf16)(vv[rd].x >> 16); vp[2 * VP] = (bf16)(vv[rd].y & 0xffffu); vp[3 * VP] = (bf16)(vv[rd].y >> 16);
        vp[4 * VP] = (bf16)(vv[rd].z & 0xffffu); vp[5 * VP] = (bf16)(vv[rd].z >> 16); vp[6 * VP] = (bf16)(vv[rd].w & 0xffffu); vp[7 * VP] = (bf16)(vv[rd].w >> 16); }
}
__device__ __forceinline__ void attn_qload(const AttnItem& A, const bf16* QH, int tid, u32x4 (&qr)[4]) {
    const int w = tid >> 6, lane = tid & 63, fr = lane & 15, fq = lane >> 4;
#pragma unroll
    for (int m2 = 0; m2 < 2; ++m2) { const bf16* p = QH + (A.qrow0 + 32 * w + 16 * m2 + fr) * 64 + 8 * fq; qr[2 * m2] = *(const u32x4*)p; qr[2 * m2 + 1] = *(const u32x4*)(p + 32); }
}
__device__ __forceinline__ void attn_tile2(const AttnItem& A, const u32x4 (&qr)[4], const float* gq, bf16* QH, float* LSE, unsigned char* lds, int tid) {
    asm volatile("" : "+v"(tid));
    const bf16* Ks = (const bf16*)(lds + LK_OFF); const bf16* Vt = (const bf16*)(lds + LV_OFF);
    const int w = tid >> 6, lane = tid & 63, fr = lane & 15, fq = lane >> 4;
    const int kt0 = (2 * w < 14) ? 2 * w : 14;
    bf16x8 qf[2][2];
    { const f32x4 g0 = *(const f32x4*)(gq + 8 * fq), g1 = *(const f32x4*)(gq + 8 * fq + 4), g2 = *(const f32x4*)(gq + 32 + 8 * fq), g3 = *(const f32x4*)(gq + 32 + 8 * fq + 4);
#pragma unroll
      for (int m = 0; m < 2; ++m) { const u32x4 q0 = qr[2 * m], q1 = qr[2 * m + 1];
        float f[16]; f[0] = bflo(q0.x); f[1] = bfhi(q0.x); f[2] = bflo(q0.y); f[3] = bfhi(q0.y); f[4] = bflo(q0.z); f[5] = bfhi(q0.z); f[6] = bflo(q0.w); f[7] = bfhi(q0.w);
        f[8] = bflo(q1.x); f[9] = bfhi(q1.x); f[10] = bflo(q1.y); f[11] = bfhi(q1.y); f[12] = bflo(q1.z); f[13] = bfhi(q1.z); f[14] = bflo(q1.w); f[15] = bfhi(q1.w);
        float ss = 0.f;
#pragma unroll
        for (int i = 0; i < 16; ++i) ss += f[i] * f[i];
        ss += __shfl_xor(ss, 16); ss += __shfl_xor(ss, 32);
        const float rs = rsqrtf(ss * (1.f / 64.f) + EPS) * 0.125f;
        u32x4 a, c;
        a.x = pk2(f[0] * rs * g0.x, f[1] * rs * g0.y); a.y = pk2(f[2] * rs * g0.z, f[3] * rs * g0.w); a.z = pk2(f[4] * rs * g1.x, f[5] * rs * g1.y); a.w = pk2(f[6] * rs * g1.z, f[7] * rs * g1.w);
        c.x = pk2(f[8] * rs * g2.x, f[9] * rs * g2.y); c.y = pk2(f[10] * rs * g2.z, f[11] * rs * g2.w); c.z = pk2(f[12] * rs * g3.x, f[13] * rs * g3.y); c.w = pk2(f[14] * rs * g3.z, f[15] * rs * g3.w);
        qf[m][0] = __builtin_bit_cast(bf16x8, a); qf[m][1] = __builtin_bit_cast(bf16x8, c); } }
    f32x4 s[2][10];
#pragma unroll
    for (int m = 0; m < 2; ++m)
#pragma unroll
        for (int t = 0; t < 10; ++t) s[m][t] = (f32x4){0.f, 0.f, 0.f, 0.f};
    {
        bf16x8 kf[2][4];
        const bf16* kb0 = Ks + (16 * kt0 + fr) * QP + 8 * fq;
#define ATT_LDK(pr, sl) do { _Pragma("unroll") for (int tt = 0; tt < 2; ++tt) _Pragma("unroll") for (int kk = 0; kk < 2; ++kk) kf[sl][tt * 2 + kk] = *(const bf16x8*)(kb0 + (16 * (2 * (pr) + tt)) * QP + 32 * kk); } while (0)
        ATT_LDK(0, 0);
#pragma unroll
        for (int pr = 0; pr < 5; ++pr) {
            if (pr + 1 < 5) ATT_LDK(pr + 1, (pr + 1) & 1);
            __builtin_amdgcn_sched_barrier(0);
#pragma unroll
            for (int tt = 0; tt < 2; ++tt)
#pragma unroll
                for (int kk = 0; kk < 2; ++kk)
#pragma unroll
                    for (int m = 0; m < 2; ++m) s[m][2 * pr + tt] = __builtin_amdgcn_mfma_f32_16x16x32_bf16(kf[pr & 1][tt * 2 + kk], qf[m][kk], s[m][2 * pr + tt], 0, 0, 0);
            __builtin_amdgcn_sched_barrier(0);
        }
#undef ATT_LDK
    }
    float mx[2], sum[2];
#pragma unroll
    for (int m = 0; m < 2; ++m) {
        const int qi = 32 * w + 16 * m + fr;
        const int dbase = 16 * kt0 + 4 * fq - qi, kbase = 16 * kt0 + 4 * fq - ((A.n0 > 0) ? 0 : 128);
        float mxv = -INFINITY;
#pragma unroll
        for (int t = 0; t < 10; ++t)
#pragma unroll
            for (int j = 0; j < 4; ++j) { const int dlt = dbase + 16 * t + j; const int bad = (dlt | (128 - dlt) | (kbase + 16 * t + j)) >> 31;
                s[m][t][j] += __int_as_float(bad & (int)0xff800000); mxv = fmaxf(mxv, s[m][t][j]); }
        mx[m] = mxv; }
#pragma unroll
    for (int m = 0; m < 2; ++m) { mx[m] = fmaxf(mx[m], __shfl_xor(mx[m], 16)); mx[m] = fmaxf(mx[m], __shfl_xor(mx[m], 32)); }
#pragma unroll
    for (int m = 0; m < 2; ++m) { float sm = 0.f;
#pragma unroll
        for (int t = 0; t < 10; ++t)
#pragma unroll
            for (int j = 0; j < 4; ++j) { const float p = __builtin_amdgcn_exp2f((s[m][t][j] - mx[m]) * 1.44269504089f); s[m][t][j] = p; sm += p; }
        sum[m] = sm; }
#pragma unroll
    for (int m = 0; m < 2; ++m) { sum[m] += __shfl_xor(sum[m], 16); sum[m] += __shfl_xor(sum[m], 32); }
    f32x4 o[2][4];
#pragma unroll
    for (int m = 0; m < 2; ++m)
#pragma unroll
        for (int dt = 0; dt < 4; ++dt) o[m][dt] = (f32x4){0.f, 0.f, 0.f, 0.f};
    {
        u32x4 vf[2][4];
#define ATT_LDV(jj_, sl) do { _Pragma("unroll") for (int dt = 0; dt < 4; ++dt) { const int dd = 16 * dt + fr, sw = ((dd >> 3) & 7) << 2, kb = 32 * (kt0 / 2 + (jj_)) + 4 * fq; const bf16* vr = Vt + dd * VP; \
            const u32x2 lo = *(const u32x2*)(vr + (kb ^ sw)), hi = *(const u32x2*)(vr + ((kb + 16) ^ sw)); vf[sl][dt] = (u32x4){lo.x, lo.y, hi.x, hi.y}; } } while (0)
        ATT_LDV(0, 0);
#pragma unroll
        for (int jj = 0; jj < 5; ++jj) {
            if (jj + 1 < 5) ATT_LDV(jj + 1, (jj + 1) & 1);
            bf16x8 pf[2];
#pragma unroll
            for (int m = 0; m < 2; ++m) { u32x4 pw; pw.x = pk2(s[m][2 * jj][0], s[m][2 * jj][1]); pw.y = pk2(s[m][2 * jj][2], s[m][2 * jj][3]); pw.z = pk2(s[m][2 * jj + 1][0], s[m][2 * jj + 1][1]); pw.w = pk2(s[m][2 * jj + 1][2], s[m][2 * jj + 1][3]);
                pf[m] = __builtin_bit_cast(bf16x8, pw); }
            __builtin_amdgcn_sched_barrier(0);
#pragma unroll
            for (int dt = 0; dt < 4; ++dt)
#pragma unroll
                for (int m = 0; m < 2; ++m) o[m][dt] = __builtin_amdgcn_mfma_f32_16x16x32_bf16(__builtin_bit_cast(bf16x8, vf[jj & 1][dt]), pf[m], o[m][dt], 0, 0, 0);
            __builtin_amdgcn_sched_barrier(0);
        }
#undef ATT_LDV
    }
#pragma unroll
    for (int m = 0; m < 2; ++m) {
        const float inv = 1.0f / sum[m];
        const size_t prow = A.qrow0 + 32 * w + 16 * m + fr;
        bf16* op = QH + prow * 64 + 4 * fq;
#pragma unroll
        for (int dt = 0; dt < 4; ++dt) { u32x2 w2; w2.x = pk2(o[m][dt][0] * inv, o[m][dt][1] * inv); w2.y = pk2(o[m][dt][2] * inv, o[m][dt][3] * inv); *(u32x2*)(op + 16 * dt) = w2; }
        if (fq == 0) LSE[prow] = mx[m] + logf(sum[m]);
    }
}

constexpr int ULP = 520;
__device__ __forceinline__ void ssm_stage_u(const bf16* UH, int g, int mt, unsigned char* lds, int tid) {
    const bf16* src = UH + ((size_t)g * 16384 + (size_t)mt * 2048) * 16;
    u32x4 v[8];
#pragma unroll
    for (int k = 0; k < 8; ++k) v[k] = *(const u32x4*)(src + (size_t)(tid + NTHR * k) * 8);
#pragma unroll
    for (int k = 0; k < 8; ++k) { const int i = tid + NTHR * k; *(u32x4*)(lds + (i >> 6) * (ULP * 2) + (i & 63) * 16) = v[k]; }
}
__device__ __forceinline__ void ssm_s1_item(int item, const bf16* UH, unsigned char* ws, const unsigned char* tab, unsigned char* lds, int tid) {
    const int g = item >> 3, mt = item & 7, w = tid >> 6, lane = tid & 63, fr = lane & 15, fq = lane >> 4;
    const bf16* E = (const bf16*)(tab + TB_E) + (size_t)g * 128 * 512; float* S = (float*)(ws + WS_S);
    const bf16* ep = E + (size_t)(16 * w + fr) * 512 + 8 * fq;
    bf16x8 ef[16];
#pragma unroll
    for (int ks = 0; ks < 16; ++ks) ef[ks] = *(const bf16x8*)(ep + 32 * ks);
    ssm_stage_u(UH, g, mt, lds, tid);
    __syncthreads();
    const bf16* UL = (const bf16*)lds;
    f32x4 acc[4];
#pragma unroll
    for (int mi = 0; mi < 4; ++mi) acc[mi] = (f32x4){0.f, 0.f, 0.f, 0.f};
#pragma unroll
    for (int ks = 0; ks < 16; ++ks)
#pragma unroll
        for (int mi = 0; mi < 4; ++mi) { const bf16x8 uf = *(const bf16x8*)(UL + (16 * mi + fr) * ULP + (2 * ks + (fq >> 1)) * 16 + 8 * (fq & 1)); acc[mi] = __builtin_amdgcn_mfma_f32_16x16x32_bf16(ef[ks], uf, acc[mi], 0, 0, 0); }
#pragma unroll
    for (int mi = 0; mi < 4; ++mi) *(f32x4*)(S + ((size_t)(64 * mt + 16 * mi + fr) * 32 + g) * 128 + 16 * w + 4 * fq) = acc[mi];
    __syncthreads();
}

__device__ __forceinline__ void ssm_carry_item(int item, unsigned char* ws, const unsigned char* tab, float* L, int tid) {
    const int b = item >> 5, g = item & 31;
    const float* S = (const float*)(ws + WS_S); bf16* XP = (bf16*)(ws + WS_XP); const float* AT = (const float*)(tab + TB_AT) + g * 128;
#pragma unroll 4
    for (int i = 0; i < 16; ++i) { const int idx = i * NTHR + tid, k = idx >> 5, q4 = idx & 31;
        *(f32x4*)(L + k * 128 + 4 * q4) = *(const f32x4*)(S + ((size_t)(b * CHB + k) * 32 + g) * 128 + 4 * q4); }
    __syncthreads();
    const int w = tid >> 6, p = tid & 63; float* EB = L + 32768 + 8;
    const float ar = AT[p], ai = AT[64 + p];
    { float xr = 0.f, xi = 0.f;
#pragma unroll 8
      for (int j = 0; j < 32; ++j) { const int k = 32 * w + j; const float sr = L[k * 128 + p], si = L[k * 128 + 64 + p];
          L[k * 128 + p] = xr; L[k * 128 + 64 + p] = xi;
          const float nr = ar * xr - ai * xi + sr, ni = ar * xi + ai * xr + si; xr = nr; xi = ni; }
      EB[w * 128 + p] = xr; EB[w * 128 + 64 + p] = xi; }
    __syncthreads();
    float cr = 0.f, ci = 0.f;
    { float br = ar, bi = ai;
#pragma unroll
      for (int q = 0; q < 5; ++q) { const float t = br * br - bi * bi; bi = 2.f * br * bi; br = t; }
      for (int v = 0; v < w; ++v) { const float er = EB[v * 128 + p], ei = EB[v * 128 + 64 + p]; const float nr = br * cr - bi * ci + er, ni = br * ci + bi * cr + ei; cr = nr; ci = ni; } }
    { float pr = 1.f, pi = 0.f; bf16* xo = XP + ((size_t)(b * CHB + 32 * w) * 32 + g) * 128 + p;
#pragma unroll 8
      for (int j = 0; j < 32; ++j) { const int k = 32 * w + j; const float xr = L[k * 128 + p] + (pr * cr - pi * ci), xi = L[k * 128 + 64 + p] + (pr * ci + pi * cr);
          xo[(size_t)j * 32 * 128] = (bf16)f2bf(xr); xo[(size_t)j * 32 * 128 + 64] = (bf16)f2bf(xi);
          const float t = pr * ar - pi * ai; pi = pr * ai + pi * ar; pr = t; } }
    __syncthreads();
}

__device__ __forceinline__ void phase_merge(const bf16* QH, bf16* Aout, const float* LSE, int vt, int nvt) {
    constexpr int UN = 8;
    for (int i0 = vt; i0 < MTOK * 64; i0 += UN * nvt) {
        float l[UN][3]; u32x4 av[UN][3];
#pragma unroll
        for (int q = 0; q < UN; ++q) { const int i = i0 + q * nvt; if (i < MTOK * 64) { const int row = i >> 6, h = (i >> 3) & 7, ch = i & 7, b = row >> 13, t = row & 8191;
            const size_t r0 = ((size_t)(b * 3 + 0) * 8 + h) * 8192 + t;
            const size_t r1 = ((size_t)(b * 3 + 1) * 8 + h) * 8192 + ((t & 3) << 11) + (t >> 2);
            const size_t r2 = ((size_t)(b * 3 + 2) * 8 + h) * 8192 + ((t & 15) << 9) + (t >> 4);
            l[q][0] = LSE[r0]; l[q][1] = LSE[r1]; l[q][2] = LSE[r2];
            av[q][0] = *(const u32x4*)(QH + r0 * 64 + ch * 8); av[q][1] = *(const u32x4*)(QH + r1 * 64 + ch * 8); av[q][2] = *(const u32x4*)(QH + r2 * 64 + ch * 8); }
          else { l[q][0] = l[q][1] = l[q][2] = 0.f; av[q][0] = av[q][1] = av[q][2] = (u32x4){0u, 0u, 0u, 0u}; } }
#pragma unroll
        for (int q = 0; q < UN; ++q) { const int i = i0 + q * nvt; if (i < MTOK * 64) { const int row = i >> 6, h = (i >> 3) & 7, ch = i & 7;
            const float l0 = l[q][0], l1 = l[q][1], l2 = l[q][2];
            const float mx = fmaxf(l0, fmaxf(l1, l2)); float w0 = expf(l0 - mx), w1 = expf(l1 - mx), w2 = expf(l2 - mx); const float inv = 1.0f / (w0 + w1 + w2); w0 *= inv; w1 *= inv; w2 *= inv;
            const u32x4 a0 = av[q][0], a1 = av[q][1], a2 = av[q][2];
            u32x4 o;
            o.x = pk2(w0 * bflo(a0.x) + w1 * bflo(a1.x) + w2 * bflo(a2.x), w0 * bfhi(a0.x) + w1 * bfhi(a1.x) + w2 * bfhi(a2.x));
            o.y = pk2(w0 * bflo(a0.y) + w1 * bflo(a1.y) + w2 * bflo(a2.y), w0 * bfhi(a0.y) + w1 * bfhi(a1.y) + w2 * bfhi(a2.y));
            o.z = pk2(w0 * bflo(a0.z) + w1 * bflo(a1.z) + w2 * bflo(a2.z), w0 * bfhi(a0.z) + w1 * bfhi(a1.z) + w2 * bfhi(a2.z));
            o.w = pk2(w0 * bflo(a0.w) + w1 * bflo(a1.w) + w2 * bflo(a2.w), w0 * bfhi(a0.w) + w1 * bfhi(a1.w) + w2 * bfhi(a2.w));
            *(u32x4*)(Aout + (size_t)row * AW + h * 64 + ch * 8) = o; } }
    }
}

__device__ __forceinline__ float gelu_tanh(float y) { const float z = 1.5957691216f * (y + 0.044715f * y * y * y); return y * __builtin_amdgcn_rcpf(1.0f + __builtin_amdgcn_exp2f(-1.44269504089f * z)); }
constexpr int XLP = 136;
constexpr int S3_XL = 64 * ULP * 2, S3_KL = S3_XL + 64 * XLP * 2;
__device__ __forceinline__ void ssm_s3_item(int item, const float* dskip, const bf16* UH, bf16* Y, unsigned char* ws, const unsigned char* tab, unsigned char* lds, int tid) {
    const int g = item >> 3, mt = item & 7, w = tid >> 6, lane = tid & 63, fr = lane & 15, fq = lane >> 4;
    const bf16* KT = (const bf16*)(tab + TB_KT) + (size_t)g * 32 * 256; const bf16* P = (const bf16*)(tab + TB_P) + (size_t)g * 512 * 128; const bf16* XP = (const bf16*)(ws + WS_XP);
    { u32x4 xv[2], kv2[2];
#pragma unroll
      for (int k = 0; k < 2; ++k) { const int i = tid + NTHR * k; xv[k] = *(const u32x4*)(XP + ((size_t)(64 * mt + (i >> 4)) * 32 + g) * 128 + (i & 15) * 8); kv2[k] = *(const u32x4*)(KT + (size_t)i * 8); }
      ssm_stage_u(UH, g, mt, lds, tid);
#pragma unroll
      for (int k = 0; k < 2; ++k) { const int i = tid + NTHR * k; *(u32x4*)(lds + S3_XL + (i >> 4) * (XLP * 2) + (i & 15) * 16) = xv[k]; *(u32x4*)(lds + S3_KL + i * 16) = kv2[k]; } }
    const float* dsk = dskip + g * 16 + 4 * fq;
    const float d0 = dsk[0], d1 = dsk[1], d2 = dsk[2], d3 = dsk[3];
    __syncthreads();
    const bf16* UL = (const bf16*)lds; const bf16* XL = (const bf16*)(lds + S3_XL); const bf16* KL = (const bf16*)(lds + S3_KL);
    const int shalf = fq >> 1, c20 = 8 * (fq & 1);
#pragma unroll 1
    for (int ti = 0; ti < 4; ++ti) {
        const int t = (ti == 0) ? w : (ti == 1) ? 15 - w : (ti == 2) ? 16 + w : 31 - w;
        bf16x8 pf[4];
#pragma unroll
        for (int k2 = 0; k2 < 4; ++k2) pf[k2] = *(const bf16x8*)(P + (size_t)(t * 16 + fr) * 128 + 32 * k2 + 8 * fq);
        f32x4 acc[4];
#pragma unroll
        for (int mi = 0; mi < 4; ++mi) acc[mi] = (f32x4){0.f, 0.f, 0.f, 0.f};
        const int nks = (t >> 1) + 1;
#pragma unroll 2
        for (int ks = 0; ks < nks; ++ks) {
            const int s = 2 * ks + shalf, lag = t - s;
            bf16x8 wf = (bf16x8){0, 0, 0, 0, 0, 0, 0, 0};
            if (lag >= 0) wf = *(const bf16x8*)(KL + lag * 256 + fr * 16 + c20);
#pragma unroll
            for (int mi = 0; mi < 4; ++mi) { const bf16x8 uf = *(const bf16x8*)(UL + (16 * mi + fr) * ULP + s * 16 + c20);
                acc[mi] = __builtin_amdgcn_mfma_f32_16x16x32_bf16(wf, uf, acc[mi], 0, 0, 0); }
        }
#pragma unroll
        for (int k2 = 0; k2 < 4; ++k2)
#pragma unroll
            for (int mi = 0; mi < 4; ++mi) { const bf16x8 xf = *(const bf16x8*)(XL + (16 * mi + fr) * XLP + 32 * k2 + 8 * fq);
                acc[mi] = __builtin_amdgcn_mfma_f32_16x16x32_bf16(pf[k2], xf, acc[mi], 0, 0, 0); }
#pragma unroll
        for (int mi = 0; mi < 4; ++mi) { const size_t tok = (size_t)(64 * mt + 16 * mi + fr) * TC + t;
            const u32x2 uu = *(const u32x2*)(UL + (16 * mi + fr) * ULP + t * 16 + 4 * fq);
            const float y0 = acc[mi][0] + d0 * bflo(uu.x), y1 = acc[mi][1] + d1 * bfhi(uu.x), y2 = acc[mi][2] + d2 * bflo(uu.y), y3 = acc[mi][3] + d3 * bfhi(uu.y);
            u32x2 o; o.x = pk2(gelu_tanh(y0), gelu_tanh(y1)); o.y = pk2(gelu_tanh(y2), gelu_tanh(y3));
            *(u32x2*)(Y + tok * AW + 16 * g + 4 * fq) = o; }
    }
    __syncthreads();
}

#define XB_TMO      128
#define XB_XCNT(j)  (256  + 64 * (j))
#define XB_XSUB(j)  (1280 + 64 * (j))
#define XB_XGEN(j)  (2304 + 64 * (j))
#define XB_TOP      3328
#define XB_TOPGEN   3392
#define XCD_BAR_WORDS 3456
#define XB_SPIN_CAP (1u << 20)
__device__ __forceinline__ unsigned xb_ld(unsigned* p)              { return __hip_atomic_load(p, __ATOMIC_RELAXED, __HIP_MEMORY_SCOPE_AGENT); }
__device__ __forceinline__ unsigned xb_add(unsigned* p, unsigned v) { return __hip_atomic_fetch_add(p, v, __ATOMIC_RELAXED, __HIP_MEMORY_SCOPE_AGENT); }
__device__ __forceinline__ unsigned xb_xcc_id() { return (unsigned)__builtin_amdgcn_s_getreg((3 << 11) | 20) & 0xFu; }
#define XB_SPIN(cond, bar) do { unsigned _sp = 0; while (cond) { __builtin_amdgcn_s_sleep(1); \
    if ((++_sp & 255u) == 0u) { if (xb_ld(&(bar)[XB_TMO])) break; if (_sp > XB_SPIN_CAP) { atomicAdd(&(bar)[XB_TMO], 1u); break; } } } } while (0)
struct XcdBarrier { unsigned* bar; unsigned x; volatile LAS unsigned* st; };
__device__ __forceinline__ XcdBarrier xcd_barrier_post(unsigned* bar, volatile LAS unsigned* st) {
    XcdBarrier b; b.bar = bar; b.x = xb_xcc_id(); b.st = st;
    if (threadIdx.x == 0) (void)xb_add(&bar[XB_XCNT(b.x)], 1u);
    return b;
}
__device__ __forceinline__ void xcd_barrier_complete(unsigned* bar, unsigned x, unsigned& nloc, unsigned& nx) {
    const unsigned G = gridDim.x * gridDim.y * gridDim.z;
    unsigned sum, cnt, mine, sp = 0u;
    for (;;) {
        sum = 0u; cnt = 0u; mine = 0u;
#pragma unroll
        for (unsigned j = 0; j < 16; ++j) { const unsigned c = xb_ld(&bar[XB_XCNT(j)]); sum += c; cnt += (c > 0u) ? 1u : 0u; mine = (j == x) ? c : mine; }
        if (sum == G) break;
        __builtin_amdgcn_s_sleep(1);
        if ((++sp & 255u) == 0u) { if (xb_ld(&bar[XB_TMO])) break; if (sp > XB_SPIN_CAP) { atomicAdd(&bar[XB_TMO], 1u); break; } }
    }
    nloc = mine > 0u ? mine : 1u; nx = cnt > 0u ? cnt : 1u;
}
__device__ __forceinline__ void xcd_barrier(const XcdBarrier& b) {
    asm volatile("s_waitcnt vmcnt(0)" ::: "memory");
    __syncthreads();
    if (threadIdx.x == 0) {
        unsigned* bar = b.bar;
        __builtin_amdgcn_s_waitcnt(0);
        unsigned nloc = b.st[0], nx = b.st[1];
        if (nloc == 0u) { xcd_barrier_complete(bar, b.x, nloc, nx); b.st[0] = nloc; b.st[1] = nx; }
        const unsigned old = xb_add(&bar[XB_XSUB(b.x)], 1u);
        const unsigned gen = old / nloc;
        if (old + 1u == (gen + 1u) * nloc) {
            __builtin_amdgcn_fence(__ATOMIC_RELEASE, "agent");
            asm volatile("s_waitcnt vmcnt(0)" ::: "memory");
            const unsigned og = xb_add(&bar[XB_TOP], 1u);
            const unsigned tg = og / nx;
            if (og + 1u == (tg + 1u) * nx) xb_add(&bar[XB_TOPGEN], 1u);
            else XB_SPIN(xb_ld(&bar[XB_TOPGEN]) == tg, bar);
            __builtin_amdgcn_fence(__ATOMIC_ACQUIRE, "agent");
            xb_add(&bar[XB_XGEN(b.x)], 1u);
            asm volatile("s_waitcnt vmcnt(0)" ::: "memory");
        } else {
            XB_SPIN(xb_ld(&bar[XB_XGEN(b.x)]) == gen, bar);
            __builtin_amdgcn_fence(__ATOMIC_ACQUIRE, "agent");
            asm volatile("s_waitcnt vmcnt(0)" ::: "memory");
        }
    }
    __syncthreads();
}

__device__ __forceinline__ void phase_stagger(int bx) {
    const unsigned long long t0 = __builtin_amdgcn_s_memrealtime(), wait = (unsigned long long)(bx * 100);
    while (__builtin_amdgcn_s_memrealtime() - t0 < wait) __builtin_amdgcn_s_sleep(32);
}

constexpr int KPL = 8, KPLX = KPL + ((DUP_K >= 0) ? 1 : 0), N_PHASES = 1 + KPLX * DEPTH;
__global__ void __launch_bounds__(NTHR, 2) mega_fwd(Args a) {
    extern __shared__ __attribute__((aligned(16))) unsigned char lds[];
    cg::grid_group grid = cg::this_grid();
    LAS unsigned char* ldsl = (LAS unsigned char*)lds;
    volatile LAS unsigned* bst = (volatile LAS unsigned*)(ldsl + LDS_BYTES - 16);
    if (threadIdx.x < 2) bst[threadIdx.x] = 0u;
    __syncthreads();
    XcdBarrier xbar; xbar.bar = (unsigned*)a.ws; xbar.x = 0; xbar.st = bst;
    if (a.ph_hi - a.ph_lo > 1) xbar = xcd_barrier_post((unsigned*)a.ws, bst);
    int prep = 0;
    for (int ph = a.ph_lo; ph < a.ph_hi; ++ph) {
        int zero; asm volatile("s_mov_b32 %0, 0" : "=s"(zero));
        int tid = threadIdx.x; asm volatile("" : "+v"(tid));
        const int lane = tid & 63, wave = __builtin_amdgcn_readfirstlane(tid >> 6);
        const int G = (int)gridDim.x + zero, bx = (int)blockIdx.x + zero;
        const int gw = bx * NWAVES + wave, ngw = G * NWAVES;
        unsigned char* ws = a.ws + zero; float* outp = a.out + zero;
        bf16* WB = (bf16*)(ws + WS_WB); bf16* QH = (bf16*)(ws + WS_Z); bf16* UG = (bf16*)(ws + WS_Z + 144 * MiB); bf16* UH = (bf16*)(ws + WS_Z + 208 * MiB); bf16* AK = QH + QPLANE; bf16* ACT = (bf16*)(ws + WS_ACT); bf16* Y = AK + (size_t)MTOK * AW; float* LSE = (float*)(ws + WS_LSE);
        bf16* MIX = QH;
        float* SS1 = (float*)(ws + WS_S); float* SS2 = (float*)(ws + WS_S + MiB);
        if (ph == 0) {
            const bool wfill = (W_FILL != 0) && ((MTOK / 256) * (2 * DFF / 256) % G != 0);
            if (G >= 64) {
                if (bx < 32) ssm_pre_item(a, zero, 0, bx, ws + WS_TAB, (float*)lds, tid);
                else phase_weights(a, zero, WB, (float*)lds, (bx - 32) * NWAVES + wave, (G - 32) * NWAVES, wave, lane, 0, wfill ? 1 : DEPTH);
            } else {
                phase_weights(a, zero, WB, (float*)lds, gw, ngw, wave, lane, 0, wfill ? 1 : DEPTH);
                __syncthreads();
                for (int g = bx; g < 32; g += G) ssm_pre_item(a, zero, 0, g, ws + WS_TAB, (float*)lds, tid);
            }
            phase_xprep(a.in[zero], ACT, SS2, gw, ngw, lane);
        } else {
            const int l = (ph - 1) / KPLX, kp = (ph - 1) % KPLX, k = (DUP_K >= 0 && kp > DUP_K) ? kp - 1 : kp;
            const bf16* wl = WB + (size_t)l * LAYER_W;
            unsigned char* tab = ws + WS_TAB + (size_t)(l & 1) * TAB_STRIDE;
            if (W_FILL != 0 && k == 6 && l + 1 < DEPTH) {
                const int nu = (MTOK / 256) * (2 * DFF / 256), rem = nu - (nu / G) * G;
                if (rem != 0 && bx >= rem) { phase_weights(a, zero, WB, (float*)lds, (bx - rem) * NWAVES + wave, (G - rem) * NWAVES, wave, lane, l + 1, l + 2); __syncthreads(); }
            }
            if (k == 0) {
                pg8::Gemm gm{ACT, wl + OFF_IN, MTOK, INC, DM, DM}; pg8::StaticOrder S; S.init(MTOK, INC, G, bx, WGM_K0);
                PG8_LAS float* rst = (PG8_LAS float*)(ldsl + 131088); int pbase = 0;
                pbase = (bx & 7) * 2048;
                for (int i = tid; i < 2048; i += NTHR) rst[i] = pg8::row_rstd(SS2, (size_t)(pbase + i));
                __syncthreads();
                pg8::EpiZ E{QH, UG, UH, SS2, rst, pbase};
                if (K0_DELAY_US > 0 && ((bx >> 3) & 1)) phase_stagger(K0_DELAY_US);
                pg8::gemm_phase<pg8::EpiZ, pg8::StaticOrder, true, true>(ldsl, tid, gm, S, E);
            } else if (k == 1) {
                const float* gq = a.in[3 + zero] + l * 64; const float* gk = a.in[4 + zero] + l * 64;
                u32x4 kv[6], vv[6], qr[4], qn[4];
#pragma unroll
                for (int i = 0; i < 6; ++i) { kv[i] = (u32x4){0u, 0u, 0u, 0u}; vv[i] = (u32x4){0u, 0u, 0u, 0u}; qr[i & 3] = (u32x4){0u, 0u, 0u, 0u}; qn[i & 3] = (u32x4){0u, 0u, 0u, 0u}; }
                if (bx < 1536) { const AttnItem A0 = attn_decode(bx); attn_load(A0, QH, tid, kv, vv); attn_qload(A0, QH, tid, qn); }
                for (int it = bx; it < 1536; it += G) {
                    const AttnItem A = attn_decode(it);
                    attn_stage(gk, lds, tid, kv, vv);
#pragma unroll
                    for (int i = 0; i < 4; ++i) qr[i] = qn[i];
                    __builtin_amdgcn_sched_barrier(0);
                    __syncthreads();
                    if (it + G < 1536) { const AttnItem An = attn_decode(it + G); attn_load(An, QH, tid, kv, vv); attn_qload(An, QH, tid, qn); }
                    __builtin_amdgcn_sched_barrier(0);
                    attn_tile2(A, qr, gq, QH, LSE, lds, tid);
                    __builtin_amdgcn_sched_barrier(0);
                    __syncthreads();
                }
                for (int it = bx; it < 256; it += G) for (int rep = 0; rep < NREP(2); ++rep) ssm_s1_item(it, UH, ws, tab, lds, tid);
            } else if (k == 2) {
                if (G >= 256) {
                    if (bx < 64) { for (int rep = 0; rep < NREP(3); ++rep) ssm_carry_item(bx, ws, tab, (float*)lds, tid); }
                    else if (bx < 96) { if (l + 1 < DEPTH) for (int rep = 0; rep < NREP(11); ++rep) ssm_pre_item(a, zero, l + 1, bx - 64, ws + WS_TAB + (size_t)((l + 1) & 1) * TAB_STRIDE, (float*)lds, tid); }
                    else { for (int rep = 0; rep < NREP(10); ++rep) phase_merge(QH, AK, LSE, (bx - 96) * NTHR + tid, (G - 96) * NTHR); }
                } else {
                    for (int it = bx; it < 64; it += G) ssm_carry_item(it, ws, tab, (float*)lds, tid);
                    if (l + 1 < DEPTH) for (int g = bx; g < 32; g += G) ssm_pre_item(a, zero, l + 1, g, ws + WS_TAB + (size_t)((l + 1) & 1) * TAB_STRIDE, (float*)lds, tid);
                    phase_merge(QH, AK, LSE, bx * NTHR + tid, G * NTHR);
                }
            } else if (k == 3) {
                const float* dskip = a.in[13 + zero] + l * 512;
                for (int rep = 0; rep < NREP(4); ++rep) for (int it = bx; it < 256; it += G) ssm_s3_item(it, dskip, UH, Y, ws, tab, lds, tid);
            } else if (k == 4) {
                pg8::Gemm gm{AK, wl + OFF_P, 2 * MTOK, 3 * DM, AW, AW}; pg8::K4Order S; S.base.init(MTOK, DM, G, bx, WGM_S);
                pg8::EpiK4 E{pg8::EpiGate1{MIX, DM, (const unsigned char*)UG, UGP}, pg8::EpiGlu{MIX, DM, (const unsigned char*)UG + 1024, UGP}};
                pg8::gemm_phase<pg8::EpiK4, pg8::K4Order, true, true>(ldsl, tid, gm, S, E);
            } else if (k == 5) {
                pg8::Gemm gm{MIX, wl + OFF_OUT, MTOK, DM, DM, DM}; pg8::StaticOrder S; S.init(MTOK, DM, G, bx, WGM_S);
                pg8::EpiResid E{ACT, nullptr, DM, SS1};
                pg8::gemm_phase<pg8::EpiResid, pg8::StaticOrder, true, true>(ldsl, tid, gm, S, E);
            } else if (k == 6) {
                pg8::Gemm gm{ACT, wl + OFF_GU, MTOK, 2 * DFF, DM, DM}; pg8::StaticOrder S; S.init(MTOK, 2 * DFF, G, bx, WGM_K6);
                PG8_LAS float* rst = (PG8_LAS float*)(ldsl + 131088); int pbase = 0;
                pbase = (bx & 7) * 2048;
                for (int i = tid; i < 2048; i += NTHR) rst[i] = pg8::row_rstd(SS1, (size_t)(pbase + i));
                __syncthreads();
                pg8::EpiSwiglu E{QH, DFF, SS1, rst, pbase};
                if (W_FILL == 0 && K6_DELAY_US > 0 && (long)5 * G + bx >= S.nwg) phase_stagger(K6_DELAY_US);
                pg8::gemm_phase<pg8::EpiSwiglu, pg8::StaticOrder, true, true>(ldsl, tid, gm, S, E);
            } else {
                pg8::Gemm gm{QH, wl + OFF_DN, MTOK, DM, DFF, DFF}; pg8::StaticOrder S; S.init(MTOK, DM, G, bx, WGM_S);
                pg8::EpiResid E{ACT, (l == DEPTH - 1) ? outp : nullptr, DM, SS2};
                pg8::gemm_phase<pg8::EpiResid, pg8::StaticOrder, true, true>(ldsl, tid, gm, S, E);
            }
        }
        if (REP_PH != 0 && ph > 0 && ((REP_PH >> ((ph - 1) % KPLX)) & 1) && prep == 0) { prep = 1; --ph; xcd_barrier(xbar); continue; }
        prep = 0;
        if (ph + 1 < a.ph_hi) { if (a.ph_lo < 0) grid.sync(); else { for (int sx = 0; sx < SYNC_X; ++sx) xcd_barrier(xbar); } }
    }
}

extern "C" void kernel_launch(void* const* d_in, const int* in_sizes, int n_in, void* d_out, int out_size, void* d_ws, size_t ws_size, hipStream_t stream) {
    static int grid = 0;
    if (grid == 0) {
        if (n_in != 21 || in_sizes[0] != MTOK * DM || out_size != MTOK * DM || ws_size < WS_END) { fprintf(stderr, "kernel_launch: unexpected shapes / workspace (n_in %d, ws %zu)\n", n_in, ws_size); grid = -1; return; }
        int dev = 0, cus = 0, per_cu = 0;
        (void)hipGetDevice(&dev); (void)hipDeviceGetAttribute(&cus, hipDeviceAttributeMultiprocessorCount, dev);
        (void)hipFuncSetAttribute((const void*)mega_fwd, hipFuncAttributeMaxDynamicSharedMemorySize, LDS_BYTES);
        (void)hipOccupancyMaxActiveBlocksPerMultiprocessor(&per_cu, (const void*)mega_fwd, NTHR, LDS_BYTES);
        if (per_cu < 1) per_cu = 1;
        (void)hipGetLastError();
        grid = cus * per_cu;
    }
    if (grid < 0) return;
    (void)hipMemsetAsync(d_ws, 0, 16384, stream);
    Args a{};
    for (int i = 0; i < 21; ++i) a.in[i] = (const float*)d_in[i];
    a.out = (float*)d_out; a.ws = (unsigned char*)d_ws;
#if MK_SINGLE
    a.ph_lo = 0; a.ph_hi = N_PHASES;
    void* args[] = {&a};
    hipError_t e = hipLaunchCooperativeKernel((const void*)mega_fwd, dim3(grid), dim3(NTHR), args, LDS_BYTES, stream);
    if (e != hipSuccess) fprintf(stderr, "cooperative launch failed: %s (grid %d)\n", hipGetErrorString(e), grid);
#else
    for (int ph = 0; ph < N_PHASES; ++ph) { a.ph_lo = ph; a.ph_hi = ph + 1; hipLaunchKernelGGL(mega_fwd, dim3(grid), dim3(NTHR), LDS_BYTES, stream, a); }
#endif
}
```

```cpp
#include <hip/hip_runtime.h>
#include <hip/hip_cooperative_groups.h>
#include <cstdio>
#include <cstdint>
namespace cg = cooperative_groups;

#ifndef REP_MASK
#define REP_MASK 0
#endif
#ifndef REP_PH
#define REP_PH 0
#endif
#ifndef REP_ATT
#define REP_ATT 0
#endif
#ifndef WGM_K0
#define WGM_K0 4
#endif
#ifndef WGM_K6
#define WGM_K6 8
#endif
#ifndef WGM_S
#define WGM_S 8
#endif
#ifndef W_FILL
#define W_FILL 1
#endif
#ifndef K0_DELAY_US
#define K0_DELAY_US 0
#endif
#ifndef K6_DELAY_US
#define K6_DELAY_US 15
#endif
#ifndef STAGGER_US
#define STAGGER_US 0
#endif
#ifndef DUP_K
#define DUP_K (-1)
#endif
#ifndef SYNC_X
#define SYNC_X 1
#endif
#define NREP(k) (((REP_MASK >> (k)) & 1) ? 2 : 1)
#ifndef MK_SINGLE
#define MK_SINGLE 1
#endif

namespace pg8 {
#define PG8_LAS __attribute__((address_space(3)))
typedef unsigned short bf16_t;
typedef short bf16x8 __attribute__((ext_vector_type(8)));
typedef float f32x4 __attribute__((ext_vector_type(4)));
typedef unsigned u32x4 __attribute__((ext_vector_type(4)));
constexpr int BM = 256, BK = 64, HALF = 128, HTB = HALF * BK * 2, STAGE_BYTES = 8 * HTB, NXCD = 8, WGM = 8;

__host__ __device__ __forceinline__ int lds_byte(int r, int c) { const int st = (r >> 4) * 2 + (c >> 5), rr = r & 15, cc = c & 31, ob = rr * 64 + cc * 2; return st * 1024 + (ob ^ (((ob >> 9) & 1) << 5)); }
__host__ __device__ __forceinline__ void stage_rc(int b, int& R, int& C) { const int st = b / 1024, sb = b % 1024, swz = sb ^ (((sb >> 9) & 1) << 5); R = (st >> 1) * 16 + swz / 64; C = (st & 1) * 32 + (swz % 64) / 2; }
__host__ __device__ __forceinline__ int perm32(int rho) { const int n = rho >> 4, i = rho & 15; return 8 * (i >> 2) + 4 * n + (i & 3); }

struct Unit { int pm, pn; };
struct Gemm { const bf16_t* A; const bf16_t* Bt; int M, N, K, lda; };

struct StaticOrder {
    int nM, nN, nwg, G, c, wgm;
    __host__ __device__ void init(int M, int N, int G_, int c_, int wgm_ = WGM) { nM = M / BM; nN = N / BM; nwg = nM * nN; G = G_; c = c_; wgm = wgm_; }
    __host__ __device__ bool next(int i, Unit& u) const {
        const long L = (long)i * G + c; if (L >= nwg) return false;
        int wgid = (int)L; { const int q = nwg / NXCD, r = nwg % NXCD, xcd = wgid % NXCD, off = wgid / NXCD; wgid = (xcd < r ? xcd * (q + 1) : r * (q + 1) + (xcd - r) * q) + off; }
        const int nig = wgm * nN, gid = wgid / nig, fm = gid * wgm, gsz = (nM - fm) < wgm ? (nM - fm) : wgm;
        u.pm = fm + ((wgid % nig) % gsz); u.pn = (wgid % nig) / gsz; return true;
    }
    __device__ __forceinline__ void a_ready(const Unit&) const {}
    __device__ __forceinline__ void done(const Unit&) const {}
};
struct PairOrder {
    StaticOrder base;
    __host__ __device__ bool next(int i, Unit& u) const { Unit b; if (!base.next(i >> 1, b)) return false; u.pm = b.pm; u.pn = 2 * b.pn + (i & 1); return true; }
    __device__ __forceinline__ void a_ready(const Unit&) const {}
    __device__ __forceinline__ void done(const Unit&) const {}
};

typedef float f32x2c_ __attribute__((ext_vector_type(2))); typedef __bf16 bf16x2c_ __attribute__((ext_vector_type(2)));
__device__ __forceinline__ unsigned cvt_pk_bf16(float lo, float hi) { const f32x2c_ v = {lo, hi}; const bf16x2c_ b = __builtin_convertvector(v, bf16x2c_); return __builtin_bit_cast(unsigned, b); }
__device__ __forceinline__ float bf_lo(unsigned w) { return __uint_as_float(w << 16); }
__device__ __forceinline__ float bf_hi(unsigned w) { return __uint_as_float(w & 0xffff0000u); }
__device__ __forceinline__ float ub(unsigned w, int i) { return (float)((w >> (8 * i)) & 255u) * (1.0f / 255.0f); }
__device__ __forceinline__ unsigned pk_u8x4(float a, float b, float c, float d) { return (unsigned)(a * 255.f + 0.5f) | ((unsigned)(b * 255.f + 0.5f) << 8) | ((unsigned)(c * 255.f + 0.5f) << 16) | ((unsigned)(d * 255.f + 0.5f) << 24); }
__device__ __forceinline__ float sigmoidf_(float x) { return __builtin_amdgcn_rcpf(1.0f + __builtin_amdgcn_exp2f(-1.44269504089f * x)); }

__device__ __forceinline__ float row_rstd(const float* SSP, size_t row) {
    const f32x4* p = (const f32x4*)(SSP + row * 16); const f32x4 a = p[0], b = p[1], c = p[2], d = p[3];
    const float ss = ((a[0] + a[1]) + (a[2] + a[3])) + ((b[0] + b[1]) + (b[2] + b[3])) + ((c[0] + c[1]) + (c[2] + c[3])) + ((d[0] + d[1]) + (d[2] + d[3]));
    return rsqrtf(ss * (1.0f / 1024.0f) + 1e-6f);
}
struct EpiZ {
    static constexpr bool PERM = true, AFTER_DRAIN = false;
    bf16_t* QH; bf16_t* UG; bf16_t* UH; const float* SS; const PG8_LAS float* rst; int pbase;
    __device__ __forceinline__ void operator()(const f32x4 (&acc)[2][2][4][2], const Unit& u, int wr, int wc, int fr, int fq) const {
        const int row0 = u.pm * BM + wr * 64 + fr;
        float rs[2][4];
#pragma unroll
        for (int ai = 0; ai < 2; ++ai)
#pragma unroll
            for (int m = 0; m < 4; ++m) { const int rr = row0 + ai * HALF + m * 16, rl = rr - pbase; rs[ai][m] = ((unsigned)rl < 2048u) ? rst[rl] : row_rstd(SS, (size_t)rr); }
        if (u.pn < 18) {
            const int which = u.pn / 6, colt = (u.pn % 6) * 256;
#pragma unroll
            for (int bj = 0; bj < 2; ++bj) { const int col = colt + bj * HALF + wc * 32 + 8 * fq, gi = col >> 9, h = (col >> 6) & 7, e = col & 63, dsh = 2 * gi;
#pragma unroll
                for (int ai = 0; ai < 2; ++ai)
#pragma unroll
                    for (int m = 0; m < 4; ++m) { const int row = row0 + ai * HALF + m * 16, b = row >> 13, t = row & 8191, idx = ((t & ((1 << dsh) - 1)) << (13 - dsh)) + (t >> dsh);
                        const f32x4 v0 = acc[ai][bj][m][0] * rs[ai][m], v1 = acc[ai][bj][m][1] * rs[ai][m];
                        u32x4 w; w.x = cvt_pk_bf16(v0[0], v0[1]); w.y = cvt_pk_bf16(v0[2], v0[3]); w.z = cvt_pk_bf16(v1[0], v1[1]); w.w = cvt_pk_bf16(v1[2], v1[3]);
                        *(u32x4*)(QH + ((((size_t)(which * 2 + b) * 3 + gi) * 8 + h) * 8192 + idx) * 64 + e) = w; } }
        } else if (u.pn < 20) {
#pragma unroll
            for (int bj = 0; bj < 2; ++bj) { const int col = (u.pn - 18) * BM + bj * HALF + wc * 32 + 8 * fq, g = col >> 4, c0 = col & 15;
#pragma unroll
                for (int ai = 0; ai < 2; ++ai)
#pragma unroll
                    for (int m = 0; m < 4; ++m) { const int row = row0 + ai * HALF + m * 16;
                        const f32x4 v0 = acc[ai][bj][m][0] * rs[ai][m], v1 = acc[ai][bj][m][1] * rs[ai][m];
                        u32x4 w; w.x = cvt_pk_bf16(v0[0], v0[1]); w.y = cvt_pk_bf16(v0[2], v0[3]); w.z = cvt_pk_bf16(v1[0], v1[1]); w.w = cvt_pk_bf16(v1[2], v1[3]);
                        *(u32x4*)(UH + ((size_t)g * 16384 + row) * 16 + c0) = w; } }
        } else {
            typedef unsigned u32x2g __attribute__((ext_vector_type(2)));
            unsigned char* UG8 = (unsigned char*)UG; const int col0 = (u.pn - 20) * BM + wc * 32 + 8 * fq;
#pragma unroll
            for (int ai = 0; ai < 2; ++ai)
#pragma unroll
                for (int m = 0; m < 4; ++m) { unsigned char* rowp = UG8 + (size_t)(row0 + ai * HALF + m * 16) * 2048 + col0;
#pragma unroll
                    for (int bj = 0; bj < 2; ++bj) { f32x4 v0 = acc[ai][bj][m][0] * rs[ai][m], v1 = acc[ai][bj][m][1] * rs[ai][m];
#pragma unroll
                        for (int j = 0; j < 4; ++j) { v0[j] = sigmoidf_(v0[j]); v1[j] = sigmoidf_(v1[j]); }
                        *(u32x2g*)(rowp + bj * HALF) = (u32x2g){pk_u8x4(v0[0], v0[1], v0[2], v0[3]), pk_u8x4(v1[0], v1[1], v1[2], v1[3])}; } }
        }
    }
};
struct EpiGate1 {
    static constexpr bool PERM = true, AFTER_DRAIN = false;
    bf16_t* O; int ldc; const unsigned char* G; int ldg;
    __device__ __forceinline__ void operator()(const f32x4 (&acc)[2][2][4][2], const Unit& u, int wr, int wc, int fr, int fq) const {
        const int row0 = u.pm * BM + wr * 64 + fr, col0 = u.pn * BM + wc * 32 + 8 * fq;
#pragma unroll
        for (int ai = 0; ai < 2; ++ai) {
            typedef unsigned u32x2g __attribute__((ext_vector_type(2))); u32x2g g[4][2];
#pragma unroll
            for (int m = 0; m < 4; ++m)
#pragma unroll
                for (int bj = 0; bj < 2; ++bj) g[m][bj] = *(const u32x2g*)(G + (size_t)(row0 + ai * HALF + m * 16) * ldg + col0 + bj * HALF);
#pragma unroll
            for (int m = 0; m < 4; ++m) { const size_t r = (size_t)(row0 + ai * HALF + m * 16);
#pragma unroll
                for (int bj = 0; bj < 2; ++bj) { const f32x4 v0 = acc[ai][bj][m][0], v1 = acc[ai][bj][m][1]; const u32x2g gg = g[m][bj];
                    u32x4 w; w.x = cvt_pk_bf16(v0[0] * ub(gg.x, 0), v0[1] * ub(gg.x, 1)); w.y = cvt_pk_bf16(v0[2] * ub(gg.x, 2), v0[3] * ub(gg.x, 3));
                    w.z = cvt_pk_bf16(v1[0] * ub(gg.y, 0), v1[1] * ub(gg.y, 1)); w.w = cvt_pk_bf16(v1[2] * ub(gg.y, 2), v1[3] * ub(gg.y, 3));
                    *(u32x4*)(O + r * ldc + col0 + bj * HALF) = w; } }
            asm volatile("" ::: "memory"); }
    }
};
struct EpiGlu {
    static constexpr bool PERM = true, AFTER_DRAIN = false;
    bf16_t* O; int ldc; const unsigned char* G; int ldg;
    __device__ __forceinline__ void operator()(const f32x4 (&acc)[2][2][4][2], const Unit& u, int wr, int wc, int fr, int fq) const {
        const int row0 = u.pm * BM + wr * 64 + fr, col0 = u.pn * HALF + wc * 32 + 8 * fq;
#pragma unroll
        for (int ai = 0; ai < 2; ++ai) {
            typedef unsigned u32x2g __attribute__((ext_vector_type(2))); u32x2g gv[4]; u32x4 tv[4];
#pragma unroll
            for (int m = 0; m < 4; ++m) { const size_t r = (size_t)(row0 + ai * HALF + m * 16); gv[m] = *(const u32x2g*)(G + r * ldg + col0); tv[m] = *(const u32x4*)(O + r * ldc + col0); }
#pragma unroll
            for (int m = 0; m < 4; ++m) { const size_t r = (size_t)(row0 + ai * HALF + m * 16); const u32x2g g = gv[m]; const u32x4 t = tv[m];
                const f32x4 a0 = acc[ai][0][m][0], a1 = acc[ai][0][m][1], b0 = acc[ai][1][m][0], b1 = acc[ai][1][m][1];
                u32x4 w;
                w.x = cvt_pk_bf16(bf_lo(t.x) + ub(g.x, 0) * a0[0] * sigmoidf_(b0[0]), bf_hi(t.x) + ub(g.x, 1) * a0[1] * sigmoidf_(b0[1]));
                w.y = cvt_pk_bf16(bf_lo(t.y) + ub(g.x, 2) * a0[2] * sigmoidf_(b0[2]), bf_hi(t.y) + ub(g.x, 3) * a0[3] * sigmoidf_(b0[3]));
                w.z = cvt_pk_bf16(bf_lo(t.z) + ub(g.y, 0) * a1[0] * sigmoidf_(b1[0]), bf_hi(t.z) + ub(g.y, 1) * a1[1] * sigmoidf_(b1[1]));
                w.w = cvt_pk_bf16(bf_lo(t.w) + ub(g.y, 2) * a1[2] * sigmoidf_(b1[2]), bf_hi(t.w) + ub(g.y, 3) * a1[3] * sigmoidf_(b1[3]));
                *(u32x4*)(O + r * ldc + col0) = w; }
            asm volatile("" ::: "memory"); }
    }
};
struct K4Order {
    StaticOrder base;
    __host__ __device__ bool next(int i, Unit& u) const { Unit b; if (!base.next(i / 3, b)) return false; const int j = i % 3;
        if (j == 0) { u.pm = b.pm; u.pn = b.pn; } else { u.pm = 64 + b.pm; u.pn = 4 + 2 * b.pn + (j - 1); } return true; }
    __device__ __forceinline__ void a_ready(const Unit&) const {}
    __device__ __forceinline__ void done(const Unit&) const {}
};
struct EpiK4 {
    static constexpr bool PERM = true, AFTER_DRAIN = false;
    EpiGate1 e1; EpiGlu e2;
    __device__ __forceinline__ void operator()(const f32x4 (&acc)[2][2][4][2], const Unit& u, int wr, int wc, int fr, int fq) const {
        if (u.pn < 4) e1(acc, u, wr, wc, fr, fq);
        else { Unit v; v.pm = u.pm - 64; v.pn = u.pn - 4; e2(acc, v, wr, wc, fr, fq); }
    }
};
struct EpiSwiglu {
    static constexpr bool PERM = true, AFTER_DRAIN = false;
    bf16_t* O; int ldc; const float* SS; const PG8_LAS float* rst; int pbase;
    __device__ __forceinline__ void operator()(const f32x4 (&acc)[2][2][4][2], const Unit& u, int wr, int wc, int fr, int fq) const {
        const int row0 = u.pm * BM + wr * 64 + fr, col0 = u.pn * HALF + wc * 32 + 8 * fq;
#pragma unroll
        for (int ai = 0; ai < 2; ++ai)
#pragma unroll
            for (int m = 0; m < 4; ++m) { const size_t r = (size_t)(row0 + ai * HALF + m * 16);
                const int rl = (int)r - pbase; const float rs = ((unsigned)rl < 2048u) ? rst[rl] : row_rstd(SS, r);
                const f32x4 a0 = acc[ai][0][m][0] * rs, a1 = acc[ai][0][m][1] * rs, b0 = acc[ai][1][m][0] * rs, b1 = acc[ai][1][m][1] * rs;
                u32x4 w;
                w.x = cvt_pk_bf16(a0[0] * sigmoidf_(a0[0]) * b0[0], a0[1] * sigmoidf_(a0[1]) * b0[1]);
                w.y = cvt_pk_bf16(a0[2] * sigmoidf_(a0[2]) * b0[2], a0[3] * sigmoidf_(a0[3]) * b0[3]);
                w.z = cvt_pk_bf16(a1[0] * sigmoidf_(a1[0]) * b1[0], a1[1] * sigmoidf_(a1[1]) * b1[1]);
                w.w = cvt_pk_bf16(a1[2] * sigmoidf_(a1[2]) * b1[2], a1[3] * sigmoidf_(a1[3]) * b1[3]);
                *(u32x4*)(O + r * ldc + col0) = w; }
    }
};
struct EpiResid {
    static constexpr bool PERM = true, AFTER_DRAIN = false;
    bf16_t* XB; float* C; int ldc; float* SS;
    __device__ __forceinline__ void operator()(const f32x4 (&acc)[2][2][4][2], const Unit& u, int wr, int wc, int fr, int fq) const {
        const int row0 = u.pm * BM + wr * 64 + fr, col0 = u.pn * BM + wc * 32 + 8 * fq;
#pragma unroll
        for (int ai = 0; ai < 2; ++ai) {
            u32x4 rv[4][2];
#pragma unroll
            for (int m = 0; m < 4; ++m)
#pragma unroll
                for (int bj = 0; bj < 2; ++bj) rv[m][bj] = *(const u32x4*)(XB + (size_t)(row0 + ai * HALF + m * 16) * ldc + col0 + bj * HALF);
#pragma unroll
            for (int m = 0; m < 4; ++m) { const int row = row0 + ai * HALF + m * 16; const size_t off = (size_t)row * ldc + col0; float ss = 0.f;
#pragma unroll
                for (int bj = 0; bj < 2; ++bj) { const u32x4 r = rv[m][bj];
                    const f32x4 o0 = acc[ai][bj][m][0] + (f32x4){bf_lo(r.x), bf_hi(r.x), bf_lo(r.y), bf_hi(r.y)}, o1 = acc[ai][bj][m][1] + (f32x4){bf_lo(r.z), bf_hi(r.z), bf_lo(r.w), bf_hi(r.w)};
                    ss += ((o0[0] * o0[0] + o0[1] * o0[1]) + (o0[2] * o0[2] + o0[3] * o0[3])) + ((o1[0] * o1[0] + o1[1] * o1[1]) + (o1[2] * o1[2] + o1[3] * o1[3]));
                    u32x4 w; w.x = cvt_pk_bf16(o0[0], o0[1]); w.y = cvt_pk_bf16(o0[2], o0[3]); w.z = cvt_pk_bf16(o1[0], o1[1]); w.w = cvt_pk_bf16(o1[2], o1[3]);
                    *(u32x4*)(XB + off + bj * HALF) = w;
                    if (C) { *(f32x4*)(C + off + bj * HALF) = o0; *(f32x4*)(C + off + bj * HALF + 4) = o1; } }
                ss += __shfl_xor(ss, 16); ss += __shfl_xor(ss, 32);
                if (fq == 0) SS[(size_t)row * 16 + u.pn * 4 + wc] = ss; }
            asm volatile("" ::: "memory"); }
    }
};

template <class Epi, class Sched, bool ALIGN_EPI = false, bool SP2 = false>
__device__ __forceinline__ void gemm_phase(PG8_LAS unsigned char* lds, const int tid, const Gemm g, const Sched& S, const Epi& E) {
    const int wid = __builtin_amdgcn_readfirstlane(tid >> 6), lane = tid & 63, wr = wid >> 2, wc = wid & 3, fr = lane & 15, fq = lane >> 4;
    const int K = g.K, nt = K / BK, lda = g.lda;
    unsigned voffA[2], voffB[2];
#pragma unroll
    for (int i = 0; i < 2; ++i) { int R, C; stage_rc(tid * 16 + i * 8192, R, C); const int Rb = Epi::PERM ? ((R & ~31) + perm32(R & 31)) : R;
        voffA[i] = (unsigned)(R * lda + C) * 2u; voffB[i] = (unsigned)(Rb * K + C) * 2u; }
    const size_t kstep = (size_t)(BK * 2);
    const size_t hA = (size_t)HALF * lda * 2, hB = (size_t)HALF * K * 2;
    const size_t tA = 2 * hA, tB = 2 * hB;
    const unsigned ldsw = (unsigned)wid * 1024u;
    const int aoff = lds_byte(wr * 64 + fr, fq * 8), boff = lds_byte(wc * 32 + fr, fq * 8);
#define PG8_SA(b, h) (((b) * 2 + (h)) * HTB)
#define PG8_SB(b, h) ((4 + (b) * 2 + (h)) * HTB)
#define PG8_STAGE(bufoff, gbase, voff) do { _Pragma("unroll") for (int _i = 0; _i < 2; ++_i) \
        __builtin_amdgcn_global_load_lds((const unsigned*)((const char*)(gbase) + (voff)[_i]), (PG8_LAS unsigned*)(lds + (bufoff) + ldsw + _i * 8192), 16, 0, 0); } while (0)
#define PG8_LDA(dst, b, h) do { _Pragma("unroll") for (int m = 0; m < 4; ++m) _Pragma("unroll") for (int k = 0; k < 2; ++k) dst[m][k] = *(const PG8_LAS bf16x8*)(lds + PG8_SA(b, h) + aoff + m * 2048 + k * 1024); } while (0)
#define PG8_LDB(dst, b, h) do { _Pragma("unroll") for (int n = 0; n < 2; ++n) _Pragma("unroll") for (int k = 0; k < 2; ++k) dst[n][k] = *(const PG8_LAS bf16x8*)(lds + PG8_SB(b, h) + boff + n * 2048 + k * 1024); } while (0)
#define PG8_MMA(ai, bj, At, Bt) do { __builtin_amdgcn_s_setprio(1); _Pragma("unroll") for (int m = 0; m < 4; ++m) _Pragma("unroll") for (int n = 0; n < 2; ++n) _Pragma("unroll") for (int k = 0; k < 2; ++k) \
        acc[ai][bj][m][n] = __builtin_amdgcn_mfma_f32_16x16x32_bf16(Bt[n][k], At[m][k], acc[ai][bj][m][n], 0, 0, 0); __builtin_amdgcn_s_setprio(0); } while (0)
#define PG8_WAIT_V(n) asm volatile("s_waitcnt vmcnt(" #n ")" ::: "memory")
#define PG8_WAIT_L(n) asm volatile("s_waitcnt lgkmcnt(" #n ")" ::: "memory")
#define PG8_BAR __builtin_amdgcn_s_barrier()
#define PG8_SCHED __builtin_amdgcn_sched_barrier(0)
    Unit cur, nxt; int ui = 0;
    if (!S.next(0, cur)) return;
    f32x4 acc[2][2][4][2];
#pragma unroll
    for (int a = 0; a < 2; ++a)
#pragma unroll
        for (int b = 0; b < 2; ++b)
#pragma unroll
            for (int m = 0; m < 4; ++m)
#pragma unroll
                for (int n = 0; n < 2; ++n) acc[a][b][m][n] = (f32x4){0.f, 0.f, 0.f, 0.f};
    bf16x8 At[4][2], B0[2][2], B1[2][2];
    const char* cA = (const char*)g.A + (size_t)cur.pm * tA; const char* cB = (const char*)g.Bt + (size_t)cur.pn * tB;
    S.a_ready(cur);
    if constexpr (SP2) {
        PG8_STAGE(PG8_SB(0, 0), cB, voffB); PG8_STAGE(PG8_SB(0, 1), cB + hB, voffB); PG8_STAGE(PG8_SA(0, 0), cA, voffA); PG8_STAGE(PG8_SA(0, 1), cA + hA, voffA);
        if (wr == 1) PG8_BAR;
        PG8_WAIT_V(2); PG8_BAR;
        PG8_STAGE(PG8_SB(1, 0), cB + kstep, voffB); PG8_STAGE(PG8_SA(1, 0), cA + kstep, voffA); PG8_STAGE(PG8_SB(1, 1), cB + hB + kstep, voffB);
        PG8_WAIT_V(6); PG8_BAR;
    } else {
        PG8_STAGE(PG8_SB(0, 0), cB, voffB); PG8_STAGE(PG8_SA(0, 0), cA, voffA); PG8_STAGE(PG8_SB(0, 1), cB + hB, voffB); PG8_STAGE(PG8_SA(0, 1), cA + hA, voffA);
        if (wr == 1) PG8_BAR;
        PG8_WAIT_V(4); PG8_BAR;
        PG8_STAGE(PG8_SB(1, 0), cB + kstep, voffB); PG8_STAGE(PG8_SA(1, 0), cA + kstep, voffA); PG8_STAGE(PG8_SB(1, 1), cB + hB + kstep, voffB);
        PG8_WAIT_V(6); PG8_BAR;
    }
    for (;;) {
        const bool has_next = S.next(ui + 1, nxt);
        const char* nA = has_next ? (const char*)g.A + (size_t)nxt.pm * tA : cA; const char* nB = has_next ? (const char*)g.Bt + (size_t)nxt.pn * tB : cB;
        for (int t = 0; t < nt; t += 2) {
            const bool last = (t == nt - 2);
            const char* a1 = cA + (size_t)(t + 1) * kstep;
            const char* a2 = last ? nA : cA + (size_t)(t + 2) * kstep; const char* b2 = last ? nB : cB + (size_t)(t + 2) * kstep;
            const char* a3 = a2 + kstep; const char* b3 = b2 + kstep;
            if (last && has_next) S.a_ready(nxt);
            if constexpr (SP2) {
            PG8_LDB(B0, 0, 0); PG8_LDB(B1, 0, 1); PG8_SCHED; PG8_LDA(At, 0, 0); PG8_STAGE(PG8_SA(1, 1), a1 + hA, voffA);
            PG8_WAIT_V(8); PG8_WAIT_L(0); PG8_BAR; PG8_MMA(0, 0, At, B0); PG8_MMA(0, 1, At, B1); PG8_BAR; PG8_SCHED;
            PG8_LDA(At, 0, 1); PG8_STAGE(PG8_SB(0, 0), b2, voffB); PG8_STAGE(PG8_SB(0, 1), b2 + hB, voffB); PG8_STAGE(PG8_SA(0, 0), a2, voffA);
            PG8_WAIT_V(8); PG8_WAIT_L(0); PG8_BAR; PG8_MMA(1, 0, At, B0); PG8_MMA(1, 1, At, B1); PG8_BAR; PG8_SCHED;
            PG8_LDB(B0, 1, 0); PG8_LDB(B1, 1, 1); PG8_SCHED; PG8_LDA(At, 1, 0); PG8_STAGE(PG8_SA(0, 1), a2 + hA, voffA);
            PG8_WAIT_V(8); PG8_WAIT_L(0); PG8_BAR; PG8_MMA(0, 0, At, B0); PG8_MMA(0, 1, At, B1); PG8_BAR; PG8_SCHED;
            PG8_LDA(At, 1, 1); PG8_STAGE(PG8_SB(1, 0), b3, voffB); PG8_STAGE(PG8_SB(1, 1), b3 + hB, voffB); PG8_STAGE(PG8_SA(1, 0), a3, voffA);
            PG8_WAIT_V(8); PG8_WAIT_L(0); PG8_BAR; PG8_MMA(1, 0, At, B0); PG8_MMA(1, 1, At, B1); PG8_BAR; PG8_SCHED;
            } else {
            PG8_LDB(B0, 0, 0); PG8_SCHED; PG8_LDA(At, 0, 0); PG8_STAGE(PG8_SA(1, 1), a1 + hA, voffA);
            PG8_WAIT_L(8); PG8_BAR; PG8_WAIT_L(0); PG8_MMA(0, 0, At, B0); PG8_BAR; PG8_SCHED;
            PG8_LDB(B1, 0, 1); PG8_STAGE(PG8_SB(0, 0), b2, voffB);
            PG8_BAR; PG8_WAIT_L(0); PG8_MMA(0, 1, At, B1); PG8_BAR;
            PG8_LDA(At, 0, 1); PG8_STAGE(PG8_SA(0, 0), a2, voffA);
            PG8_BAR; PG8_WAIT_L(0); PG8_MMA(1, 0, At, B0); PG8_BAR; PG8_SCHED;
            PG8_STAGE(PG8_SB(0, 1), b2 + hB, voffB);
            PG8_WAIT_V(6); PG8_BAR; PG8_MMA(1, 1, At, B1); PG8_BAR;
            PG8_LDB(B0, 1, 0); PG8_SCHED; PG8_LDA(At, 1, 0); PG8_STAGE(PG8_SA(0, 1), a2 + hA, voffA);
            PG8_WAIT_L(8); PG8_BAR; PG8_WAIT_L(0); PG8_MMA(0, 0, At, B0); PG8_BAR; PG8_SCHED;
            PG8_LDB(B1, 1, 1); PG8_STAGE(PG8_SB(1, 0), b3, voffB);
            PG8_BAR; PG8_WAIT_L(0); PG8_MMA(0, 1, At, B1); PG8_BAR;
            PG8_LDA(At, 1, 1); PG8_STAGE(PG8_SA(1, 0), a3, voffA);
            PG8_BAR; PG8_WAIT_L(0); PG8_MMA(1, 0, At, B0); PG8_BAR; PG8_SCHED;
            PG8_STAGE(PG8_SB(1, 1), b3 + hB, voffB);
            PG8_WAIT_V(6); PG8_BAR; PG8_MMA(1, 1, At, B1); PG8_BAR;
            }
        }
        if constexpr (ALIGN_EPI) { if (wr == 0) PG8_BAR; }
        if constexpr (!Epi::AFTER_DRAIN) { E(acc, cur, wr, wc, fr, fq); S.done(cur); }
        if (!has_next) break;
#pragma unroll
        for (int a = 0; a < 2; ++a)
#pragma unroll
            for (int b = 0; b < 2; ++b)
#pragma unroll
                for (int m = 0; m < 4; ++m)
#pragma unroll
                    for (int n = 0; n < 2; ++n) acc[a][b][m][n] = (f32x4){0.f, 0.f, 0.f, 0.f};
        cur = nxt; cA = nA; cB = nB; ++ui;
        if constexpr (ALIGN_EPI) { if (wr == 1) PG8_BAR; }
    }
    PG8_WAIT_V(0);
    if constexpr (!ALIGN_EPI) { if (wr == 0) PG8_BAR; }
    PG8_BAR;
#undef PG8_SA
#undef PG8_SB
#undef PG8_STAGE
#undef PG8_LDA
#undef PG8_LDB
#undef PG8_MMA
#undef PG8_WAIT_V
#undef PG8_WAIT_L
#undef PG8_BAR
#undef PG8_SCHED
}
}

typedef unsigned short bf16;
typedef short bf16x8 __attribute__((ext_vector_type(8)));
typedef float f32x4 __attribute__((ext_vector_type(4)));
typedef unsigned u32x4 __attribute__((ext_vector_type(4)));
typedef unsigned u32x2 __attribute__((ext_vector_type(2)));
#define LAS __attribute__((address_space(3)))

constexpr int NWAVES = 8, NTHR = 512;
constexpr int DM = 1024, SEQ = 8192, MTOK = 16384, DEPTH = 4;
constexpr int INC = 7168, DFF = 2816, AW = 512;
constexpr int COL_Q = 0, COL_K = 1536, COL_V = 3072, COL_U = 4608, COL_GA = 5120, COL_GS = 6144;
constexpr int UGP = 2048;
constexpr int TC = 32, NCH = MTOK / TC  , CHB = SEQ / TC  ;
constexpr float EPS = 1e-6f;

constexpr size_t OFF_IN = 0, OFF_P = 7340032, OFF_GLU = 7864320, OFF_OUT = 8912896, OFF_GU = 9961472, OFF_DN = 15728640, LAYER_W = 18612224;
constexpr size_t MiB = 1u << 20;
constexpr size_t WS_SS1 = 65536, WS_SS2 = 131072;
constexpr size_t WS_WB = 1 * MiB, WS_Z = 143 * MiB, WS_ACT = 367 * MiB, WS_Y = 399 * MiB, WS_LSE = 415 * MiB, WS_TAB = 417 * MiB, TAB_STRIDE = 9 * MiB,
                 WS_S = 435 * MiB, WS_XP = 443 * MiB, WS_END = 447 * MiB;
constexpr size_t TB_KT = 0, TB_AT = 768 * 1024, TB_E = 1 * MiB, TB_P = 5 * MiB;
static_assert(WS_WB + 4 * LAYER_W * 2 <= WS_Z && WS_Z + (size_t)MTOK * INC * 2 <= WS_ACT, "ws map");
constexpr int LDS_BYTES = 147456;

struct Args { const float* in[21]; float* out; unsigned char* ws; int ph_lo, ph_hi; };

__device__ __forceinline__ unsigned f2bf(float f) { unsigned u = __float_as_uint(f); return (u + 0x7fffu + ((u >> 16) & 1u)) >> 16; }
__device__ __forceinline__ unsigned pk2(float lo, float hi) { return pg8::cvt_pk_bf16(lo, hi); }
__device__ __forceinline__ float bflo(unsigned w) { return __uint_as_float(w << 16); }
__device__ __forceinline__ float bfhi(unsigned w) { return __uint_as_float(w & 0xffff0000u); }
__device__ __forceinline__ float wave_sum(float v) {
#pragma unroll
    for (int o = 1; o < 64; o <<= 1) v += __shfl_xor(v, o);
    return v;
}

__device__ __forceinline__ void transpose_item(const float* W, int K, int N, bf16* WT, int il_off, float* scr, int item, int lane, const float* gk = nullptr) {
    const int nblk = N / 64, kb = item / nblk, nb = item % nblk, k0 = 64 * kb, n0 = 64 * nb;
    const float* src = W + (size_t)k0 * N + n0 + lane;
#pragma unroll 16
    for (int i = 0; i < 64; ++i) scr[i * 65 + lane] = src[(size_t)i * N];
    const int drow = (il_off < 0) ? n0 : (n0 / 128) * 256 + il_off + (n0 % 128);
    const int c = lane & 7, nn = lane >> 3;
    f32x4 g0 = (f32x4){1.f, 1.f, 1.f, 1.f}, g1 = g0;
    if (gk) { g0 = *(const f32x4*)(gk + k0 + 8 * c); g1 = *(const f32x4*)(gk + k0 + 8 * c + 4); }
#pragma unroll
    for (int j = 0; j < 8; ++j) { const int n = nn + 8 * j; const float* p = scr + (8 * c) * 65 + n;
        u32x4 o; o.x = pk2(p[0 * 65] * g0.x, p[1 * 65] * g0.y); o.y = pk2(p[2 * 65] * g0.z, p[3 * 65] * g0.w); o.z = pk2(p[4 * 65] * g1.x, p[5 * 65] * g1.y); o.w = pk2(p[6 * 65] * g1.z, p[7 * 65] * g1.w);
        *(u32x4*)(WT + (size_t)(drow + n) * K + k0 + 8 * c) = o; }
}
__device__ __forceinline__ void phase_weights(const Args& a, int zero, bf16* WB, float* ldsf, int gw, int ngw, int wave, int lane, int l0 = 0, int l1 = DEPTH) {
    float* scr = ldsf + wave * 4352;
    constexpr int PER_LAYER = 4544;
    for (int it = l0 * PER_LAYER + gw; it < l1 * PER_LAYER; it += ngw) {
        const int l = it / PER_LAYER; int r = it % PER_LAYER; bf16* wl = WB + (size_t)l * LAYER_W;
        if (r < 1792) { transpose_item(a.in[2 + zero] + (size_t)l * DM * INC, DM, INC, wl + OFF_IN, -1, scr, r, lane, a.in[1 + zero] + l * DM); continue; } r -= 1792;
        if (r < 128) { transpose_item(a.in[5 + zero] + (size_t)l * AW * DM, AW, DM, wl + OFF_P, -1, scr, r, lane); continue; } r -= 128;
        if (r < 128) { transpose_item(a.in[14 + zero] + (size_t)l * AW * DM, AW, DM, wl + OFF_GLU, 0, scr, r, lane); continue; } r -= 128;
        if (r < 128) { transpose_item(a.in[15 + zero] + (size_t)l * AW * DM, AW, DM, wl + OFF_GLU, 128, scr, r, lane); continue; } r -= 128;
        if (r < 256) { transpose_item(a.in[16 + zero] + (size_t)l * DM * DM, DM, DM, wl + OFF_OUT, -1, scr, r, lane); continue; } r -= 256;
        if (r < 704) { transpose_item(a.in[18 + zero] + (size_t)l * DM * DFF, DM, DFF, wl + OFF_GU, 0, scr, r, lane, a.in[17 + zero] + l * DM); continue; } r -= 704;
        if (r < 704) { transpose_item(a.in[19 + zero] + (size_t)l * DM * DFF, DM, DFF, wl + OFF_GU, 128, scr, r, lane, a.in[17 + zero] + l * DM); continue; } r -= 704;
        transpose_item(a.in[20 + zero] + (size_t)l * DFF * DM, DFF, DM, wl + OFF_DN, -1, scr, r, lane);
    }
}

__device__ __forceinline__ void phase_xprep(const float* x, bf16* out, float* SS, int gw, int ngw, int lane) {
    for (int m = gw; m < MTOK; m += ngw) {
        const f32x4* xr = (const f32x4*)(x + (size_t)m * DM) + lane;
        f32x4 v[4]; float s = 0.f;
#pragma unroll
        for (int j = 0; j < 4; ++j) { v[j] = xr[64 * j]; s += (v[j].x * v[j].x + v[j].y * v[j].y) + (v[j].z * v[j].z + v[j].w * v[j].w); }
        s = wave_sum(s);
        u32x2* o8 = (u32x2*)(out + (size_t)m * DM) + lane;
#pragma unroll
        for (int j = 0; j < 4; ++j) { u32x2 w; w.x = pk2(v[j].x, v[j].y); w.y = pk2(v[j].z, v[j].w); o8[64 * j] = w; }
        if (lane < 16) SS[(size_t)m * 16 + lane] = (lane == 0) ? s : 0.f;
    }
}

__device__ __forceinline__ void ssm_pre_item(const Args& a, int zero, int l, int g, unsigned char* tab, float* L, int tid) {
    float* pw = L; float* bb = L + 4224; float* cc = L + 6272; float* cc2 = L + 8320;
    const float* lam_re = a.in[6 + zero] + (size_t)(l * 32 + g) * 64; const float* lam_im = a.in[7 + zero] + (size_t)(l * 32 + g) * 64;
    const float* b_re = a.in[9 + zero] + (size_t)(l * 32 + g) * 1024; const float* b_im = a.in[10 + zero] + (size_t)(l * 32 + g) * 1024;
    const float* c_re = a.in[11 + zero] + (size_t)(l * 32 + g) * 1024; const float* c_im = a.in[12 + zero] + (size_t)(l * 32 + g) * 1024;
    const float ldt = a.in[8 + zero][l * 32 + g];
    const double INV_2PI = 0.15915494309189533577, TWO_PI = 6.283185307179586476925;
    float brv[2], biv[2], crv[2], civ[2], lrv[5], liv[5];
#pragma unroll
    for (int q = 0; q < 2; ++q) { const int i = tid + NTHR * q; brv[q] = b_re[i]; biv[q] = b_im[i]; crv[q] = c_re[i]; civ[q] = c_im[i]; }
#pragma unroll
    for (int q = 0; q < 5; ++q) { const int i = tid + NTHR * q, p = i & 63; lrv[q] = lam_re[p]; liv[q] = lam_im[p]; }
    const float dt = expf(ldt);
#pragma unroll
    for (int q = 0; q < 2; ++q) { const int i = tid + NTHR * q, p = i >> 4; const float lr = lam_re[p], li = lam_im[p];
        const double angle = (double)li * (double)dt; const double rr = angle - TWO_PI * rint(angle * INV_2PI);
        float sn, cs; sincosf((float)rr, &sn, &cs); const float mag = expf(lr * dt);
        const float nr = mag * cs - 1.0f, ni = mag * sn, den = lr * lr + li * li;
        const float cr = (nr * lr + ni * li) / den, ci = (ni * lr - nr * li) / den;
        bb[i * 2] = cr * brv[q] - ci * biv[q]; bb[i * 2 + 1] = cr * biv[q] + ci * brv[q];
        cc[i * 2] = crv[q]; cc[i * 2 + 1] = civ[q]; { const int cI = i >> 6, pI = i & 63; cc2[(pI * 16 + cI) * 2] = crv[q]; cc2[(pI * 16 + cI) * 2 + 1] = civ[q]; } }
#pragma unroll
    for (int q = 0; q < 5; ++q) { const int i = tid + NTHR * q; if (i < 33 * 64) { const int j = i >> 6;
        const double angle = (double)liv[q] * (double)dt * (double)j; const double rr = angle - TWO_PI * rint(angle * INV_2PI);
        float sn, cs; sincosf((float)rr, &sn, &cs); const float mag = expf(lrv[q] * dt * (float)j);
        pw[i * 2] = mag * cs; pw[i * 2 + 1] = mag * sn; } }
    __syncthreads();
    bf16* KT = (bf16*)(tab + TB_KT) + (size_t)g * 32 * 256; bf16* E = (bf16*)(tab + TB_E) + (size_t)g * 128 * 512; bf16* P = (bf16*)(tab + TB_P) + (size_t)g * 512 * 128;
    float* AT = (float*)(tab + TB_AT) + g * 128;
    { const int j = tid >> 4, c = tid & 15; float acc16[16];
#pragma unroll
      for (int q = 0; q < 16; ++q) acc16[q] = 0.f;
      for (int p = 0; p < 64; ++p) { const float Cr = cc2[(p * 16 + c) * 2], Ci = cc2[(p * 16 + c) * 2 + 1], wr_ = pw[(j * 64 + p) * 2], wi_ = pw[(j * 64 + p) * 2 + 1];
          const float tr = Cr * wr_ - Ci * wi_, ti = Cr * wi_ + Ci * wr_; const f32x4* b4 = (const f32x4*)(bb + p * 32);
#pragma unroll
          for (int q = 0; q < 8; ++q) { const f32x4 bv = b4[q]; acc16[2 * q] += tr * bv.x - ti * bv.y; acc16[2 * q + 1] += tr * bv.z - ti * bv.w; } }
      u32x4 o0, o1; o0.x = pk2(acc16[0], acc16[1]); o0.y = pk2(acc16[2], acc16[3]); o0.z = pk2(acc16[4], acc16[5]); o0.w = pk2(acc16[6], acc16[7]);
      o1.x = pk2(acc16[8], acc16[9]); o1.y = pk2(acc16[10], acc16[11]); o1.z = pk2(acc16[12], acc16[13]); o1.w = pk2(acc16[14], acc16[15]);
      *(u32x4*)(KT + (size_t)tid * 16) = o0; *(u32x4*)(KT + (size_t)tid * 16 + 8) = o1; }
    for (int i8 = tid; i8 < 128 * 64; i8 += NTHR) { const int row = i8 >> 6, k8 = i8 & 63, p = row & 63, s_ = k8 >> 1, c0 = (k8 & 1) * 8, j = 31 - s_;
        const float wr_ = pw[(j * 64 + p) * 2], wi_ = pw[(j * 64 + p) * 2 + 1]; const f32x4* b4 = (const f32x4*)(bb + (p * 16 + c0) * 2); float v[8];
#pragma unroll
        for (int q = 0; q < 4; ++q) { const f32x4 bv = b4[q];
            v[2 * q] = (row < 64) ? (wr_ * bv.x - wi_ * bv.y) : (wr_ * bv.y + wi_ * bv.x); v[2 * q + 1] = (row < 64) ? (wr_ * bv.z - wi_ * bv.w) : (wr_ * bv.w + wi_ * bv.z); }
        u32x4 o; o.x = pk2(v[0], v[1]); o.y = pk2(v[2], v[3]); o.z = pk2(v[4], v[5]); o.w = pk2(v[6], v[7]);
        *(u32x4*)(E + (size_t)i8 * 8) = o; }
    for (int i8 = tid; i8 < 512 * 16; i8 += NTHR) { const int row = i8 >> 4, q0 = (i8 & 15) * 8, p0 = q0 & 63, t = row >> 4, c = row & 15, j = t + 1;
        const f32x4* c4 = (const f32x4*)(cc + (c * 64 + p0) * 2); const f32x4* w4 = (const f32x4*)(pw + (j * 64 + p0) * 2); float v[8];
#pragma unroll
        for (int q = 0; q < 4; ++q) { const f32x4 cv = c4[q], wv = w4[q];
            v[2 * q] = (q0 < 64) ? (cv.x * wv.x - cv.y * wv.y) : -(cv.x * wv.y + cv.y * wv.x); v[2 * q + 1] = (q0 < 64) ? (cv.z * wv.z - cv.w * wv.w) : -(cv.z * wv.w + cv.w * wv.z); }
        u32x4 o; o.x = pk2(v[0], v[1]); o.y = pk2(v[2], v[3]); o.z = pk2(v[4], v[5]); o.w = pk2(v[6], v[7]);
        *(u32x4*)(P + (size_t)i8 * 8) = o; }
    if (tid < 64) { AT[tid] = pw[(32 * 64 + tid) * 2]; AT[64 + tid] = pw[(32 * 64 + tid) * 2 + 1]; }
    __syncthreads();
}

constexpr int QP = 72, VP = 400;
constexpr int LK_OFF = 0, LV_OFF = 384 * QP * 2;
constexpr size_t QPLANE = (size_t)2 * 3 * 8 * 8192 * 64;
struct AttnItem { int n0; size_t qrow0; };
__device__ __forceinline__ AttnItem attn_decode(int sit) {
    AttnItem A; int it = sit; const int rn2 = it & 31; it >>= 5; const int h = it & 7; it >>= 3; const int gi = it % 3, b = it / 3;
    const int dsh = 2 * gi, psh = 5 - dsh;
    const int r = rn2 >> psh; A.n0 = 2 * (rn2 & ((1 << psh) - 1));
    A.qrow0 = ((size_t)(b * 3 + gi) * 8 + h) * 8192 + (size_t)r * (8192 >> dsh) + 128 * A.n0;
    return A;
}
__device__ __forceinline__ void attn_load(const AttnItem& A, const bf16* QH, int tid, u32x4 (&kv)[6], u32x4 (&vv)[6]) {
    const bf16* kp = QH + QPLANE + (A.qrow0 - 128) * 64 + tid * 8;
#pragma unroll
    for (int rd = 0; rd < 6; ++rd) {
        if (A.n0 > 0 || rd >= 2) { kv[rd] = *(const u32x4*)(kp + rd * 4096); vv[rd] = *(const u32x4*)(kp + QPLANE + rd * 4096); }
        else { kv[rd] = (u32x4){0u, 0u, 0u, 0u}; vv[rd] = (u32x4){0u, 0u, 0u, 0u}; } }
}
__device__ __forceinline__ void attn_stage(const float* gk, unsigned char* lds, int tid, const u32x4 (&kv)[6], const u32x4 (&vv)[6]) {
    asm volatile("" : "+v"(tid));
    bf16* Ks = (bf16*)(lds + LK_OFF); bf16* Vt = (bf16*)(lds + LV_OFF);
    const int chunk = tid & 7, rowi = tid >> 3;
    float gkv[8];
#pragma unroll
    for (int i = 0; i < 8; ++i) gkv[i] = gk[chunk * 8 + i];
#pragma unroll
    for (int rd = 0; rd < 6; ++rd) { float f[8]; f[0] = bflo(kv[rd].x); f[1] = bfhi(kv[rd].x); f[2] = bflo(kv[rd].y); f[3] = bfhi(kv[rd].y); f[4] = bflo(kv[rd].z); f[5] = bfhi(kv[rd].z); f[6] = bflo(kv[rd].w); f[7] = bfhi(kv[rd].w);
        float ss = 0.f;
#pragma unroll
        for (int i = 0; i < 8; ++i) ss += f[i] * f[i];
        ss += __shfl_xor(ss, 1); ss += __shfl_xor(ss, 2); ss += __shfl_xor(ss, 4);
        const float rs = rsqrtf(ss * (1.f / 64.f) + EPS);
        u32x4 w; w.x = pk2(f[0] * rs * gkv[0], f[1] * rs * gkv[1]); w.y = pk2(f[2] * rs * gkv[2], f[3] * rs * gkv[3]); w.z = pk2(f[4] * rs * gkv[4], f[5] * rs * gkv[5]); w.w = pk2(f[6] * rs * gkv[6], f[7] * rs * gkv[7]);
        const int ki = rowi + 64 * rd;
        *(u32x4*)(Ks + ki * QP + chunk * 8) = w;
        bf16* vp = Vt + (chunk * 8) * VP + (ki ^ (chunk << 2));
        vp[0 * VP] = (bf16)(vv[rd].x & 0xffffu); vp[1 * VP] = (bf16)(vv[rd].x >> 16); vp[2 * VP] = (bf16)(vv[rd].y & 0xffffu); vp[3 * VP] = (bf16)(vv[rd].y >> 16);
        vp[4 * VP] = (bf16)(vv[rd].z & 0xffffu); vp[5 * VP] = (bf16)(vv[rd].z >> 16); vp[6 * VP] = (bf16)(vv[rd].w & 0xffffu); vp[7 * VP] = (bf16)(vv[rd].w >> 16); }
}
__device__ __forceinline__ void attn_qload(const AttnItem& A, const bf16* QH, int tid, u32x4 (&qr)[4]) {
    const int w = tid >> 6, lane = tid & 63, fr = lane & 15, fq = lane >> 4;
#pragma unroll
    for (int m2 = 0; m2 < 2; ++m2) { const bf16* p = QH + (A.qrow0 + 32 * w + 16 * m2 + fr) * 64 + 8 * fq; qr[2 * m2] = *(const u32x4*)p; qr[2 * m2 + 1] = *(const u32x4*)(p + 32); }
}
__device__ __forceinline__ void attn_tile2(const AttnItem& A, const u32x4 (&qr)[4], const float* gq, bf16* QH, float* LSE, unsigned char* lds, int tid) {
    asm volatile("" : "+v"(tid));
    const bf16* Ks = (const bf16*)(lds + LK_OFF); const bf16* Vt = (const bf16*)(lds + LV_OFF);
    const int w = tid >> 6, lane = tid & 63, fr = lane & 15, fq = lane >> 4;
    const int kt0 = (2 * w < 14) ? 2 * w : 14;
    bf16x8 qf[2][2];
    { const f32x4 g0 = *(const f32x4*)(gq + 8 * fq), g1 = *(const f32x4*)(gq + 8 * fq + 4), g2 = *(const f32x4*)(gq + 32 + 8 * fq), g3 = *(const f32x4*)(gq + 32 + 8 * fq + 4);
#pragma unroll
      for (int m = 0; m < 2; ++m) { const u32x4 q0 = qr[2 * m], q1 = qr[2 * m + 1];
        float f[16]; f[0] = bflo(q0.x); f[1] = bfhi(q0.x); f[2] = bflo(q0.y); f[3] = bfhi(q0.y); f[4] = bflo(q0.z); f[5] = bfhi(q0.z); f[6] = bflo(q0.w); f[7] = bfhi(q0.w);
        f[8] = bflo(q1.x); f[9] = bfhi(q1.x); f[10] = bflo(q1.y); f[11] = bfhi(q1.y); f[12] = bflo(q1.z); f[13] = bfhi(q1.z); f[14] = bflo(q1.w); f[15] = bfhi(q1.w);
        float ss = 0.f;
#pragma unroll
        for (int i = 0; i < 16; ++i) ss += f[i] * f[i];
        ss += __shfl_xor(ss, 16); ss += __shfl_xor(ss, 32);
        const float rs = rsqrtf(ss * (1.f / 64.f) + EPS) * 0.125f;
        u32x4 a, c;
        a.x = pk2(f[0] * rs * g0.x, f[1] * rs * g0.y); a.y = pk2(f[2] * rs * g0.z, f[3] * rs * g0.w); a.z = pk2(f[4] * rs * g1.x, f[5] * rs * g1.y); a.w = pk2(f[6] * rs * g1.z, f[7] * rs * g1.w);
        c.x = pk2(f[8] * rs * g2.x, f[9] * rs * g2.y); c.y = pk2(f[10] * rs * g2.z, f[11] * rs * g2.w); c.z = pk2(f[12] * rs * g3.x, f[13] * rs * g3.y); c.w = pk2(f[14] * rs * g3.z, f[15] * rs * g3.w);
        qf[m][0] = __builtin_bit_cast(bf16x8, a); qf[m][1] = __builtin_bit_cast(bf16x8, c); } }
    f32x4 s[2][10];
#pragma unroll
    for (int m = 0; m < 2; ++m)
#pragma unroll
        for (int t = 0; t < 10; ++t) s[m][t] = (f32x4){0.f, 0.f, 0.f, 0.f};
    {
        bf16x8 kf[2][4];
        const bf16* kb0 = Ks + (16 * kt0 + fr) * QP + 8 * fq;
#define ATT_LDK(pr, sl) do { _Pragma("unroll") for (int tt = 0; tt < 2; ++tt) _Pragma("unroll") for (int kk = 0; kk < 2; ++kk) kf[sl][tt * 2 + kk] = *(const bf16x8*)(kb0 + (16 * (2 * (pr) + tt)) * QP + 32 * kk); } while (0)
        ATT_LDK(0, 0);
#pragma unroll
        for (int pr = 0; pr < 5; ++pr) {
            if (pr + 1 < 5) ATT_LDK(pr + 1, (pr + 1) & 1);
            __builtin_amdgcn_sched_barrier(0);
#pragma unroll
            for (int tt = 0; tt < 2; ++tt)
#pragma unroll
                for (int kk = 0; kk < 2; ++kk)
#pragma unroll
                    for (int m = 0; m < 2; ++m) s[m][2 * pr + tt] = __builtin_amdgcn_mfma_f32_16x16x32_bf16(kf[pr & 1][tt * 2 + kk], qf[m][kk], s[m][2 * pr + tt], 0, 0, 0);
            __builtin_amdgcn_sched_barrier(0);
        }
#undef ATT_LDK
    }
    float mx[2], sum[2];
#pragma unroll
    for (int m = 0; m < 2; ++m) {
        const int qi = 32 * w + 16 * m + fr;
        const int dbase = 16 * kt0 + 4 * fq - qi, kbase = 16 * kt0 + 4 * fq - ((A.n0 > 0) ? 0 : 128);
        float mxv = -INFINITY;
#pragma unroll
        for (int t = 0; t < 10; ++t)
#pragma unroll
            for (int j = 0; j < 4; ++j) { const int dlt = dbase + 16 * t + j; const int bad = (dlt | (128 - dlt) | (kbase + 16 * t + j)) >> 31;
                s[m][t][j] += __int_as_float(bad & (int)0xff800000); mxv = fmaxf(mxv, s[m][t][j]); }
        mx[m] = mxv; }
#pragma unroll
    for (int m = 0; m < 2; ++m) { mx[m] = fmaxf(mx[m], __shfl_xor(mx[m], 16)); mx[m] = fmaxf(mx[m], __shfl_xor(mx[m], 32)); }
#pragma unroll
    for (int m = 0; m < 2; ++m) { float sm = 0.f;
#pragma unroll
        for (int t = 0; t < 10; ++t)
#pragma unroll
            for (int j = 0; j < 4; ++j) { const float p = __builtin_amdgcn_exp2f((s[m][t][j] - mx[m]) * 1.44269504089f); s[m][t][j] = p; sm += p; }
        sum[m] = sm; }
#pragma unroll
    for (int m = 0; m < 2; ++m) { sum[m] += __shfl_xor(sum[m], 16); sum[m] += __shfl_xor(sum[m], 32); }
    f32x4 o[2][4];
#pragma unroll
    for (int m = 0; m < 2; ++m)
#pragma unroll
        for (int dt = 0; dt < 4; ++dt) o[m][dt] = (f32x4){0.f, 0.f, 0.f, 0.f};
    {
        u32x4 vf[2][4];
#define ATT_LDV(jj_, sl) do { _Pragma("unroll") for (int dt = 0; dt < 4; ++dt) { const int dd = 16 * dt + fr, sw = ((dd >> 3) & 7) << 2, kb = 32 * (kt0 / 2 + (jj_)) + 4 * fq; const bf16* vr = Vt + dd * VP; \
            const u32x2 lo = *(const u32x2*)(vr + (kb ^ sw)), hi = *(const u32x2*)(vr + ((kb + 16) ^ sw)); vf[sl][dt] = (u32x4){lo.x, lo.y, hi.x, hi.y}; } } while (0)
        ATT_LDV(0, 0);
#pragma unroll
        for (int jj = 0; jj < 5; ++jj) {
            if (jj + 1 < 5) ATT_LDV(jj + 1, (jj + 1) & 1);
            bf16x8 pf[2];
#pragma unroll
            for (int m = 0; m < 2; ++m) { u32x4 pw; pw.x = pk2(s[m][2 * jj][0], s[m][2 * jj][1]); pw.y = pk2(s[m][2 * jj][2], s[m][2 * jj][3]); pw.z = pk2(s[m][2 * jj + 1][0], s[m][2 * jj + 1][1]); pw.w = pk2(s[m][2 * jj + 1][2], s[m][2 * jj + 1][3]);
                pf[m] = __builtin_bit_cast(bf16x8, pw); }
            __builtin_amdgcn_sched_barrier(0);
#pragma unroll
            for (int dt = 0; dt < 4; ++dt)
#pragma unroll
                for (int m = 0; m < 2; ++m) o[m][dt] = __builtin_amdgcn_mfma_f32_16x16x32_bf16(__builtin_bit_cast(bf16x8, vf[jj & 1][dt]), pf[m], o[m][dt], 0, 0, 0);
            __builtin_amdgcn_sched_barrier(0);
        }
#undef ATT_LDV
    }
#pragma unroll
    for (int m = 0; m < 2; ++m) {
        const float inv = 1.0f / sum[m];
        const size_t prow = A.qrow0 + 32 * w + 16 * m + fr;
        bf16* op = QH + prow * 64 + 4 * fq;
#pragma unroll
        for (int dt = 0; dt < 4; ++dt) { u32x2 w2; w2.x = pk2(o[m][dt][0] * inv, o[m][dt][1] * inv); w2.y = pk2(o[m][dt][2] * inv, o[m][dt][3] * inv); *(u32x2*)(op + 16 * dt) = w2; }
        if (fq == 0) LSE[prow] = mx[m] + logf(sum[m]);
    }
}

constexpr int ULP = 520;
__device__ __forceinline__ void ssm_stage_u(const bf16* UH, int g, int mt, unsigned char* lds, int tid) {
    const bf16* src = UH + ((size_t)g * 16384 + (size_t)mt * 2048) * 16;
    u32x4 v[8];
#pragma unroll
    for (int k = 0; k < 8; ++k) v[k] = *(const u32x4*)(src + (size_t)(tid + NTHR * k) * 8);
#pragma unroll
    for (int k = 0; k < 8; ++k) { const int i = tid + NTHR * k; *(u32x4*)(lds + (i >> 6) * (ULP * 2) + (i & 63) * 16) = v[k]; }
}
__device__ __forceinline__ void ssm_s1_item(int item, const bf16* UH, unsigned char* ws, const unsigned char* tab, unsigned char* lds, int tid) {
    const int g = item >> 3, mt = item & 7, w = tid >> 6, lane = tid & 63, fr = lane & 15, fq = lane >> 4;
    const bf16* E = (const bf16*)(tab + TB_E) + (size_t)g * 128 * 512; float* S = (float*)(ws + WS_S);
    const bf16* ep = E + (size_t)(16 * w + fr) * 512 + 8 * fq;
    bf16x8 ef[16];
#pragma unroll
    for (int ks = 0; ks < 16; ++ks) ef[ks] = *(const bf16x8*)(ep + 32 * ks);
    ssm_stage_u(UH, g, mt, lds, tid);
    __syncthreads();
    const bf16* UL = (const bf16*)lds;
    f32x4 acc[4];
#pragma unroll
    for (int mi = 0; mi < 4; ++mi) acc[mi] = (f32x4){0.f, 0.f, 0.f, 0.f};
#pragma unroll
    for (int ks = 0; ks < 16; ++ks)
#pragma unroll
        for (int mi = 0; mi < 4; ++mi) { const bf16x8 uf = *(const bf16x8*)(UL + (16 * mi + fr) * ULP + (2 * ks + (fq >> 1)) * 16 + 8 * (fq & 1)); acc[mi] = __builtin_amdgcn_mfma_f32_16x16x32_bf16(ef[ks], uf, acc[mi], 0, 0, 0); }
#pragma unroll
    for (int mi = 0; mi < 4; ++mi) *(f32x4*)(S + ((size_t)(64 * mt + 16 * mi + fr) * 32 + g) * 128 + 16 * w + 4 * fq) = acc[mi];
    __syncthreads();
}

__device__ __forceinline__ void ssm_carry_item(int item, unsigned char* ws, const unsigned char* tab, float* L, int tid) {
    const int b = item >> 5, g = item & 31;
    const float* S = (const float*)(ws + WS_S); bf16* XP = (bf16*)(ws + WS_XP); const float* AT = (const float*)(tab + TB_AT) + g * 128;
#pragma unroll 4
    for (int i = 0; i < 16; ++i) { const int idx = i * NTHR + tid, k = idx >> 5, q4 = idx & 31;
        *(f32x4*)(L + k * 128 + 4 * q4) = *(const f32x4*)(S + ((size_t)(b * CHB + k) * 32 + g) * 128 + 4 * q4); }
    __syncthreads();
    const int w = tid >> 6, p = tid & 63; float* EB = L + 32768 + 8;
    const float ar = AT[p], ai = AT[64 + p];
    { float xr = 0.f, xi = 0.f;
#pragma unroll 8
      for (int j = 0; j < 32; ++j) { const int k = 32 * w + j; const float sr = L[k * 128 + p], si = L[k * 128 + 64 + p];
          L[k * 128 + p] = xr; L[k * 128 + 64 + p] = xi;
          const float nr = ar * xr - ai * xi + sr, ni = ar * xi + ai * xr + si; xr = nr; xi = ni; }
      EB[w * 128 + p] = xr; EB[w * 128 + 64 + p] = xi; }
    __syncthreads();
    float cr = 0.f, ci = 0.f;
    { float br = ar, bi = ai;
#pragma unroll
      for (int q = 0; q < 5; ++q) { const float t = br * br - bi * bi; bi = 2.f * br * bi; br = t; }
      for (int v = 0; v < w; ++v) { const float er = EB[v * 128 + p], ei = EB[v * 128 + 64 + p]; const float nr = br * cr - bi * ci + er, ni = br * ci + bi * cr + ei; cr = nr; ci = ni; } }
    { float pr = 1.f, pi = 0.f; bf16* xo = XP + ((size_t)(b * CHB + 32 * w) * 32 + g) * 128 + p;
#pragma unroll 8
      for (int j = 0; j < 32; ++j) { const int k = 32 * w + j; const float xr = L[k * 128 + p] + (pr * cr - pi * ci), xi = L[k * 128 + 64 + p] + (pr * ci + pi * cr);
          xo[(size_t)j * 32 * 128] = (bf16)f2bf(xr); xo[(size_t)j * 32 * 128 + 64] = (bf16)f2bf(xi);
          const float t = pr * ar - pi * ai; pi = pr * ai + pi * ar; pr = t; } }
    __syncthreads();
}

__device__ __forceinline__ void phase_merge(const bf16* QH, bf16* Aout, const float* LSE, int vt, int nvt) {
    constexpr int UN = 2;
    for (int i0 = vt; i0 < MTOK * 64; i0 += UN * nvt) {
        float l[UN][3]; u32x4 av[UN][3];
#pragma unroll
        for (int q = 0; q < UN; ++q) { const int i = i0 + q * nvt; if (i < MTOK * 64) { const int row = i >> 6, h = (i >> 3) & 7, ch = i & 7, b = row >> 13, t = row & 8191;
            const size_t r0 = ((size_t)(b * 3 + 0) * 8 + h) * 8192 + t;
            const size_t r1 = ((size_t)(b * 3 + 1) * 8 + h) * 8192 + ((t & 3) << 11) + (t >> 2);
            const size_t r2 = ((size_t)(b * 3 + 2) * 8 + h) * 8192 + ((t & 15) << 9) + (t >> 4);
            l[q][0] = LSE[r0]; l[q][1] = LSE[r1]; l[q][2] = LSE[r2];
            av[q][0] = *(const u32x4*)(QH + r0 * 64 + ch * 8); av[q][1] = *(const u32x4*)(QH + r1 * 64 + ch * 8); av[q][2] = *(const u32x4*)(QH + r2 * 64 + ch * 8); }
          else { l[q][0] = l[q][1] = l[q][2] = 0.f; av[q][0] = av[q][1] = av[q][2] = (u32x4){0u, 0u, 0u, 0u}; } }
#pragma unroll
        for (int q = 0; q < UN; ++q) { const int i = i0 + q * nvt; if (i < MTOK * 64) { const int row = i >> 6, h = (i >> 3) & 7, ch = i & 7;
            const float l0 = l[q][0], l1 = l[q][1], l2 = l[q][2];
            const float mx = fmaxf(l0, fmaxf(l1, l2)); float w0 = expf(l0 - mx), w1 = expf(l1 - mx), w2 = expf(l2 - mx); const float inv = 1.0f / (w0 + w1 + w2); w0 *= inv; w1 *= inv; w2 *= inv;
            const u32x4 a0 = av[q][0], a1 = av[q][1], a2 = av[q][2];
            u32x4 o;
            o.x = pk2(w0 * bflo(a0.x) + w1 * bflo(a1.x) + w2 * bflo(a2.x), w0 * bfhi(a0.x) + w1 * bfhi(a1.x) + w2 * bfhi(a2.x));
            o.y = pk2(w0 * bflo(a0.y) + w1 * bflo(a1.y) + w2 * bflo(a2.y), w0 * bfhi(a0.y) + w1 * bfhi(a1.y) + w2 * bfhi(a2.y));
            o.z = pk2(w0 * bflo(a0.z) + w1 * bflo(a1.z) + w2 * bflo(a2.z), w0 * bfhi(a0.z) + w1 * bfhi(a1.z) + w2 * bfhi(a2.z));
            o.w = pk2(w0 * bflo(a0.w) + w1 * bflo(a1.w) + w2 * bflo(a2.w), w0 * bfhi(a0.w) + w1 * bfhi(a1.w) + w2 * bfhi(a2.w));
            *(u32x4*)(Aout + (size_t)row * AW + h * 64 + ch * 8) = o; } }
    }
}

__device__ __forceinline__ float gelu_tanh(float y) { const float z = 1.5957691216f * (y + 0.044715f * y * y * y); return y * __builtin_amdgcn_rcpf(1.0f + __builtin_amdgcn_exp2f(-1.44269504089f * z)); }
constexpr int XLP = 136;
constexpr int S3_XL = 64 * ULP * 2, S3_KL = S3_XL + 64 * XLP * 2;
__device__ __forceinline__ void ssm_s3_item(int item, const float* dskip, const bf16* UH, bf16* Y, unsigned char* ws, const unsigned char* tab, unsigned char* lds, int tid) {
    const int g = item >> 3, mt = item & 7, w = tid >> 6, lane = tid & 63, fr = lane & 15, fq = lane >> 4;
    const bf16* KT = (const bf16*)(tab + TB_KT) + (size_t)g * 32 * 256; const bf16* P = (const bf16*)(tab + TB_P) + (size_t)g * 512 * 128; const bf16* XP = (const bf16*)(ws + WS_XP);
    { u32x4 xv[2], kv2[2];
#pragma unroll
      for (int k = 0; k < 2; ++k) { const int i = tid + NTHR * k; xv[k] = *(const u32x4*)(XP + ((size_t)(64 * mt + (i >> 4)) * 32 + g) * 128 + (i & 15) * 8); kv2[k] = *(const u32x4*)(KT + (size_t)i * 8); }
      ssm_stage_u(UH, g, mt, lds, tid);
#pragma unroll
      for (int k = 0; k < 2; ++k) { const int i = tid + NTHR * k; *(u32x4*)(lds + S3_XL + (i >> 4) * (XLP * 2) + (i & 15) * 16) = xv[k]; *(u32x4*)(lds + S3_KL + i * 16) = kv2[k]; } }
    const float* dsk = dskip + g * 16 + 4 * fq;
    const float d0 = dsk[0], d1 = dsk[1], d2 = dsk[2], d3 = dsk[3];
    __syncthreads();
    const bf16* UL = (const bf16*)lds; const bf16* XL = (const bf16*)(lds + S3_XL); const bf16* KL = (const bf16*)(lds + S3_KL);
    const int shalf = fq >> 1, c20 = 8 * (fq & 1);
#pragma unroll 1
    for (int ti = 0; ti < 4; ++ti) {
        const int t = (ti == 0) ? w : (ti == 1) ? 15 - w : (ti == 2) ? 16 + w : 31 - w;
        bf16x8 pf[4];
#pragma unroll
        for (int k2 = 0; k2 < 4; ++k2) pf[k2] = *(const bf16x8*)(P + (size_t)(t * 16 + fr) * 128 + 32 * k2 + 8 * fq);
        f32x4 acc[4];
#pragma unroll
        for (int mi = 0; mi < 4; ++mi) acc[mi] = (f32x4){0.f, 0.f, 0.f, 0.f};
        const int nks = (t >> 1) + 1;
#pragma unroll 2
        for (int ks = 0; ks < nks; ++ks) {
            const int s = 2 * ks + shalf, lag = t - s;
            bf16x8 wf = (bf16x8){0, 0, 0, 0, 0, 0, 0, 0};
            if (lag >= 0) wf = *(const bf16x8*)(KL + lag * 256 + fr * 16 + c20);
#pragma unroll
            for (int mi = 0; mi < 4; ++mi) { const bf16x8 uf = *(const bf16x8*)(UL + (16 * mi + fr) * ULP + s * 16 + c20);
                acc[mi] = __builtin_amdgcn_mfma_f32_16x16x32_bf16(wf, uf, acc[mi], 0, 0, 0); }
        }
#pragma unroll
        for (int k2 = 0; k2 < 4; ++k2)
#pragma unroll
            for (int mi = 0; mi < 4; ++mi) { const bf16x8 xf = *(const bf16x8*)(XL + (16 * mi + fr) * XLP + 32 * k2 + 8 * fq);
                acc[mi] = __builtin_amdgcn_mfma_f32_16x16x32_bf16(pf[k2], xf, acc[mi], 0, 0, 0); }
#pragma unroll
        for (int mi = 0; mi < 4; ++mi) { const size_t tok = (size_t)(64 * mt + 16 * mi + fr) * TC + t;
            const u32x2 uu = *(const u32x2*)(UL + (16 * mi + fr) * ULP + t * 16 + 4 * fq);
            const float y0 = acc[mi][0] + d0 * bflo(uu.x), y1 = acc[mi][1] + d1 * bfhi(uu.x), y2 = acc[mi][2] + d2 * bflo(uu.y), y3 = acc[mi][3] + d3 * bfhi(uu.y);
            u32x2 o; o.x = pk2(gelu_tanh(y0), gelu_tanh(y1)); o.y = pk2(gelu_tanh(y2), gelu_tanh(y3));
            *(u32x2*)(Y + tok * AW + 16 * g + 4 * fq) = o; }
    }
    __syncthreads();
}

#define XB_TMO      128
#define XB_XCNT(j)  (256  + 64 * (j))
#define XB_XSUB(j)  (1280 + 64 * (j))
#define XB_XGEN(j)  (2304 + 64 * (j))
#define XB_TOP      3328
#define XB_TOPGEN   3392
#define XCD_BAR_WORDS 3456
#define XB_SPIN_CAP (1u << 20)
__device__ __forceinline__ unsigned xb_ld(unsigned* p)              { return __hip_atomic_load(p, __ATOMIC_RELAXED, __HIP_MEMORY_SCOPE_AGENT); }
__device__ __forceinline__ unsigned xb_add(unsigned* p, unsigned v) { return __hip_atomic_fetch_add(p, v, __ATOMIC_RELAXED, __HIP_MEMORY_SCOPE_AGENT); }
__device__ __forceinline__ unsigned xb_xcc_id() { return (unsigned)__builtin_amdgcn_s_getreg((3 << 11) | 20) & 0xFu; }
#define XB_SPIN(cond, bar) do { unsigned _sp = 0; while (cond) { __builtin_amdgcn_s_sleep(1); \
    if ((++_sp & 255u) == 0u) { if (xb_ld(&(bar)[XB_TMO])) break; if (_sp > XB_SPIN_CAP) { atomicAdd(&(bar)[XB_TMO], 1u); break; } } } } while (0)
struct XcdBarrier { unsigned* bar; unsigned x; volatile LAS unsigned* st; };
__device__ __forceinline__ XcdBarrier xcd_barrier_post(unsigned* bar, volatile LAS unsigned* st) {
    XcdBarrier b; b.bar = bar; b.x = xb_xcc_id(); b.st = st;
    if (threadIdx.x == 0) (void)xb_add(&bar[XB_XCNT(b.x)], 1u);
    return b;
}
__device__ __forceinline__ void xcd_barrier_complete(unsigned* bar, unsigned x, unsigned& nloc, unsigned& nx) {
    const unsigned G = gridDim.x * gridDim.y * gridDim.z;
    unsigned sum, cnt, mine, sp = 0u;
    for (;;) {
        sum = 0u; cnt = 0u; mine = 0u;
#pragma unroll
        for (unsigned j = 0; j < 16; ++j) { const unsigned c = xb_ld(&bar[XB_XCNT(j)]); sum += c; cnt += (c > 0u) ? 1u : 0u; mine = (j == x) ? c : mine; }
        if (sum == G) break;
        __builtin_amdgcn_s_sleep(1);
        if ((++sp & 255u) == 0u) { if (xb_ld(&bar[XB_TMO])) break; if (sp > XB_SPIN_CAP) { atomicAdd(&bar[XB_TMO], 1u); break; } }
    }
    nloc = mine > 0u ? mine : 1u; nx = cnt > 0u ? cnt : 1u;
}
__device__ __forceinline__ void xcd_barrier(const XcdBarrier& b) {
    asm volatile("s_waitcnt vmcnt(0)" ::: "memory");
    __syncthreads();
    if (threadIdx.x == 0) {
        unsigned* bar = b.bar;
        __builtin_amdgcn_s_waitcnt(0);
        unsigned nloc = b.st[0], nx = b.st[1];
        if (nloc == 0u) { xcd_barrier_complete(bar, b.x, nloc, nx); b.st[0] = nloc; b.st[1] = nx; }
        const unsigned old = xb_add(&bar[XB_XSUB(b.x)], 1u);
        const unsigned gen = old / nloc;
        if (old + 1u == (gen + 1u) * nloc) {
            __builtin_amdgcn_fence(__ATOMIC_RELEASE, "agent");
            asm volatile("s_waitcnt vmcnt(0)" ::: "memory");
            const unsigned og = xb_add(&bar[XB_TOP], 1u);
            const unsigned tg = og / nx;
            if (og + 1u == (tg + 1u) * nx) xb_add(&bar[XB_TOPGEN], 1u);
            else XB_SPIN(xb_ld(&bar[XB_TOPGEN]) == tg, bar);
            __builtin_amdgcn_fence(__ATOMIC_ACQUIRE, "agent");
            xb_add(&bar[XB_XGEN(b.x)], 1u);
            asm volatile("s_waitcnt vmcnt(0)" ::: "memory");
        } else {
            XB_SPIN(xb_ld(&bar[XB_XGEN(b.x)]) == gen, bar);
            __builtin_amdgcn_fence(__ATOMIC_ACQUIRE, "agent");
            asm volatile("s_waitcnt vmcnt(0)" ::: "memory");
        }
    }
    __syncthreads();
}

__device__ __forceinline__ void phase_stagger(int bx) {
    const unsigned long long t0 = __builtin_amdgcn_s_memrealtime(), wait = (unsigned long long)(bx * 100);
    while (__builtin_amdgcn_s_memrealtime() - t0 < wait) __builtin_amdgcn_s_sleep(32);
}

constexpr int KPL = 8, KPLX = KPL + ((DUP_K >= 0) ? 1 : 0), N_PHASES = 1 + KPLX * DEPTH;
__global__ void __launch_bounds__(NTHR, 2) mega_fwd(Args a) {
    extern __shared__ __attribute__((aligned(16))) unsigned char lds[];
    cg::grid_group grid = cg::this_grid();
    LAS unsigned char* ldsl = (LAS unsigned char*)lds;
    volatile LAS unsigned* bst = (volatile LAS unsigned*)(ldsl + LDS_BYTES - 16);
    if (threadIdx.x < 2) bst[threadIdx.x] = 0u;
    __syncthreads();
    XcdBarrier xbar; xbar.bar = (unsigned*)a.ws; xbar.x = 0; xbar.st = bst;
    if (a.ph_hi - a.ph_lo > 1) xbar = xcd_barrier_post((unsigned*)a.ws, bst);
    int prep = 0;
    for (int ph = a.ph_lo; ph < a.ph_hi; ++ph) {
        int zero; asm volatile("s_mov_b32 %0, 0" : "=s"(zero));
        int tid = threadIdx.x; asm volatile("" : "+v"(tid));
        const int lane = tid & 63, wave = __builtin_amdgcn_readfirstlane(tid >> 6);
        const int G = (int)gridDim.x + zero, bx = (int)blockIdx.x + zero;
        const int gw = bx * NWAVES + wave, ngw = G * NWAVES;
        unsigned char* ws = a.ws + zero; float* outp = a.out + zero;
        bf16* WB = (bf16*)(ws + WS_WB); bf16* QH = (bf16*)(ws + WS_Z); bf16* UG = (bf16*)(ws + WS_Z + 144 * MiB); bf16* UH = (bf16*)(ws + WS_Z + 208 * MiB); bf16* AK = QH + QPLANE; bf16* ACT = (bf16*)(ws + WS_ACT); bf16* Y = AK + (size_t)MTOK * AW; float* LSE = (float*)(ws + WS_LSE);
        bf16* MIX = QH;
        float* SS1 = (float*)(ws + WS_S); float* SS2 = (float*)(ws + WS_S + MiB);
        if (ph == 0) {
            const bool wfill = (W_FILL != 0) && ((MTOK / 256) * (2 * DFF / 256) % G != 0);
            if (G >= 64) {
                if (bx < 32) ssm_pre_item(a, zero, 0, bx, ws + WS_TAB, (float*)lds, tid);
                else phase_weights(a, zero, WB, (float*)lds, (bx - 32) * NWAVES + wave, (G - 32) * NWAVES, wave, lane, 0, wfill ? 1 : DEPTH);
            } else {
                phase_weights(a, zero, WB, (float*)lds, gw, ngw, wave, lane, 0, wfill ? 1 : DEPTH);
                __syncthreads();
                for (int g = bx; g < 32; g += G) ssm_pre_item(a, zero, 0, g, ws + WS_TAB, (float*)lds, tid);
            }
            phase_xprep(a.in[zero], ACT, SS2, gw, ngw, lane);
        } else {
            const int l = (ph - 1) / KPLX, kp = (ph - 1) % KPLX, k = (DUP_K >= 0 && kp > DUP_K) ? kp - 1 : kp;
            const bf16* wl = WB + (size_t)l * LAYER_W;
            unsigned char* tab = ws + WS_TAB + (size_t)(l & 1) * TAB_STRIDE;
            if (W_FILL != 0 && k == 6 && l + 1 < DEPTH) {
                const int nu = (MTOK / 256) * (2 * DFF / 256), rem = nu - (nu / G) * G;
                if (rem != 0 && bx >= rem) { phase_weights(a, zero, WB, (float*)lds, (bx - rem) * NWAVES + wave, (G - rem) * NWAVES, wave, lane, l + 1, l + 2); __syncthreads(); }
            }
            if (k == 0) {
                pg8::Gemm gm{ACT, wl + OFF_IN, MTOK, INC, DM, DM}; pg8::StaticOrder S; S.init(MTOK, INC, G, bx, WGM_K0);
                PG8_LAS float* rst = (PG8_LAS float*)(ldsl + 131088); int pbase = 0;
                pbase = (bx & 7) * 2048;
                for (int i = tid; i < 2048; i += NTHR) rst[i] = pg8::row_rstd(SS2, (size_t)(pbase + i));
                __syncthreads();
                pg8::EpiZ E{QH, UG, UH, SS2, rst, pbase};
                if (K0_DELAY_US > 0 && ((bx >> 3) & 1)) phase_stagger(K0_DELAY_US);
                pg8::gemm_phase<pg8::EpiZ, pg8::StaticOrder, true, true>(ldsl, tid, gm, S, E);
            } else if (k == 1) {
                const float* gq = a.in[3 + zero] + l * 64; const float* gk = a.in[4 + zero] + l * 64;
                u32x4 kv[6], vv[6], qr[4], qn[4];
#pragma unroll
                for (int i = 0; i < 6; ++i) { kv[i] = (u32x4){0u, 0u, 0u, 0u}; vv[i] = (u32x4){0u, 0u, 0u, 0u}; qr[i & 3] = (u32x4){0u, 0u, 0u, 0u}; qn[i & 3] = (u32x4){0u, 0u, 0u, 0u}; }
                if (bx < 1536) { const AttnItem A0 = attn_decode(bx); attn_load(A0, QH, tid, kv, vv); attn_qload(A0, QH, tid, qn); }
                for (int it = bx; it < 1536; it += G) {
                    const AttnItem A = attn_decode(it);
                    attn_stage(gk, lds, tid, kv, vv);
#pragma unroll
                    for (int i = 0; i < 4; ++i) qr[i] = qn[i];
                    __builtin_amdgcn_sched_barrier(0);
                    __syncthreads();
                    if (it + G < 1536) { const AttnItem An = attn_decode(it + G); attn_load(An, QH, tid, kv, vv); attn_qload(An, QH, tid, qn); }
                    __builtin_amdgcn_sched_barrier(0);
                    attn_tile2(A, qr, gq, QH, LSE, lds, tid);
                    __builtin_amdgcn_sched_barrier(0);
                    __syncthreads();
                }
                for (int it = bx; it < 256; it += G) for (int rep = 0; rep < NREP(2); ++rep) ssm_s1_item(it, UH, ws, tab, lds, tid);
            } else if (k == 2) {
                if (G >= 256) {
                    if (bx < 64) { for (int rep = 0; rep < NREP(3); ++rep) ssm_carry_item(bx, ws, tab, (float*)lds, tid); }
                    else if (bx < 96) { if (l + 1 < DEPTH) for (int rep = 0; rep < NREP(11); ++rep) ssm_pre_item(a, zero, l + 1, bx - 64, ws + WS_TAB + (size_t)((l + 1) & 1) * TAB_STRIDE, (float*)lds, tid); }
                    else { for (int rep = 0; rep < NREP(10); ++rep) phase_merge(QH, AK, LSE, (bx - 96) * NTHR + tid, (G - 96) * NTHR); }
                } else {
                    for (int it = bx; it < 64; it += G) ssm_carry_item(it, ws, tab, (float*)lds, tid);
                    if (l + 1 < DEPTH) for (int g = bx; g < 32; g += G) ssm_pre_item(a, zero, l + 1, g, ws + WS_TAB + (size_t)((l + 1) & 1) * TAB_STRIDE, (float*)lds, tid);
                    phase_merge(QH, AK, LSE, bx * NTHR + tid, G * NTHR);
                }
            } else if (k == 3) {
                const float* dskip = a.in[13 + zero] + l * 512;
                for (int rep = 0; rep < NREP(4); ++rep) for (int it = bx; it < 256; it += G) ssm_s3_item(it, dskip, UH, Y, ws, tab, lds, tid);
            } else if (k == 4) {
                pg8::Gemm gm{AK, wl + OFF_P, 2 * MTOK, 3 * DM, AW, AW}; pg8::K4Order S; S.base.init(MTOK, DM, G, bx, WGM_S);
                pg8::EpiK4 E{pg8::EpiGate1{MIX, DM, (const unsigned char*)UG, UGP}, pg8::EpiGlu{MIX, DM, (const unsigned char*)UG + 1024, UGP}};
                pg8::gemm_phase<pg8::EpiK4, pg8::K4Order, true, true>(ldsl, tid, gm, S, E);
            } else if (k == 5) {
                pg8::Gemm gm{MIX, wl + OFF_OUT, MTOK, DM, DM, DM}; pg8::StaticOrder S; S.init(MTOK, DM, G, bx, WGM_S);
                pg8::EpiResid E{ACT, nullptr, DM, SS1};
                pg8::gemm_phase<pg8::EpiResid, pg8::StaticOrder, true, true>(ldsl, tid, gm, S, E);
            } else if (k == 6) {
                pg8::Gemm gm{ACT, wl + OFF_GU, MTOK, 2 * DFF, DM, DM}; pg8::StaticOrder S; S.init(MTOK, 2 * DFF, G, bx, WGM_K6);
                PG8_LAS float* rst = (PG8_LAS float*)(ldsl + 131088); int pbase = 0;
                pbase = (bx & 7) * 2048;
                for (int i = tid; i < 2048; i += NTHR) rst[i] = pg8::row_rstd(SS1, (size_t)(pbase + i));
                __syncthreads();
                pg8::EpiSwiglu E{QH, DFF, SS1, rst, pbase};
                if (W_FILL == 0 && K6_DELAY_US > 0 && (long)5 * G + bx >= S.nwg) phase_stagger(K6_DELAY_US);
                pg8::gemm_phase<pg8::EpiSwiglu, pg8::StaticOrder, true, true>(ldsl, tid, gm, S, E);
            } else {
                pg8::Gemm gm{QH, wl + OFF_DN, MTOK, DM, DFF, DFF}; pg8::StaticOrder S; S.init(MTOK, DM, G, bx, WGM_S);
                pg8::EpiResid E{ACT, (l == DEPTH - 1) ? outp : nullptr, DM, SS2};
                pg8::gemm_phase<pg8::EpiResid, pg8::StaticOrder, true, true>(ldsl, tid, gm, S, E);
            }
        }
        if (REP_PH != 0 && ph > 0 && ((REP_PH >> ((ph - 1) % KPLX)) & 1) && prep == 0) { prep = 1; --ph; xcd_barrier(xbar); continue; }
        prep = 0;
        if (ph + 1 < a.ph_hi) { if (a.ph_lo < 0) grid.sync(); else { for (int sx = 0; sx < SYNC_X; ++sx) xcd_barrier(xbar); } }
    }
}

extern "C" void kernel_launch(void* const* d_in, const int* in_sizes, int n_in, void* d_out, int out_size, void* d_ws, size_t ws_size, hipStream_t stream) {
    static int grid = 0;
    if (grid == 0) {
        if (n_in != 21 || in_sizes[0] != MTOK * DM || out_size != MTOK * DM || ws_size < WS_END) { fprintf(stderr, "kernel_launch: unexpected shapes / workspace (n_in %d, ws %zu)\n", n_in, ws_size); grid = -1; return; }
        int dev = 0, cus = 0, per_cu = 0;
        (void)hipGetDevice(&dev); (void)hipDeviceGetAttribute(&cus, hipDeviceAttributeMultiprocessorCount, dev);
        (void)hipFuncSetAttribute((const void*)mega_fwd, hipFuncAttributeMaxDynamicSharedMemorySize, LDS_BYTES);
        (void)hipOccupancyMaxActiveBlocksPerMultiprocessor(&per_cu, (const void*)mega_fwd, NTHR, LDS_BYTES);
        if (per_cu < 1) per_cu = 1;
        (void)hipGetLastError();
        grid = cus * per_cu;
    }
    if (grid < 0) return;
    (void)hipMemsetAsync(d_ws, 0, 16384, stream);
    Args a{};
    for (int i = 0; i < 21; ++i) a.in[i] = (const float*)d_in[i];
    a.out = (float*)d_out; a.ws = (unsigned char*)d_ws;
#if MK_SINGLE
    a.ph_lo = 0; a.ph_hi = N_PHASES;
    void* args[] = {&a};
    hipError_t e = hipLaunchCooperativeKernel((const void*)mega_fwd, dim3(grid), dim3(NTHR), args, LDS_BYTES, stream);
    if (e != hipSuccess) fprintf(stderr, "cooperative launch failed: %s (grid %d)\n", hipGetErrorString(e), grid);
#else
    for (int ph = 0; ph < N_PHASES; ++ph) { a.ph_lo = ph; a.ph_hi = ph + 1; hipLaunchKernelGGL(mega_fwd, dim3(grid), dim3(NTHR), LDS_BYTES, stream, a); }
#endif
}
```
